# Optimizing an MI355X kernel written in HIP

```python
import math
import jax, jax.numpy as jnp
from jax import lax
import numpy as np

D_MODEL = 1024
BATCH = 8
SEQ = 4096
DEPTH = 2

DEEPNORM_ALPHA = (2 * DEPTH) ** 0.25
DEEPNORM_BETA = (8 * DEPTH) ** -0.25
LN_EPS = 1e-5
N_EVEN = (DEPTH + 1) // 2
N_ODD = DEPTH // 2

GDN_HEADS = D_MODEL // 256
GDN_KDIM = 128
GDN_VDIM = 128
GDN_W = GDN_HEADS * GDN_VDIM
CONV_K = 4
GDN_CHUNK = 64

S5_W = D_MODEL // 2
S5_GROUP_CH = 16
S5_GROUPS = S5_W // S5_GROUP_CH
S5_STATE = 64

MIX_W = GDN_W + S5_W
IN_AB = 4 * GDN_W + 2 * GDN_HEADS + S5_W

ATTN_HEAD_DIM = 64
ATTN_HEADS = D_MODEL // ATTN_HEAD_DIM
DILATED_CONFIGS = ((128, 1), (512, 4), (2048, 16))

MOE_GROUPS = 4
EXPERTS_PER_GROUP = 8
N_EXPERTS = MOE_GROUPS * EXPERTS_PER_GROUP
EXPERT_FF = D_MODEL // 2
MOE_TOP_K = 2
MOE_BLOCK = 128

kernel_name = "hybrid_gdn_s5_dilated_hmoe_trunk"


def _layer_norm(x, g, b):
    xf = x.astype(jnp.float32)
    mu = xf.mean(-1, keepdims=True)
    var = jnp.square(xf - mu).mean(-1, keepdims=True)
    return ((xf - mu) * lax.rsqrt(var + LN_EPS) * g.astype(jnp.float32) + b.astype(jnp.float32)).astype(x.dtype)


def _l2norm(t):
    return t * lax.rsqrt(jnp.sum(t * t, axis=-1, keepdims=True) + 1e-6)


def _causal_depthwise_conv(x, w):
    k = w.shape[0]
    return lax.conv_general_dilated(x, w[:, None, :], window_strides=(1,), padding=((k - 1, 0),),
                                    dimension_numbers=('NWC', 'WIO', 'NWC'), feature_group_count=x.shape[-1])


def _chunked_gated_delta_rule(q, k, v, g, beta):
    bsz, s, h, dk = q.shape
    dv = v.shape[-1]
    n = s // GDN_CHUNK

    def to_chunks(t):
        return t.reshape(bsz, n, GDN_CHUNK, h, t.shape[-1]).transpose(0, 3, 1, 2, 4)

    q = to_chunks(q) * (dk ** -0.5)
    k = to_chunks(k)
    v = to_chunks(v)
    g = to_chunks(g[..., None])[..., 0]
    beta = to_chunks(beta[..., None])[..., 0]
    gc = jnp.cumsum(g, axis=-1)
    idx = jnp.arange(GDN_CHUNK)
    causal = idx[:, None] >= idx[None, :]
    strict = idx[:, None] > idx[None, :]
    decay = jnp.exp(jnp.where(causal, gc[..., :, None] - gc[..., None, :], -jnp.inf))
    kb = k * beta[..., None]
    lower = jnp.where(strict, jnp.einsum('bhnik,bhnjk->bhnij', kb, k) * decay, 0.0)
    eye = jnp.eye(GDN_CHUNK, dtype=jnp.float32)
    rhs = jnp.concatenate([v * beta[..., None], kb * jnp.exp(gc)[..., None]], axis=-1)
    sol = lax.linalg.triangular_solve(lower + eye, rhs, left_side=True, lower=True, unit_diagonal=True)
    u, w = sol[..., :dv], sol[..., dv:]
    qk = jnp.where(causal, jnp.einsum('bhnik,bhnjk->bhnij', q, k) * decay, 0.0)
    q_dec = q * jnp.exp(gc)[..., None]
    k_dec = k * jnp.exp(gc[..., -1:] - gc)[..., None]
    g_last = jnp.exp(gc[..., -1])
    xs = (jnp.moveaxis(u, 2, 0), jnp.moveaxis(w, 2, 0), jnp.moveaxis(qk, 2, 0),
          jnp.moveaxis(q_dec, 2, 0), jnp.moveaxis(k_dec, 2, 0), jnp.moveaxis(g_last, 2, 0))

    def step(state, inp):
        u_n, w_n, qk_n, qd_n, kd_n, gl_n = inp
        v_new = u_n - jnp.einsum('bhck,bhkv->bhcv', w_n, state)
        o_n = jnp.einsum('bhck,bhkv->bhcv', qd_n, state) + jnp.einsum('bhij,bhjv->bhiv', qk_n, v_new)
        state = state * gl_n[..., None, None] + jnp.einsum('bhck,bhcv->bhkv', kd_n, v_new)
        return state, o_n

    state0 = jnp.zeros((bsz, h, dk, dv), jnp.float32)
    _, o = lax.scan(step, state0, xs)
    return o.transpose(1, 0, 3, 2, 4).reshape(bsz, s, h, dv)


def _gated_deltanet(qkv_in, z, b_logit, a_logit, conv_w, a_log, dt_bias, norm_w):
    bsz, s, _ = qkv_in.shape
    qkv = jax.nn.silu(_causal_depthwise_conv(qkv_in, conv_w)).astype(jnp.float32)
    q, k, v = jnp.split(qkv, 3, axis=-1)
    q = _l2norm(q.reshape(bsz, s, GDN_HEADS, GDN_KDIM))
    k = _l2norm(k.reshape(bsz, s, GDN_HEADS, GDN_KDIM))
    v = v.reshape(bsz, s, GDN_HEADS, GDN_VDIM)
    beta = jax.nn.sigmoid(b_logit.astype(jnp.float32))
    g = -jnp.exp(a_log.astype(jnp.float32)) * jax.nn.softplus(a_logit.astype(jnp.float32) + dt_bias.astype(jnp.float32))
    o = _chunked_gated_delta_rule(q, k, v, g, beta)
    zh = z.astype(jnp.float32).reshape(bsz, s, GDN_HEADS, GDN_VDIM)
    o = o * lax.rsqrt(jnp.mean(o * o, axis=-1, keepdims=True) + 1e-6) * norm_w.astype(jnp.float32) * jax.nn.silu(zh)
    return o.reshape(bsz, s, GDN_W)


def _s5_layer(u, lam_re, lam_im, log_dt, b_re, b_im, c_re, c_im, d_skip, w_glu):
    bsz, s, _ = u.shape
    uf = u.astype(jnp.float32)
    ug = uf.reshape(bsz, s, S5_GROUPS, S5_GROUP_CH)
    dt = jnp.exp(log_dt.astype(jnp.float32))[:, None]
    lr, li = lam_re.astype(jnp.float32), lam_im.astype(jnp.float32)
    mag = jnp.exp(lr * dt)
    a_re, a_im = mag * jnp.cos(li * dt), mag * jnp.sin(li * dt)
    den = lr * lr + li * li
    nr, ni = a_re - 1.0, a_im
    cr = (nr * lr + ni * li) / den
    ci = (ni * lr - nr * li) / den
    br, bi = b_re.astype(jnp.float32), b_im.astype(jnp.float32)
    bb_re = cr[..., None] * br - ci[..., None] * bi
    bb_im = cr[..., None] * bi + ci[..., None] * br
    bu_re = jnp.einsum('bsgh,gph->bsgp', ug, bb_re)
    bu_im = jnp.einsum('bsgh,gph->bsgp', ug, bb_im)
    a_re_t = jnp.broadcast_to(a_re, (1, s) + a_re.shape)
    a_im_t = jnp.broadcast_to(a_im, (1, s) + a_im.shape)

    def combine(e1, e2):
        a1r, a1i, b1r, b1i = e1
        a2r, a2i, b2r, b2i = e2
        return (a2r * a1r - a2i * a1i, a2r * a1i + a2i * a1r,
                a2r * b1r - a2i * b1i + b2r, a2r * b1i + a2i * b1r + b2i)

    _, _, h_re, h_im = lax.associative_scan(combine, (a_re_t, a_im_t, bu_re, bu_im), axis=1)
    y = (jnp.einsum('gkp,bsgp->bsgk', c_re.astype(jnp.float32), h_re)
         - jnp.einsum('gkp,bsgp->bsgk', c_im.astype(jnp.float32), h_im))
    y = y.reshape(bsz, s, S5_W) + d_skip.astype(jnp.float32) * uf
    y = jax.nn.gelu(y)
    return y * jax.nn.sigmoid(y @ w_glu.astype(jnp.float32))


def _mixer_ab(x, w_in, conv_w, a_log, dt_bias, norm_w, lam_re, lam_im, log_dt,
              b_re, b_im, c_re, c_im, d_skip, w_glu, w_out):
    proj = x @ w_in
    qkv, z, b_logit, a_logit, u = jnp.split(
        proj, [3 * GDN_W, 4 * GDN_W, 4 * GDN_W + GDN_HEADS, 4 * GDN_W + 2 * GDN_HEADS], axis=-1)
    ya = _gated_deltanet(qkv, z, b_logit, a_logit, conv_w, a_log, dt_bias, norm_w)
    yb = _s5_layer(u, lam_re, lam_im, log_dt, b_re, b_im, c_re, c_im, d_skip, w_glu)
    y = jnp.concatenate([ya, yb], axis=-1).astype(x.dtype)
    return y @ w_out


def _dilated_branch(q, k, v, dilation, steps):
    bsz, s, h, e = q.shape
    length = s // dilation
    nb = -(-length // steps)
    lp = nb * steps

    def by_residue(t):
        t = t.reshape(bsz, length, dilation, h, e).transpose(0, 2, 1, 3, 4)
        t = jnp.pad(t, ((0, 0), (0, 0), (0, lp - length), (0, 0), (0, 0)))
        return t.reshape(bsz, dilation, nb, steps, h, e)

    def with_prev(t):
        prev = jnp.pad(t, ((0, 0), (0, 0), (1, 0), (0, 0), (0, 0), (0, 0)))[:, :, :-1]
        return jnp.concatenate([prev, t], axis=3)

    qb = by_residue(q)
    kk = with_prev(by_residue(k))
    vv = with_prev(by_residue(v))
    scores = jnp.einsum('bdnqhe,bdnkhe->bdhnqk', qb, kk).astype(jnp.float32) * (e ** -0.5)
    i = jnp.arange(steps)[:, None]
    j = jnp.arange(2 * steps)[None, :]
    dist = steps + i - j
    blk = jnp.arange(nb)[:, None, None]
    valid = (dist >= 0) & (dist <= steps) & (blk * steps + j - steps >= 0)
    scores = jnp.where(valid, scores, -1e30)
    m = jnp.max(scores, axis=-1, keepdims=True)
    p = jnp.exp(scores - m)
    ssum = jnp.sum(p, axis=-1, keepdims=True)
    out = jnp.einsum('bdhnqk,bdnkhe->bdnqhe', p / ssum, vv.astype(jnp.float32))
    lse = (m + jnp.log(ssum))[..., 0]
    out = out.reshape(bsz, dilation, lp, h, e)[:, :, :length].transpose(0, 2, 1, 3, 4).reshape(bsz, s, h, e)
    lse = lse.transpose(0, 1, 3, 4, 2).reshape(bsz, dilation, lp, h)[:, :, :length]
    lse = lse.transpose(0, 2, 1, 3).reshape(bsz, s, h)
    return out, lse


def _mixer_c(x, w_qkv, w_out):
    bsz, s, _ = x.shape
    qkv = (x @ w_qkv).reshape(bsz, s, 3, ATTN_HEADS, ATTN_HEAD_DIM)
    q, k, v = qkv[:, :, 0], qkv[:, :, 1], qkv[:, :, 2]
    outs, lses = [], []
    for window, dilation in DILATED_CONFIGS:
        o, l = _dilated_branch(q, k, v, dilation, window // dilation)
        outs.append(o)
        lses.append(l)
    wts = jax.nn.softmax(jnp.stack(lses, axis=0), axis=0)
    o = jnp.einsum('cbsh,cbshe->bshe', wts, jnp.stack(outs, axis=0))
    return o.reshape(bsz, s, D_MODEL).astype(x.dtype) @ w_out


def _hier_moe(x, wg_r, bg_r, we_r, be_r, w_gate, w_up, w_down):
    bsz, s, d = x.shape
    n = bsz * s
    xt = x.reshape(n, d)
    group_prob = jax.nn.softmax((xt @ wg_r + bg_r).astype(jnp.float32), axis=-1)
    p_group, group = lax.top_k(group_prob, 1)
    expert_logits = (xt @ we_r + be_r).astype(jnp.float32).reshape(n, MOE_GROUPS, EXPERTS_PER_GROUP)
    in_group = jnp.einsum('ng,nge->ne', jax.nn.one_hot(group[:, 0], MOE_GROUPS, dtype=jnp.float32), expert_logits)
    top_logit, top_local = lax.top_k(in_group, MOE_TOP_K)
    gate = p_group * jax.nn.softmax(top_logit, axis=-1)
    expert = group * EXPERTS_PER_GROUP + top_local
    nk = n * MOE_TOP_K
    flat_expert = expert.reshape(nk)
    flat_token = jnp.arange(nk, dtype=jnp.int32) // MOE_TOP_K
    flat_gate = gate.reshape(nk)
    order = jnp.argsort(flat_expert)
    sorted_expert = flat_expert[order]
    counts = jnp.bincount(flat_expert, length=N_EXPERTS)
    padded = (counts + MOE_BLOCK - 1) // MOE_BLOCK * MOE_BLOCK
    start = jnp.cumsum(counts) - counts
    padded_end = jnp.cumsum(padded)
    padded_start = padded_end - padded
    slot = padded_start[sorted_expert] + jnp.arange(nk) - start[sorted_expert]
    n_slots = (-(-nk // MOE_BLOCK) + N_EXPERTS) * MOE_BLOCK
    n_blocks = n_slots // MOE_BLOCK
    slot_token = jnp.zeros((n_slots,), jnp.int32).at[slot].set(flat_token[order])
    slot_gate = jnp.zeros((n_slots,), jnp.float32).at[slot].set(flat_gate[order])
    block_expert = jnp.minimum(
        jnp.searchsorted(padded_end, jnp.arange(n_blocks) * MOE_BLOCK, side='right'), N_EXPERTS - 1)
    xb = xt[slot_token].reshape(n_blocks, MOE_BLOCK, d)

    def expert_block(args):
        xi, e = args
        hdn = jax.nn.silu(xi @ w_gate[e]) * (xi @ w_up[e])
        return hdn @ w_down[e]

    yb = lax.map(expert_block, (xb, block_expert))
    y = yb.reshape(n_slots, d) * slot_gate[:, None].astype(yb.dtype)
    out = jnp.zeros((n, d), y.dtype).at[slot_token].add(y)
    return out.reshape(bsz, s, d)


def setup_inputs(seed: int = 0) -> dict:
    key = jax.random.key(seed)
    ks = iter(jax.random.split(key, 48))
    f32 = jnp.float32

    def nrm(shape, scale):
        return jax.random.normal(next(ks), shape, f32) * scale

    def unif(shape, lo, hi):
        return jax.random.uniform(next(ks), shape, f32, lo, hi)

    x = nrm((BATCH, SEQ, D_MODEL), 1.0)
    w_in_ab = nrm((N_EVEN, D_MODEL, IN_AB), D_MODEL ** -0.5)
    conv_qkv = nrm((N_EVEN, CONV_K, 3 * GDN_W), CONV_K ** -0.5)
    gdn_a_log = jnp.log(unif((N_EVEN, GDN_HEADS), 1.0, 16.0))
    dt0 = jnp.exp(unif((N_EVEN, GDN_HEADS), math.log(1e-3), math.log(1e-1)))
    gdn_dt_bias = dt0 + jnp.log(-jnp.expm1(-dt0))
    gdn_norm = 1.0 + nrm((N_EVEN, GDN_VDIM), 0.02)
    s5_lam_re = -0.5 + nrm((N_EVEN, S5_GROUPS, S5_STATE), 0.01)
    s5_lam_im = (math.pi * jnp.arange(S5_STATE, dtype=f32))[None, None, :] + nrm((N_EVEN, S5_GROUPS, S5_STATE), 0.01)
    s5_log_dt = unif((N_EVEN, S5_GROUPS), math.log(1e-3), math.log(1e-1))
    s5_b_re = nrm((N_EVEN, S5_GROUPS, S5_STATE, S5_GROUP_CH), (2 * S5_GROUP_CH) ** -0.5)
    s5_b_im = nrm((N_EVEN, S5_GROUPS, S5_STATE, S5_GROUP_CH), (2 * S5_GROUP_CH) ** -0.5)
    s5_c_re = nrm((N_EVEN, S5_GROUPS, S5_GROUP_CH, S5_STATE), S5_STATE ** -0.5)
    s5_c_im = nrm((N_EVEN, S5_GROUPS, S5_GROUP_CH, S5_STATE), S5_STATE ** -0.5)
    s5_d = nrm((N_EVEN, S5_W), 1.0)
    s5_w_glu = nrm((N_EVEN, S5_W, S5_W), S5_W ** -0.5)
    w_out_ab = nrm((N_EVEN, MIX_W, D_MODEL), MIX_W ** -0.5 * DEEPNORM_BETA)
    w_qkv_c = nrm((N_ODD, D_MODEL, 3 * D_MODEL), D_MODEL ** -0.5)
    w_out_c = nrm((N_ODD, D_MODEL, D_MODEL), D_MODEL ** -0.5 * DEEPNORM_BETA)
    ln_mix_g = 1.0 + nrm((DEPTH, D_MODEL), 0.02)
    ln_mix_b = nrm((DEPTH, D_MODEL), 0.02)
    router_group_w = nrm((DEPTH, D_MODEL, MOE_GROUPS), D_MODEL ** -0.5)
    router_group_b = nrm((DEPTH, MOE_GROUPS), 0.01)
    router_expert_w = nrm((DEPTH, D_MODEL, N_EXPERTS), D_MODEL ** -0.5)
    router_expert_b = nrm((DEPTH, N_EXPERTS), 0.01)
    moe_w_gate = nrm((DEPTH, N_EXPERTS, D_MODEL, EXPERT_FF), D_MODEL ** -0.5)
    moe_w_up = nrm((DEPTH, N_EXPERTS, D_MODEL, EXPERT_FF), D_MODEL ** -0.5)
    moe_w_down = nrm((DEPTH, N_EXPERTS, EXPERT_FF, D_MODEL), EXPERT_FF ** -0.5 * DEEPNORM_BETA)
    ln_ffn_g = 1.0 + nrm((DEPTH, D_MODEL), 0.02)
    ln_ffn_b = nrm((DEPTH, D_MODEL), 0.02)
    return {
        "x": x, "w_in_ab": w_in_ab, "conv_qkv": conv_qkv, "gdn_a_log": gdn_a_log,
        "gdn_dt_bias": gdn_dt_bias, "gdn_norm": gdn_norm, "s5_lam_re": s5_lam_re,
        "s5_lam_im": s5_lam_im, "s5_log_dt": s5_log_dt, "s5_b_re": s5_b_re, "s5_b_im": s5_b_im,
        "s5_c_re": s5_c_re, "s5_c_im": s5_c_im, "s5_d": s5_d, "s5_w_glu": s5_w_glu,
        "w_out_ab": w_out_ab, "w_qkv_c": w_qkv_c, "w_out_c": w_out_c,
        "ln_mix_g": ln_mix_g, "ln_mix_b": ln_mix_b,
        "router_group_w": router_group_w, "router_group_b": router_group_b,
        "router_expert_w": router_expert_w, "router_expert_b": router_expert_b,
        "moe_w_gate": moe_w_gate, "moe_w_up": moe_w_up, "moe_w_down": moe_w_down,
        "ln_ffn_g": ln_ffn_g, "ln_ffn_b": ln_ffn_b,
    }


def reference(x, w_in_ab, conv_qkv, gdn_a_log, gdn_dt_bias, gdn_norm, s5_lam_re, s5_lam_im,
              s5_log_dt, s5_b_re, s5_b_im, s5_c_re, s5_c_im, s5_d, s5_w_glu, w_out_ab,
              w_qkv_c, w_out_c, ln_mix_g, ln_mix_b, router_group_w, router_group_b,
              router_expert_w, router_expert_b, moe_w_gate, moe_w_up, moe_w_down,
              ln_ffn_g, ln_ffn_b):
    h = x
    for layer in range(DEPTH):
        i = layer // 2
        if layer % 2 == 0:
            mix = _mixer_ab(h, w_in_ab[i], conv_qkv[i], gdn_a_log[i], gdn_dt_bias[i], gdn_norm[i],
                            s5_lam_re[i], s5_lam_im[i], s5_log_dt[i], s5_b_re[i], s5_b_im[i],
                            s5_c_re[i], s5_c_im[i], s5_d[i], s5_w_glu[i], w_out_ab[i])
        else:
            mix = _mixer_c(h, w_qkv_c[i], w_out_c[i])
        h = _layer_norm(DEEPNORM_ALPHA * h + mix, ln_mix_g[layer], ln_mix_b[layer])
        ffn = _hier_moe(h, router_group_w[layer], router_group_b[layer], router_expert_w[layer],
                        router_expert_b[layer], moe_w_gate[layer], moe_w_up[layer], moe_w_down[layer])
        h = _layer_norm(DEEPNORM_ALPHA * h + ffn, ln_ffn_g[layer], ln_ffn_b[layer])
    return h
```

```cpp
#ifndef EMU
#include <hip/hip_runtime.h>
#include <hip/hip_cooperative_groups.h>
#endif
#include <cstdint>
#include <cstdio>
#include <cmath>
#include <cstring>
#include <cstdlib>

#ifndef CFG_BATCH
#define CFG_BATCH 8
#endif
#ifndef CFG_SEQ
#define CFG_SEQ 4096
#endif
#ifndef N_LAUNCH_MODE
#define N_LAUNCH_MODE 1
#endif

typedef unsigned short bf16_t;
typedef short bf16x8 __attribute__((ext_vector_type(8)));
typedef float f32x4 __attribute__((ext_vector_type(4)));
typedef unsigned u32x4 __attribute__((ext_vector_type(4)));
typedef unsigned u32x2 __attribute__((ext_vector_type(2)));

constexpr int NB_ = CFG_BATCH, NS_ = CFG_SEQ, NT = NB_ * NS_, DM = 1024;
constexpr int NCH = NS_ / 64;
constexpr int PROJ_LD = 2560;
constexpr int NEXP = 32, EFF = 512;
constexpr int LIST_CAP = NT * 2;
constexpr float ALPHA = 1.41421356237f;
constexpr float LN_EPS = 1e-5f;
constexpr int NTHREADS = 512, NW = 8;
constexpr int LDS_BYTES = 160 * 1024;

#ifdef EMU
#define LDS_BASE() (emu::cur->blk->smem)
#define GRID_SYNC_CG() emu::grid_sync()
#define GRID_SYNC() emu::grid_sync()
struct XcdBarrier { int dummy; };
#else
extern __shared__ __attribute__((aligned(16))) char lds_raw[];
#define LDS_BASE() (lds_raw)
#define GRID_SYNC_CG() cooperative_groups::this_grid().sync()
#define GRID_SYNC() xcd_barrier(xb)
#define XB_TMO      128
#define XB_XCNT(j)  (256  + 64 * (j))
#define XB_XSUB(j)  (1280 + 64 * (j))
#define XB_XGEN(j)  (2304 + 64 * (j))
#define XB_TOP      3328
#define XB_TOPGEN   3392
#define XCD_BAR_WORDS 3456
#define XB_SPIN_CAP (1u << 18)
#define XB_LAS __attribute__((address_space(3)))
#define XB_ACQUIRE() __builtin_amdgcn_fence(__ATOMIC_ACQUIRE, "agent")
__device__ __forceinline__ unsigned xb_ld(unsigned* p)              { return __hip_atomic_load(p, __ATOMIC_RELAXED, __HIP_MEMORY_SCOPE_AGENT); }
__device__ __forceinline__ unsigned xb_add(unsigned* p, unsigned v) { return __hip_atomic_fetch_add(p, v, __ATOMIC_RELAXED, __HIP_MEMORY_SCOPE_AGENT); }
__device__ __forceinline__ unsigned xb_xcc_id() { return (unsigned)__builtin_amdgcn_s_getreg((3 << 11) | 20) & 0xFu; }
#define XB_SPIN(cond, bar) do { unsigned _sp = 0; while (cond) { __builtin_amdgcn_s_sleep(1); \
    if ((++_sp & 255u) == 0u) { if (xb_ld(&(bar)[XB_TMO])) break; if (_sp > XB_SPIN_CAP) { atomicAdd(&(bar)[XB_TMO], 1u); break; } } } } while (0)
struct XcdBarrier { unsigned* bar; unsigned x; volatile XB_LAS unsigned* st; };
__device__ __forceinline__ XcdBarrier xcd_barrier_post(unsigned* bar, volatile XB_LAS unsigned* st) {
    XcdBarrier b; b.bar = bar; b.x = xb_xcc_id(); b.st = st;
    if (threadIdx.x == 0) (void)xb_add(&bar[XB_XCNT(b.x)], 1u);
    return b;
}
__device__ __forceinline__ void xcd_barrier_complete(unsigned* bar, unsigned x, unsigned& nloc, unsigned& nx) {
    const unsigned G = gridDim.x * gridDim.y * gridDim.z;
    unsigned sum, cnt, mine, sp = 0u;
    for (;;) {
        sum = 0u; cnt = 0u; mine = 0u;
#pragma unroll
        for (unsigned j = 0; j < 16; ++j) { const unsigned c = xb_ld(&bar[XB_XCNT(j)]); sum += c; cnt += (c > 0u) ? 1u : 0u; mine = (j == x) ? c : mine; }
        if (sum == G) break;
        __builtin_amdgcn_s_sleep(1);
        if ((++sp & 255u) == 0u) { if (xb_ld(&bar[XB_TMO])) break; if (sp > XB_SPIN_CAP) { atomicAdd(&bar[XB_TMO], 1u); break; } }
    }
    nloc = mine > 0u ? mine : 1u; nx = cnt > 0u ? cnt : 1u;
}
__device__ __forceinline__ void xcd_barrier(const XcdBarrier& b) {
    asm volatile("s_waitcnt vmcnt(0)" ::: "memory");
    __syncthreads();
    if (threadIdx.x == 0) {
        unsigned* bar = b.bar;
        __builtin_amdgcn_s_waitcnt(0);
        unsigned nloc = b.st[0], nx = b.st[1];
        if (nloc == 0u) { xcd_barrier_complete(bar, b.x, nloc, nx); b.st[0] = nloc; b.st[1] = nx; }
        const unsigned old = xb_add(&bar[XB_XSUB(b.x)], 1u);
        const unsigned gen = old / nloc;
        if (old + 1u == (gen + 1u) * nloc) {
            __builtin_amdgcn_fence(__ATOMIC_RELEASE, "agent");
            asm volatile("s_waitcnt vmcnt(0)" ::: "memory");
            const unsigned og = xb_add(&bar[XB_TOP], 1u);
            const unsigned tg = og / nx;
            if (og + 1u == (tg + 1u) * nx) xb_add(&bar[XB_TOPGEN], 1u);
            else XB_SPIN(xb_ld(&bar[XB_TOPGEN]) == tg, bar);
            XB_ACQUIRE();
            xb_add(&bar[XB_XGEN(b.x)], 1u);
            asm volatile("s_waitcnt vmcnt(0)" ::: "memory");
        } else {
            XB_SPIN(xb_ld(&bar[XB_XGEN(b.x)]) == gen, bar);
            XB_ACQUIRE();
            asm volatile("s_waitcnt vmcnt(0)" ::: "memory");
        }
    }
    __syncthreads();
}
#endif
#ifdef EMU
#define NT_STORE(ptr, val) (*(ptr) = (val))
#else
#define NT_STORE(ptr, val) __builtin_nontemporal_store((val), (ptr))
#endif
#ifndef WT_PLAIN
#define WT_PLAIN 0
#endif
#ifdef EMU
#define WT_STORE_I(ptr, val) (*(ptr) = (val))
#define WT_STORE_F(ptr, val) (*(ptr) = (val))
#define WT_STORE_F2(ptr, a, b) ((ptr)[0] = (a), (ptr)[1] = (b))
#else
#if WT_PLAIN
#define WT_STORE_F2(ptr, a, b) ((ptr)[0] = (a), (ptr)[1] = (b))
#define WT_STORE_I(ptr, val) (*(ptr) = (val))
#define WT_STORE_F(ptr, val) (*(ptr) = (val))
#else
#define WT_STORE_F2(ptr, a, b) __hip_atomic_store((unsigned long long*)(ptr), ((unsigned long long)__float_as_uint(b) << 32) | (unsigned long long)__float_as_uint(a), __ATOMIC_RELAXED, __HIP_MEMORY_SCOPE_AGENT)
#define WT_STORE_I(ptr, val) __hip_atomic_store((ptr), (val), __ATOMIC_RELAXED, __HIP_MEMORY_SCOPE_AGENT)
#define WT_STORE_F(ptr, val) __hip_atomic_store((ptr), (val), __ATOMIC_RELAXED, __HIP_MEMORY_SCOPE_AGENT)
#endif
#endif
#ifdef EMU
#define LDS_BARRIER() emu::syncthreads()
#else
#define LDS_BARRIER() asm volatile("s_waitcnt lgkmcnt(0)\n\ts_barrier" ::: "memory")
#endif
constexpr int XB_ST_OFF = 160 * 1024 - 16;

__device__ __forceinline__ int TID() {
#ifdef EMU
    return (int)emu::cur->tid.x;
#else
    int t = (int)threadIdx.x; asm volatile("" : "+v"(t)); return t;
#endif
}
__device__ __forceinline__ float bf2f(bf16_t v) { return __builtin_bit_cast(float, (unsigned)v << 16); }
__device__ __forceinline__ bf16_t f2bf(float f) { unsigned u = __builtin_bit_cast(unsigned, f); u += 0x7fffu + ((u >> 16) & 1u); return (bf16_t)(u >> 16); }
#ifdef EMU
__device__ __forceinline__ unsigned pack2(float a, float b) { return (unsigned)f2bf(a) | ((unsigned)f2bf(b) << 16); }
#else
typedef float f32x2_t_ __attribute__((ext_vector_type(2))); typedef __bf16 bf16x2_t_ __attribute__((ext_vector_type(2)));
__device__ __forceinline__ unsigned pack2(float a, float b) { f32x2_t_ v = {a, b}; bf16x2_t_ r = __builtin_convertvector(v, bf16x2_t_); return __builtin_bit_cast(unsigned, r); }
#endif
__device__ __forceinline__ float sigmoidf_(float x) { return 1.0f / (1.0f + __expf(-x)); }
__device__ __forceinline__ float siluf_(float x) { return x / (1.0f + __expf(-x)); }
__device__ __forceinline__ float wave_sum(float v) {
#pragma unroll
    for (int o = 32; o > 0; o >>= 1) v += __shfl_xor(v, o);
    return v;
}

struct TJob { const float* src; bf16_t* dst; int K, N, ldsrc, ldd, rb, rs, roff, batch; long sbs, dbs; };

struct Params {
    const float *x, *w_in, *conv, *a_log, *dt_bias, *gnorm, *lam_re, *lam_im, *log_dt, *b_re, *b_im, *c_re, *c_im, *s5d, *wglu, *wout,
        *wqkv, *woutc, *lnmg, *lnmb, *rgw, *rgb, *rew, *reb, *mg, *mu, *md, *lnfg, *lnfb;
    float* out;
    bf16_t *WinT, *WoutT, *WgluT, *WqkvT, *WoutcT;
    float* WrT;
    float *s5a, *s5a64, *s5bbr, *s5bbi;
    bf16_t* s5cm;
    bf16_t* s5bbm;
    bf16_t* hb;
    bf16_t *WguT, *WdT;
    int* cnt;
    int *tok_e, *tok_pos; float* tok_gate;
    int* list; float* list_gate;
    bf16_t* proj;
    float *gbeta, *gg;
    bf16_t *gq, *gk, *gv;
    bf16_t *cU, *cW, *cQd, *cKdT;
    bf16_t* cQK;
    float* cgl;
    bf16_t* go;
    float *s5loc, *s5in;
    bf16_t* ygelu;
    bf16_t* ycat;
    bf16_t* mix;
    bf16_t* H;
    bf16_t* Y;
    bf16_t* qkv;
    bf16_t* attno;
    bf16_t* obr[3];
    float* ost;
    bf16_t* mix1;
    bf16_t* Xg;
    float* slot_gate;
    unsigned* bar;
    TJob jobs[8]; int njobs; int pad0;
    TJob moejobs[2][3];
};

struct TTile { const float* src; bf16_t* dst; int ldsrc, ldd, rb, rs, roff, k0, n0; };
template <int NJ>
__device__ __forceinline__ TTile tt_decode(const TJob* jobs, int g) {
    TJob J = jobs[0]; int rem = g; bool found = false;
#pragma unroll
    for (int j = 0; j < NJ; ++j) { const int nt = jobs[j].batch * (jobs[j].K / 64) * (jobs[j].N / 64); if (!found) { if (rem < nt) { J = jobs[j]; found = true; } else rem -= nt; } }
    const int tk = J.K / 64, tn = J.N / 64;
    const int b = rem / (tk * tn), r2 = rem % (tk * tn);
    TTile T; T.k0 = (r2 / tn) * 64; T.n0 = (r2 % tn) * 64; T.src = J.src + (long)b * J.sbs; T.dst = J.dst + (long)b * J.dbs;
    T.ldsrc = J.ldsrc; T.ldd = J.ldd; T.rb = J.rb; T.rs = J.rs; T.roff = J.roff; return T;
}
__device__ __forceinline__ void tt_load(const TTile& T, int t, f32x4 (&r)[4]) {
#pragma unroll
    for (int i = 0; i < 4; ++i) r[i] = *(const f32x4*)(T.src + (long)(T.k0 + (t >> 4) + 16 * i) * T.ldsrc + T.n0 + (t & 15) * 4);
}
__device__ __forceinline__ void tt_emit(const TTile& T, int t, float* ts, const f32x4 (&r)[4], bool active) {
    LDS_BARRIER();
    if (active) {
#pragma unroll
        for (int i = 0; i < 4; ++i) { const int k = (t >> 4) + 16 * i, n4 = (t & 15) * 4; ts[k * 65 + n4 + 0] = r[i][0]; ts[k * 65 + n4 + 1] = r[i][1]; ts[k * 65 + n4 + 2] = r[i][2]; ts[k * 65 + n4 + 3] = r[i][3]; }
    }
    LDS_BARRIER();
    if (active) {
        const int n = t >> 2, kq = (t & 3) * 16;
        unsigned w[8];
#pragma unroll
        for (int i = 0; i < 8; ++i) w[i] = pack2(ts[(kq + 2 * i) * 65 + n], ts[(kq + 2 * i + 1) * 65 + n]);
        const int nn = T.n0 + n, row = (nn / T.rb) * T.rs + T.roff + nn % T.rb;
        u32x4* o = (u32x4*)(T.dst + (long)row * T.ldd + T.k0 + kq);
        o[0] = (u32x4){w[0], w[1], w[2], w[3]}; o[1] = (u32x4){w[4], w[5], w[6], w[7]};
    }
}
template <int NJ>
__device__ __forceinline__ void transpose_tiles(const TJob* jobs) {
    const int t = TID() & 255, half = TID() >> 8;
    float* ts = (float*)LDS_BASE() + half * (64 * 65 + 16);
    int total = 0;
#pragma unroll
    for (int j = 0; j < NJ; ++j) total += jobs[j].batch * (jobs[j].K / 64) * (jobs[j].N / 64);
    const int G = (int)gridDim.x;
    f32x4 ra[4], rb[4];
    int gp = (int)blockIdx.x;
    if (gp * 2 + half < total) { const TTile T0 = tt_decode<NJ>(jobs, gp * 2 + half); tt_load(T0, t, ra); }
#pragma unroll 1
    for (; gp * 2 < total; gp += 2 * G) {
        {
            const int g = gp * 2 + half, gn = (gp + G) * 2 + half; const bool active = g < total;
            if (gn < total) { const TTile Tn = tt_decode<NJ>(jobs, gn); tt_load(Tn, t, rb); }
            const TTile T = tt_decode<NJ>(jobs, active ? g : 0);
            tt_emit(T, t, ts, ra, active);
        }
        if ((gp + G) * 2 < total) {
            const int g = (gp + G) * 2 + half, gn = (gp + 2 * G) * 2 + half; const bool active = g < total;
            if (gn < total) { const TTile Tn = tt_decode<NJ>(jobs, gn); tt_load(Tn, t, ra); }
            const TTile T = tt_decode<NJ>(jobs, active ? g : 0);
            tt_emit(T, t, ts, rb, active);
        }
    }
}

__device__ __forceinline__ void phase_prologue(const Params& p) {
    transpose_tiles<6>(p.jobs);
    const long gtid = (long)blockIdx.x * NTHREADS + TID(), gsz = (long)gridDim.x * NTHREADS;
    for (long i = gtid; i < 2L * 36 * 1024; i += gsz) {
        const int l = (int)(i / (36 * 1024)), n = (int)((i / 1024) % 36), k = (int)(i % 1024);
        p.WrT[i] = n < 4 ? p.rgw[((long)l * 1024 + k) * 4 + n] : p.rew[((long)l * 1024 + k) * 32 + (n - 4)];
    }
    for (long i = gtid; i < 32 * 64; i += gsz) {
        const int g = (int)(i / 64);
        const float dt = expf(p.log_dt[g]);
        const float lr = p.lam_re[i], li = p.lam_im[i];
        const float mag = expf(lr * dt), ar = mag * cosf(li * dt), ai = mag * sinf(li * dt);
        const float mag64 = expf(64.0f * lr * dt), ph64 = 64.0f * li * dt;
        p.s5a[i * 2] = ar; p.s5a[i * 2 + 1] = ai;
        p.s5a64[i * 2] = mag64 * cosf(ph64); p.s5a64[i * 2 + 1] = mag64 * sinf(ph64);
        const float den = lr * lr + li * li, nr = ar - 1.0f, ni = ai;
        const float cr = (nr * lr + ni * li) / den, ci = (ni * lr - nr * li) / den;
        for (int h = 0; h < 16; ++h) {
            const float br = p.b_re[i * 16 + h], bi = p.b_im[i * 16 + h];
            p.s5bbr[i * 16 + h] = cr * br - ci * bi; p.s5bbi[i * 16 + h] = cr * bi + ci * br;
            const int pp = (int)(i % 64);
            p.s5bbm[((long)g * 128 + pp) * 16 + h] = f2bf(cr * br - ci * bi); p.s5bbm[((long)g * 128 + 64 + pp) * 16 + h] = f2bf(cr * bi + ci * br);
        }
    }
    for (long i = gtid; i < 32 * 16 * 128; i += gsz) {
        const int p2 = (int)(i % 128); const long gk = i / 128;
        p.s5cm[i] = f2bf(p2 < 64 ? p.c_re[gk * 64 + p2] : -p.c_im[gk * 64 + (p2 - 64)]);
    }
    for (long i = gtid; i < 64; i += gsz) p.cnt[i] = 0;
}

#ifndef MOE_XCD
#define MOE_XCD 1
#endif
namespace pg8 {
#ifdef EMU
#define PG8_LAS
#define PG8_WAIT_V(n) do { } while (0)
#define PG8_WAIT_L(n) do { } while (0)
#else
#define PG8_LAS __attribute__((address_space(3)))
#define PG8_WAIT_V(n) asm volatile("s_waitcnt vmcnt(" #n ")" ::: "memory")
#define PG8_WAIT_L(n) asm volatile("s_waitcnt lgkmcnt(" #n ")" ::: "memory")
#endif
constexpr int BM = 256, BK = 64, HALF = 128, HTB = HALF * BK * 2  , STAGE_BYTES = 8 * HTB, NXCD = 8, WGM = 8;
__host__ __device__ __forceinline__ int lds_byte(int r, int c) { const int st = (r >> 4) * 2 + (c >> 5), rr = r & 15, cc = c & 31, ob = rr * 64 + cc * 2; return st * 1024 + (ob ^ (((ob >> 9) & 1) << 5)); }
__host__ __device__ __forceinline__ void stage_rc(int b, int& R, int& C) { const int st = b / 1024, sb = b % 1024, swz = sb ^ (((sb >> 9) & 1) << 5); R = (st >> 1) * 16 + swz / 64; C = (st & 1) * 32 + (swz % 64) / 2; }
__host__ __device__ __forceinline__ int perm32(int rho) { const int n = rho >> 4, i = rho & 15; return 8 * (i >> 2) + 4 * n + (i & 3); }

struct Unit { int arow, brow, pn, nvalid, lrow; };

struct DenseOrder {
    int nM, nN, nwg, G, c;
    __device__ __forceinline__ void init(int M, int N, int G_, int c_) { nM = M / BM; nN = N / BM; nwg = nM * nN; G = G_; c = c_; }
    __device__ __forceinline__ bool next(int i, Unit& u) const {
        const long L = (long)i * G + c; if (L >= nwg) return false;
        int wgid = (int)L; { const int q = nwg / NXCD, r = nwg % NXCD, xcd = wgid % NXCD, off = wgid / NXCD; wgid = (xcd < r ? xcd * (q + 1) : r * (q + 1) + (xcd - r) * q) + off; }
        const int nig = WGM * nN, gid = wgid / nig, fm = gid * WGM, gsz = (nM - fm) < WGM ? (nM - fm) : WGM;
        const int pm = fm + ((wgid % nig) % gsz), pn = (wgid % nig) / gsz;
        u.arow = pm * BM; u.brow = pn * BM; u.pn = pn; u.nvalid = BM; u.lrow = 0; return true;
    }
};
struct MoeOrder {
    const int* ustart; const int* rbase; const int* cntp; int G, c, npn, brows;
    __device__ __forceinline__ bool next(int i, Unit& u) const {
        const int L0 = i * G + c, nwg = ustart[32]; if (L0 >= nwg) return false;
        int L = L0; if (MOE_XCD) { const int q = nwg / NXCD, r = nwg % NXCD, xcd = L0 % NXCD, off = L0 / NXCD; L = (xcd < r ? xcd * (q + 1) : r * (q + 1) + (xcd - r) * q) + off; }
        int e = 0; while (ustart[e + 1] <= L) ++e;
        const int cn = cntp[e], ntile = (cn + BM - 1) / BM, local = L - ustart[e], ti = local % ntile, pn = local / ntile;
        u.arow = rbase[e] + ti * BM; u.brow = e * brows + pn * BM; u.pn = pn; u.nvalid = cn - ti * BM < BM ? cn - ti * BM : BM; u.lrow = e * LIST_CAP + ti * BM; return true;
    }
};

template <class Epi, class Sched, bool GATHER = false>
__device__ __forceinline__ void gemm_phase(PG8_LAS unsigned char* lds, const bf16_t* gA, const bf16_t* gBt, const int K, const Sched& S, const Epi& E, const int* list = nullptr) {
    const int tid = TID(), wid = __builtin_amdgcn_readfirstlane(tid >> 6), lane = tid & 63, wr = wid >> 2, wc = wid & 3, fr = lane & 15, fq = lane >> 4;
    const int nt = K / BK;
    unsigned voffA[2], voffB[2]; int Rl[2], Cl[2];
#pragma unroll
    for (int i = 0; i < 2; ++i) { int R, C; stage_rc(tid * 16 + i * 8192, R, C); const int Rb = Epi::PERM ? ((R & ~31) + perm32(R & 31)) : R;
        voffA[i] = (unsigned)(R * K + C) * 2u; voffB[i] = (unsigned)(Rb * K + C) * 2u; Rl[i] = R; Cl[i] = C; }
    unsigned aoC[2][2], aoN[2][2];
#define PG8_GATHER_OFFS(ao, u_) do { _Pragma("unroll") for (int h_ = 0; h_ < 2; ++h_) _Pragma("unroll") for (int i_ = 0; i_ < 2; ++i_) { \
        int pos_ = h_ * HALF + Rl[i_]; pos_ = pos_ < (u_).nvalid ? pos_ : (u_).nvalid - 1; \
        ao[h_][i_] = (unsigned)list[(u_).lrow + pos_] * (unsigned)(K * 2) + (unsigned)(Cl[i_] * 2); } } while (0)
#define PG8_STAGE_A(bufoff, aptr, h, kb, nx) do { if constexpr (GATHER) { unsigned ao_[2] = {(nx) ? aoN[h][0] : aoC[h][0], (nx) ? aoN[h][1] : aoC[h][1]}; \
        PG8_STAGE(bufoff, (const char*)gA + (kb), ao_); } else { PG8_STAGE(bufoff, (aptr) + (h) * hstep, voffA); } } while (0)
    const size_t kstep = (size_t)(BK * 2);
    const size_t hstep = (size_t)HALF * K * 2;
    const unsigned ldsw = (unsigned)wid * 1024u;
    const int aoff = lds_byte(wr * 64 + fr, fq * 8), boff = lds_byte(wc * 32 + fr, fq * 8);
#define PG8_SA(b, h) (((b) * 2 + (h)) * HTB)
#define PG8_SB(b, h) ((4 + (b) * 2 + (h)) * HTB)
#define PG8_STAGE(bufoff, gbase, voff) do { _Pragma("unroll") for (int _i = 0; _i < 2; ++_i) \
        __builtin_amdgcn_global_load_lds((const unsigned*)((const char*)(gbase) + (voff)[_i]), (PG8_LAS unsigned*)(lds + (bufoff) + ldsw + _i * 8192), 16, 0, 0); } while (0)
#define PG8_LDA(dst, b, h) do { _Pragma("unroll") for (int m = 0; m < 4; ++m) _Pragma("unroll") for (int k = 0; k < 2; ++k) dst[m][k] = *(const PG8_LAS bf16x8*)(lds + PG8_SA(b, h) + aoff + m * 2048 + k * 1024); } while (0)
#define PG8_LDB(dst, b, h) do { _Pragma("unroll") for (int n = 0; n < 2; ++n) _Pragma("unroll") for (int k = 0; k < 2; ++k) dst[n][k] = *(const PG8_LAS bf16x8*)(lds + PG8_SB(b, h) + boff + n * 2048 + k * 1024); } while (0)
#define PG8_MMA(ai, bj, At, Bt) do { __builtin_amdgcn_s_setprio(1); _Pragma("unroll") for (int m = 0; m < 4; ++m) _Pragma("unroll") for (int n = 0; n < 2; ++n) _Pragma("unroll") for (int k = 0; k < 2; ++k) \
        acc[ai][bj][m][n] = __builtin_amdgcn_mfma_f32_16x16x32_bf16(Bt[n][k], At[m][k], acc[ai][bj][m][n], 0, 0, 0); __builtin_amdgcn_s_setprio(0); } while (0)
#define PG8_BAR __builtin_amdgcn_s_barrier()
#define PG8_SCHED __builtin_amdgcn_sched_barrier(0)
    Unit cur, nxt; int ui = 0;
    if (!S.next(0, cur)) return;
    f32x4 acc[2][2][4][2];
#pragma unroll
    for (int a = 0; a < 2; ++a)
#pragma unroll
        for (int b = 0; b < 2; ++b)
#pragma unroll
            for (int m = 0; m < 4; ++m)
#pragma unroll
                for (int n = 0; n < 2; ++n) acc[a][b][m][n] = (f32x4){0.f, 0.f, 0.f, 0.f};
    bf16x8 At[4][2], B0[2][2], B1[2][2];
    const char* cA = (const char*)gA + (size_t)cur.arow * K * 2; const char* cB = (const char*)gBt + (size_t)cur.brow * K * 2;
    if constexpr (GATHER) { PG8_GATHER_OFFS(aoC, cur); }
    PG8_STAGE(PG8_SB(0, 0), cB, voffB); PG8_STAGE(PG8_SB(0, 1), cB + hstep, voffB); PG8_STAGE_A(PG8_SA(0, 0), cA, 0, 0, false); PG8_STAGE_A(PG8_SA(0, 1), cA, 1, 0, false);
    if (wr == 1) PG8_BAR;
    PG8_WAIT_V(2); PG8_BAR;
    PG8_STAGE(PG8_SB(1, 0), cB + kstep, voffB); PG8_STAGE_A(PG8_SA(1, 0), cA + kstep, 0, kstep, false); PG8_STAGE(PG8_SB(1, 1), cB + hstep + kstep, voffB);
    PG8_WAIT_V(6); PG8_BAR;
    for (;;) {
        const bool has_next = S.next(ui + 1, nxt);
        const char* nA = has_next ? (const char*)gA + (size_t)nxt.arow * K * 2 : cA; const char* nB = has_next ? (const char*)gBt + (size_t)nxt.brow * K * 2 : cB;
        if constexpr (GATHER) { if (has_next) { PG8_GATHER_OFFS(aoN, nxt); } }
        for (int t = 0; t < nt; t += 2) {
            const bool last = (t == nt - 2);
            const bool nx = last && has_next;
            const char* a1 = cA + (size_t)(t + 1) * kstep;
            const char* a2 = last ? nA : cA + (size_t)(t + 2) * kstep; const char* b2 = last ? nB : cB + (size_t)(t + 2) * kstep;
            const char* a3 = a2 + kstep; const char* b3 = b2 + kstep;
            const size_t k1 = (size_t)(t + 1) * kstep, k2 = last ? 0 : (size_t)(t + 2) * kstep, k3 = k2 + kstep;
            PG8_LDB(B0, 0, 0); PG8_LDB(B1, 0, 1); PG8_SCHED; PG8_LDA(At, 0, 0); PG8_STAGE_A(PG8_SA(1, 1), a1, 1, k1, false);
            PG8_WAIT_V(8); PG8_WAIT_L(0); PG8_BAR; PG8_MMA(0, 0, At, B0); PG8_MMA(0, 1, At, B1); PG8_BAR; PG8_SCHED;
            PG8_LDA(At, 0, 1); PG8_STAGE(PG8_SB(0, 0), b2, voffB); PG8_STAGE(PG8_SB(0, 1), b2 + hstep, voffB); PG8_STAGE_A(PG8_SA(0, 0), a2, 0, k2, nx);
            PG8_WAIT_V(8); PG8_WAIT_L(0); PG8_BAR; PG8_MMA(1, 0, At, B0); PG8_MMA(1, 1, At, B1); PG8_BAR; PG8_SCHED;
            PG8_LDB(B0, 1, 0); PG8_LDB(B1, 1, 1); PG8_SCHED; PG8_LDA(At, 1, 0); PG8_STAGE_A(PG8_SA(0, 1), a2, 1, k2, nx);
            PG8_WAIT_V(8); PG8_WAIT_L(0); PG8_BAR; PG8_MMA(0, 0, At, B0); PG8_MMA(0, 1, At, B1); PG8_BAR; PG8_SCHED;
            PG8_LDA(At, 1, 1); PG8_STAGE(PG8_SB(1, 0), b3, voffB); PG8_STAGE(PG8_SB(1, 1), b3 + hstep, voffB); PG8_STAGE_A(PG8_SA(1, 0), a3, 0, k3, nx);
            PG8_WAIT_V(8); PG8_WAIT_L(0); PG8_BAR; PG8_MMA(1, 0, At, B0); PG8_MMA(1, 1, At, B1); PG8_BAR; PG8_SCHED;
        }
        if (wr == 0) PG8_BAR;
        E(acc, cur, wr, wc, fr, fq);
        if (!has_next) break;
#pragma unroll
        for (int a = 0; a < 2; ++a)
#pragma unroll
            for (int b = 0; b < 2; ++b)
#pragma unroll
                for (int m = 0; m < 4; ++m)
#pragma unroll
                    for (int n = 0; n < 2; ++n) acc[a][b][m][n] = (f32x4){0.f, 0.f, 0.f, 0.f};
        cur = nxt; cA = nA; cB = nB; ++ui;
        if constexpr (GATHER) { _Pragma("unroll") for (int h_ = 0; h_ < 2; ++h_) _Pragma("unroll") for (int i_ = 0; i_ < 2; ++i_) aoC[h_][i_] = aoN[h_][i_]; }
        if (wr == 1) PG8_BAR;
    }
    PG8_WAIT_V(0);
    PG8_BAR;
#undef PG8_SA
#undef PG8_SB
#undef PG8_STAGE
#undef PG8_STAGE_A
#undef PG8_GATHER_OFFS
#undef PG8_LDA
#undef PG8_LDB
#undef PG8_MMA
#undef PG8_BAR
#undef PG8_SCHED
}

struct EpiStore {
    static constexpr bool PERM = true;
    bf16_t* C; int ldc;
    __device__ __forceinline__ void operator()(const f32x4 (&acc)[2][2][4][2], const Unit& u, int wr, int wc, int fr, int fq) const {
#pragma unroll
        for (int ai = 0; ai < 2; ++ai)
#pragma unroll
            for (int m = 0; m < 4; ++m) {
                bf16_t* rowp = C + (long)(u.arow + ai * HALF + wr * 64 + m * 16 + fr) * ldc + u.pn * BM + wc * 32 + 8 * fq;
#pragma unroll
                for (int bj = 0; bj < 2; ++bj) { const f32x4 v0 = acc[ai][bj][m][0], v1 = acc[ai][bj][m][1];
                    *(u32x4*)(rowp + bj * HALF) = (u32x4){pack2(v0[0], v0[1]), pack2(v0[2], v0[3]), pack2(v1[0], v1[1]), pack2(v1[2], v1[3])}; }
            }
    }
};
struct EpiGlu {
    static constexpr bool PERM = true;
    const bf16_t* y; bf16_t* ycat;
    __device__ __forceinline__ void operator()(const f32x4 (&acc)[2][2][4][2], const Unit& u, int wr, int wc, int fr, int fq) const {
#pragma unroll
        for (int ai = 0; ai < 2; ++ai)
#pragma unroll
            for (int m = 0; m < 4; ++m) {
                const long row = u.arow + ai * HALF + wr * 64 + m * 16 + fr;
#pragma unroll
                for (int bj = 0; bj < 2; ++bj) {
                    const int col = u.pn * BM + bj * HALF + wc * 32 + 8 * fq;
                    const u32x4 yy = *(const u32x4*)(y + row * 512 + col);
                    const f32x4 v0 = acc[ai][bj][m][0], v1 = acc[ai][bj][m][1];
                    float o[8];
#pragma unroll
                    for (int e = 0; e < 4; ++e) { o[e] = sigmoidf_(v0[e]); o[4 + e] = sigmoidf_(v1[e]); }
#pragma unroll
                    for (int e = 0; e < 4; ++e) { o[2 * e] *= bf2f((bf16_t)(yy[e] & 0xffff)); o[2 * e + 1] *= bf2f((bf16_t)(yy[e] >> 16)); }
                    *(u32x4*)(ycat + row * 1024 + 512 + col) = (u32x4){pack2(o[0], o[1]), pack2(o[2], o[3]), pack2(o[4], o[5]), pack2(o[6], o[7])};
                }
            }
    }
};
struct EpiMoe1 {
    static constexpr bool PERM = true;
    bf16_t* H;
    __device__ __forceinline__ void operator()(const f32x4 (&acc)[2][2][4][2], const Unit& u, int wr, int wc, int fr, int fq) const {
#pragma unroll
        for (int ai = 0; ai < 2; ++ai)
#pragma unroll
            for (int m = 0; m < 4; ++m) {
                const int rl = ai * HALF + wr * 64 + m * 16 + fr;
                if (rl < u.nvalid) {
                    float o[8];
#pragma unroll
                    for (int n = 0; n < 2; ++n)
#pragma unroll
                        for (int e = 0; e < 4; ++e) o[4 * n + e] = siluf_(acc[ai][0][m][n][e]) * acc[ai][1][m][n][e];
                    *(u32x4*)(H + (long)(u.arow + rl) * EFF + u.pn * HALF + wc * 32 + 8 * fq) = (u32x4){pack2(o[0], o[1]), pack2(o[2], o[3]), pack2(o[4], o[5]), pack2(o[6], o[7])};
                }
            }
    }
};
struct EpiMoe2 {
    static constexpr bool PERM = true;
    bf16_t* Y; const float* gate;
    __device__ __forceinline__ void operator()(const f32x4 (&acc)[2][2][4][2], const Unit& u, int wr, int wc, int fr, int fq) const {
#pragma unroll
        for (int ai = 0; ai < 2; ++ai)
#pragma unroll
            for (int m = 0; m < 4; ++m) {
                const int rl = ai * HALF + wr * 64 + m * 16 + fr;
                if (rl < u.nvalid) {
                    const float g = gate[u.lrow + rl];
                    bf16_t* rowp = Y + (long)(u.arow + rl) * DM + u.pn * BM + wc * 32 + 8 * fq;
#pragma unroll
                    for (int bj = 0; bj < 2; ++bj) { const f32x4 v0 = acc[ai][bj][m][0] * g, v1 = acc[ai][bj][m][1] * g;
                        *(u32x4*)(rowp + bj * HALF) = (u32x4){pack2(v0[0], v0[1]), pack2(v0[2], v0[3]), pack2(v1[0], v1[1]), pack2(v1[2], v1[3])}; }
                }
            }
    }
};
}

template <class Epi>
__device__ __forceinline__ void gemm_dense(const bf16_t* A, const bf16_t* Bt, int M, int N, int K, const Epi& E) {
    pg8::DenseOrder S; S.init(M, N, (int)gridDim.x, (int)blockIdx.x);
    pg8::gemm_phase<Epi, pg8::DenseOrder>((PG8_LAS unsigned char*)LDS_BASE(), A, Bt, K, S, E);
}

__device__ __forceinline__ void phase_ba(const Params& p) {
    float* wl = (float*)LDS_BASE();
    {
        float v_[16];
#pragma unroll
        for (int j = 0; j < 16; ++j) { const int i = TID() + NTHREADS * j; v_[j] = p.w_in[(long)(i >> 3) * 2568 + 2048 + (i & 7)]; }
#pragma unroll
        for (int j = 0; j < 16; ++j) { const int i = TID() + NTHREADS * j; wl[(i & 7) * 1024 + (i >> 3)] = v_[j]; }
    }
    __syncthreads();
    const int lane = TID() & 63, gw = blockIdx.x * NW + (TID() >> 6), nw = gridDim.x * NW;
    constexpr int TPI = 4;
    for (int grp = gw; grp < NT / TPI; grp += nw) {
        const long tok0 = (long)grp * TPI;
        f32x4 xv[TPI][4];
#pragma unroll
        for (int tt = 0; tt < TPI; ++tt)
#pragma unroll
            for (int i = 0; i < 4; ++i) xv[tt][i] = *(const f32x4*)(p.x + (tok0 + tt) * DM + 4 * lane + 256 * i);
#pragma unroll
        for (int tt = 0; tt < TPI; ++tt)
#pragma unroll
            for (int i = 0; i < 4; ++i) *(u32x2*)(p.hb + (tok0 + tt) * DM + 4 * lane + 256 * i) = (u32x2){pack2(xv[tt][i][0], xv[tt][i][1]), pack2(xv[tt][i][2], xv[tt][i][3])};
        float acc[TPI][8];
#pragma unroll
        for (int tt = 0; tt < TPI; ++tt)
#pragma unroll
            for (int n = 0; n < 8; ++n) acc[tt][n] = 0.f;
#pragma unroll
        for (int i = 0; i < 4; ++i)
#pragma unroll
            for (int n = 0; n < 8; ++n) {
                const f32x4 wv = *(const f32x4*)(wl + n * 1024 + 4 * lane + 256 * i);
#pragma unroll
                for (int tt = 0; tt < TPI; ++tt) acc[tt][n] += (xv[tt][i][0] * wv[0] + xv[tt][i][1] * wv[1]) + (xv[tt][i][2] * wv[2] + xv[tt][i][3] * wv[3]);
            }
#pragma unroll
        for (int o = 32; o > 0; o >>= 1)
#pragma unroll
            for (int tt = 0; tt < TPI; ++tt)
#pragma unroll
                for (int n = 0; n < 8; ++n) acc[tt][n] += __shfl_xor(acc[tt][n], o);
        if (lane < 4) {
#pragma unroll
            for (int tt = 0; tt < TPI; ++tt) {
                const float bl = lane == 0 ? acc[tt][0] : lane == 1 ? acc[tt][1] : lane == 2 ? acc[tt][2] : acc[tt][3];
                const float al = lane == 0 ? acc[tt][4] : lane == 1 ? acc[tt][5] : lane == 2 ? acc[tt][6] : acc[tt][7];
                const float xx = al + p.dt_bias[lane];
                const float sp = xx > 20.f ? xx : log1pf(expf(xx));
                p.gbeta[(tok0 + tt) * 4 + lane] = 1.0f / (1.0f + expf(-bl));
                p.gg[(tok0 + tt) * 4 + lane] = -expf(p.a_log[lane]) * sp;
            }
        }
    }
}

__device__ __forceinline__ void phase_gdn_prep(const Params& p) {
    const int t = TID(), lane = t & 63, w = t >> 6;
    constexpr int RUN = 16;
    const int nitems = (NT / RUN) * 3;
    for (int item = (int)blockIdx.x * NW + w; item < nitems; item += (int)gridDim.x * NW) {
        const int i = item % 3, run = item / 3;
        const long tok0 = (long)run * RUN; const int s0 = (int)(tok0 % NS_);
        const int cb = i * 512 + lane * 8;
        u32x4 x[RUN + 3];
#pragma unroll
        for (int j = 0; j < 3; ++j) x[j] = s0 > 0 ? *(const u32x4*)(p.proj + (tok0 - 3 + j) * PROJ_LD + cb) : (u32x4){0u, 0u, 0u, 0u};
#pragma unroll
        for (int k = 0; k < RUN; ++k) x[3 + k] = *(const u32x4*)(p.proj + (tok0 + k) * PROJ_LD + cb);
        f32x4 wv[4][2];
#pragma unroll
        for (int j = 0; j < 4; ++j) { wv[j][0] = *(const f32x4*)(p.conv + j * 1536 + cb); wv[j][1] = *(const f32x4*)(p.conv + j * 1536 + cb + 4); }
        bf16_t* dst = (i == 0 ? p.gq : i == 1 ? p.gk : p.gv) + tok0 * 512 + lane * 8;
#pragma unroll
        for (int k = 0; k < RUN; ++k) {
            float a[8];
#pragma unroll
            for (int e = 0; e < 8; ++e) a[e] = 0.f;
#pragma unroll
            for (int j = 0; j < 4; ++j) {
                const u32x4 xv = x[k + j];
                a[0] += wv[j][0][0] * bf2f((bf16_t)(xv[0] & 0xffff)); a[1] += wv[j][0][1] * bf2f((bf16_t)(xv[0] >> 16));
                a[2] += wv[j][0][2] * bf2f((bf16_t)(xv[1] & 0xffff)); a[3] += wv[j][0][3] * bf2f((bf16_t)(xv[1] >> 16));
                a[4] += wv[j][1][0] * bf2f((bf16_t)(xv[2] & 0xffff)); a[5] += wv[j][1][1] * bf2f((bf16_t)(xv[2] >> 16));
                a[6] += wv[j][1][2] * bf2f((bf16_t)(xv[3] & 0xffff)); a[7] += wv[j][1][3] * bf2f((bf16_t)(xv[3] >> 16));
            }
            float ss = 0.f;
#pragma unroll
            for (int e = 0; e < 8; ++e) { a[e] = siluf_(a[e]); ss += a[e] * a[e]; }
            if (i < 2) {
                ss += __shfl_xor(ss, 1); ss += __shfl_xor(ss, 2); ss += __shfl_xor(ss, 4); ss += __shfl_xor(ss, 8);
                const float sc = rsqrtf(ss + 1e-6f);
#pragma unroll
                for (int e = 0; e < 8; ++e) a[e] *= sc;
            }
            *(u32x4*)(dst + (long)k * 512) = (u32x4){pack2(a[0], a[1]), pack2(a[2], a[3]), pack2(a[4], a[5]), pack2(a[6], a[7])};
        }
    }
}

#ifndef FUSE_PREP
#define FUSE_PREP 1
#endif
constexpr int CLD = 136;
__device__ __forceinline__ void phase_gdn_chunk(const Params& p) {
    const int half = TID() >> 8;
    char* lds = LDS_BASE() + half * 70656;
    float* gc = (float*)lds; float* be = gc + 64; float* eg = be + 64; float* ek = eg + 64; float* bek = ek + 64;
    float* Ls = (float*)(lds + 1280);
    bf16_t* vs = (bf16_t*)(lds + 1280 + 16384); bf16_t* ks = vs + 64 * CLD; bf16_t* qs = ks + 64 * CLD;
    const int t = TID() & 255, lane = t & 63, w = t >> 6, fr = lane & 15, fq = lane >> 4;
    const int nunits = NB_ * 4 * NCH;
    for (int up = blockIdx.x; up * 2 < nunits; up += gridDim.x) {
        const int u = up * 2 + half;
        const int n = u % NCH, hh = (u / NCH) & 3, b = u / (NCH * 4);
        const long tok0 = (long)b * NS_ + n * 64;
        LDS_BARRIER();
#if FUSE_PREP
        {
            const int rg = t >> 4, ch = (t & 15) * 8;
            const int s0 = n * 64 + 4 * rg;
#pragma unroll
            for (int X = 0; X < 3; ++X) {
                const int col = X * 512 + hh * 128 + ch;
                u32x4 x[7];
#pragma unroll
                for (int j = 0; j < 7; ++j) x[j] = (s0 - 3 + j) >= 0 ? *(const u32x4*)(p.proj + (tok0 + 4 * rg - 3 + j) * PROJ_LD + col) : (u32x4){0u, 0u, 0u, 0u};
                f32x4 wv[4][2];
#pragma unroll
                for (int j = 0; j < 4; ++j) { wv[j][0] = *(const f32x4*)(p.conv + j * 1536 + col); wv[j][1] = *(const f32x4*)(p.conv + j * 1536 + col + 4); }
                bf16_t* dl = X == 0 ? qs : X == 1 ? ks : vs;
#pragma unroll
                for (int i = 0; i < 4; ++i) {
                    float a[8];
#pragma unroll
                    for (int e = 0; e < 8; ++e) a[e] = 0.f;
#pragma unroll
                    for (int j = 0; j < 4; ++j) {
                        const u32x4 xv = x[i + j];
                        a[0] += wv[j][0][0] * bf2f((bf16_t)(xv[0] & 0xffff)); a[1] += wv[j][0][1] * bf2f((bf16_t)(xv[0] >> 16));
                        a[2] += wv[j][0][2] * bf2f((bf16_t)(xv[1] & 0xffff)); a[3] += wv[j][0][3] * bf2f((bf16_t)(xv[1] >> 16));
                        a[4] += wv[j][1][0] * bf2f((bf16_t)(xv[2] & 0xffff)); a[5] += wv[j][1][1] * bf2f((bf16_t)(xv[2] >> 16));
                        a[6] += wv[j][1][2] * bf2f((bf16_t)(xv[3] & 0xffff)); a[7] += wv[j][1][3] * bf2f((bf16_t)(xv[3] >> 16));
                    }
                    float ss = 0.f;
#pragma unroll
                    for (int e = 0; e < 8; ++e) { a[e] = siluf_(a[e]); ss += a[e] * a[e]; }
                    if (X < 2) {
                        ss += __shfl_xor(ss, 1); ss += __shfl_xor(ss, 2); ss += __shfl_xor(ss, 4); ss += __shfl_xor(ss, 8);
                        const float sc = rsqrtf(ss + 1e-6f);
#pragma unroll
                        for (int e = 0; e < 8; ++e) a[e] *= sc;
                    }
                    *(u32x4*)(dl + (4 * rg + i) * CLD + ch) = (u32x4){pack2(a[0], a[1]), pack2(a[2], a[3]), pack2(a[4], a[5]), pack2(a[6], a[7])};
                }
            }
        }
#else
#pragma unroll
        for (int i = 0; i < 4; ++i) {
            const int c = t + 256 * i, row = c >> 4, ch = (c & 15) * 8;
            const long go_ = (tok0 + row) * 512 + hh * 128 + ch;
            *(u32x4*)(qs + row * CLD + ch) = *(const u32x4*)(p.gq + go_);
            *(u32x4*)(ks + row * CLD + ch) = *(const u32x4*)(p.gk + go_);
            *(u32x4*)(vs + row * CLD + ch) = *(const u32x4*)(p.gv + go_);
        }
#endif
        if (w == 0) {
            float v = p.gg[(tok0 + lane) * 4 + hh];
#pragma unroll
            for (int o = 1; o < 64; o <<= 1) { const float nb = __shfl_up(v, o); if (lane >= o) v += nb; }
            const float gl = __shfl(v, 63);
            const float bt = p.gbeta[(tok0 + lane) * 4 + hh];
            gc[lane] = v; be[lane] = bt; eg[lane] = expf(v); ek[lane] = expf(gl - v); bek[lane] = bt * expf(v);
            if (lane == 0) WT_STORE_F(p.cgl + u, expf(gl));
        }
        LDS_BARRIER();
        {
            f32x4 akk[4], aqk[4];
#pragma unroll
            for (int nn = 0; nn < 4; ++nn) { akk[nn] = (f32x4){0.f, 0.f, 0.f, 0.f}; aqk[nn] = (f32x4){0.f, 0.f, 0.f, 0.f}; }
#pragma unroll
            for (int k4 = 0; k4 < 4; ++k4) {
                const bf16x8 afk = *(const bf16x8*)(ks + (16 * w + fr) * CLD + k4 * 32 + fq * 8);
                const bf16x8 afq = *(const bf16x8*)(qs + (16 * w + fr) * CLD + k4 * 32 + fq * 8);
#pragma unroll
                for (int nn = 0; nn < 4; ++nn) {
                    const bf16x8 bfr = *(const bf16x8*)(ks + (16 * nn + fr) * CLD + k4 * 32 + fq * 8);
                    akk[nn] = __builtin_amdgcn_mfma_f32_16x16x32_bf16(bfr, afk, akk[nn], 0, 0, 0);
                    aqk[nn] = __builtin_amdgcn_mfma_f32_16x16x32_bf16(bfr, afq, aqk[nn], 0, 0, 0);
                }
            }
            const int i = 16 * w + fr; const float gci = gc[i], bei = be[i];
#pragma unroll
            for (int nn = 0; nn < 4; ++nn) {
                const int j0 = 16 * nn + 4 * fq;
                f32x4 lv; float qv[4];
#pragma unroll
                for (int r = 0; r < 4; ++r) {
                    const int j = j0 + r;
                    const float dec = i >= j ? expf(gci - gc[j]) : 0.f;
                    lv[r] = i > j ? bei * akk[nn][r] * dec : 0.f;
                    qv[r] = 0.08838834764831845f * aqk[nn][r] * dec;
                }
                *(f32x4*)(Ls + i * 64 + j0) = lv;
                *(u32x2*)(p.cQK + (long)u * 8192 + i * 64 + j0) = (u32x2){pack2(qv[0], qv[1]), pack2(qv[2], qv[3])};
            }
        }
        LDS_BARRIER();
        {
            const int c = t & 127; const bf16_t* src = t < 128 ? vs : ks; const float* mulp = t < 128 ? be : bek;
            float x[64];
#pragma unroll
            for (int i = 0; i < 64; ++i) {
                float a = mulp[i] * bf2f(src[i * CLD + c]);
#pragma unroll
                for (int j4 = 0; j4 < (i + 3) / 4; ++j4) {
                    const f32x4 l4 = *(const f32x4*)(Ls + i * 64 + 4 * j4);
                    if (4 * j4 + 0 < i) a = fmaf(-l4[0], x[4 * j4 + 0], a);
                    if (4 * j4 + 1 < i) a = fmaf(-l4[1], x[4 * j4 + 1], a);
                    if (4 * j4 + 2 < i) a = fmaf(-l4[2], x[4 * j4 + 2], a);
                    if (4 * j4 + 3 < i) a = fmaf(-l4[3], x[4 * j4 + 3], a);
                }
                x[i] = a;
                asm volatile("" ::: "memory");
            }
            LDS_BARRIER();
            bf16_t* Wt = (bf16_t*)Ls;
            if (t < 128) {
#pragma unroll
                for (int i = 0; i < 64; ++i) vs[i * CLD + c] = f2bf(x[i]);
            } else {
#pragma unroll
                for (int i = 0; i < 64; ++i) Wt[i * 128 + c] = f2bf(x[i]);
            }
        }
        LDS_BARRIER();
#pragma unroll
        for (int e = 0; e < 4; ++e) {
            const int id = t + 256 * e, row = id >> 4, ch = (id & 15) * 8;
            *(u32x4*)(p.cU + (long)u * 8192 + row * 128 + ch) = *(const u32x4*)(vs + row * CLD + ch);
            *(u32x4*)(p.cW + (long)u * 8192 + row * 128 + ch) = *(const u32x4*)((const bf16_t*)Ls + row * 128 + ch);
            {
                const u32x4 qv = *(const u32x4*)(qs + row * CLD + ch); const float sc = 0.08838834764831845f * eg[row];
                unsigned o4[4];
#pragma unroll
                for (int k = 0; k < 4; ++k) o4[k] = pack2(bf2f((bf16_t)(qv[k] & 0xffff)) * sc, bf2f((bf16_t)(qv[k] >> 16)) * sc);
                *(u32x4*)(p.cQd + (long)u * 8192 + row * 128 + ch) = (u32x4){o4[0], o4[1], o4[2], o4[3]};
            }
            {
                const int d = id >> 3, i0 = (id & 7) * 8;
                float kv[8];
#pragma unroll
                for (int k = 0; k < 8; ++k) kv[k] = bf2f(ks[(i0 + k) * CLD + d]) * ek[i0 + k];
                *(u32x4*)(p.cKdT + (long)u * 8192 + d * 64 + i0) = (u32x4){pack2(kv[0], kv[1]), pack2(kv[2], kv[3]), pack2(kv[4], kv[5]), pack2(kv[6], kv[7])};
            }
        }
    }
}

#define GO_STORE(ptr, lo, hi) (*(u32x2*)(ptr) = (u32x2){(lo), (hi)})
#ifndef SCAN_XCD_REMAP
#define SCAN_XCD_REMAP 1
#endif
struct ScanOwn { bf16x8 f[7]; u32x2 uvr; };
__device__ __forceinline__ const bf16_t* scan_slot_ptr(const Params& p, int s, int w, int fr, int fq) {
    if (s < 4) return p.cW + (16 * w + fr) * 128 + s * 32 + fq * 8;
    if (s < 8) return p.cQd + (16 * w + fr) * 128 + (s - 4) * 32 + fq * 8;
    if (s < 12) return p.cKdT + (32 * w + 16 * ((s - 8) >> 1) + fr) * 64 + ((s - 8) & 1) * 32 + fq * 8;
    return p.cQK + (16 * w + fr) * 64 + (s - 12) * 32 + fq * 8;
}
#define SCAN_LOAD(P, cu_) do { const long co_ = (long)(cu_) * 8192; \
        _Pragma("unroll") for (int j = 0; j < 7; ++j) P.f[j] = *(const bf16x8*)(sp[j] + co_); \
        P.uvr = *(const u32x2*)(up + co_); } while (0)
#define SCAN_STEP(Pw, n_) do { \
        const long cu_ = cu0 + (n_); const long tokr = (long)b * NS_ + (n_) * 64 + 16 * w + fr; \
        bf16x8 sb[4]; \
        _Pragma("unroll") for (int k4 = 0; k4 < 4; ++k4) sb[k4] = *(const bf16x8*)(SbT + fr * CLD + k4 * 32 + fq * 8); \
        f32x4 vw = (f32x4){0.f, 0.f, 0.f, 0.f}, o = (f32x4){0.f, 0.f, 0.f, 0.f}; \
        _Pragma("unroll") for (int k4 = 0; k4 < 4; ++k4) { vw = __builtin_amdgcn_mfma_f32_16x16x32_bf16(sb[k4], F[k4], vw, 0, 0, 0); o = __builtin_amdgcn_mfma_f32_16x16x32_bf16(sb[k4], F[4 + k4], o, 0, 0, 0); } \
          \
        { const u32x2 uvc = *(const u32x2*)ub; const unsigned u0_ = uvc[0], u1_ = uvc[1]; \
          VnT[(4 * fq + 0) * 72 + 16 * w + fr] = f2bf(bf2f((bf16_t)(u0_ & 0xffff)) - vw[0]); VnT[(4 * fq + 1) * 72 + 16 * w + fr] = f2bf(bf2f((bf16_t)(u0_ >> 16)) - vw[1]); \
          VnT[(4 * fq + 2) * 72 + 16 * w + fr] = f2bf(bf2f((bf16_t)(u1_ & 0xffff)) - vw[2]); VnT[(4 * fq + 3) * 72 + 16 * w + fr] = f2bf(bf2f((bf16_t)(u1_ >> 16)) - vw[3]); } \
        LDS_BARRIER(); \
        _Pragma("unroll") for (int j = 0; j < 7; ++j) *(bf16x8*)(xw + j * 512) = Pw.f[j];                   \
        *(u32x2*)ub = Pw.uvr;                                                                                \
        const float glc = glbuf[(n_)]; \
        bf16x8 vb[2]; \
        _Pragma("unroll") for (int k2 = 0; k2 < 2; ++k2) vb[k2] = *(const bf16x8*)(VnT + fr * 72 + k2 * 32 + fq * 8); \
        _Pragma("unroll") for (int k2 = 0; k2 < 2; ++k2) o = __builtin_amdgcn_mfma_f32_16x16x32_bf16(vb[k2], F[12 + k2], o, 0, 0, 0); \
        GO_STORE((p.go + tokr * 512 + hh * 128 + vsl * 16 + 4 * fq), pack2(o[0], o[1]), pack2(o[2], o[3])); \
        _Pragma("unroll") for (int m = 0; m < 2; ++m) { \
            sacc[m] = sacc[m] * glc; \
            _Pragma("unroll") for (int k2 = 0; k2 < 2; ++k2) sacc[m] = __builtin_amdgcn_mfma_f32_16x16x32_bf16(F[8 + 2 * m + k2], vb[k2], sacc[m], 0, 0, 0); \
            *(u32x2*)(SbT + fr * CLD + 32 * w + 16 * m + 4 * fq) = (u32x2){pack2(sacc[m][0], sacc[m][1]), pack2(sacc[m][2], sacc[m][3])}; \
        } \
        LDS_BARRIER(); \
        _Pragma("unroll") for (int k = 0; k < 14; ++k) F[k] = *(const bf16x8*)(xr + k * 512);                \
        { const long c3_ = cu_ + 3 < culast ? cu_ + 3 : culast; SCAN_LOAD(Pw, c3_); } \
    } while (0)
#ifdef EMU
#define PIN2(a, b) do { } while (0)
#else
#define PIN2(a, b) asm volatile("" : "+v"(a), "+v"(b))
#endif
__device__ __forceinline__ void phase_gdn_scan(const Params& p, int nblk) {
    const int half = TID() >> 8;
    bf16_t* SbT = (bf16_t*)(LDS_BASE() + half * 8192);
    bf16_t* VnT = SbT + 16 * CLD;
    const int t = TID() & 255, lane = t & 63, w = t >> 6, fr = lane & 15, fq = lane >> 4;
    bf16_t* xbuf = (bf16_t*)(LDS_BASE() + 16384) + w * (14 * 512);
    bf16_t* xw = xbuf + half * (7 * 512) + lane * 8; const bf16_t* xr = xbuf + lane * 8;
    unsigned* ub = (unsigned*)(LDS_BASE() + 16384 + 4 * 14336) + ((half * 4 + w) * 64 + lane) * 2;
    float* glbuf = (float*)(LDS_BASE() + 16384 + 4 * 14336 + 4096);
    const int nunits = NB_ * 4 * 8;
    for (int x = blockIdx.x; x * 2 < nunits; x += nblk) {
        int up_ = x;
        if (SCAN_XCD_REMAP && (nblk & 31) == 0 && (nunits & 63) == 0) { const int xcd = x & 7, slot = x >> 3; up_ = 4 * ((slot >> 2) * 8 + xcd) + (slot & 3); }
        const int u = up_ * 2 + half;
        const int vsl = u & 7, hh = (u >> 3) & 3, b = u >> 5;
        const long cu0 = (long)(b * 4 + hh) * NCH, culast = cu0 + NCH - 1;
        const bf16_t* sp[7];
#pragma unroll
        for (int j = 0; j < 7; ++j) { const bf16_t* p0 = scan_slot_ptr(p, j, w, fr, fq); const bf16_t* p1 = scan_slot_ptr(p, 7 + j, w, fr, fq); sp[j] = half ? p1 : p0; }
        const bf16_t* up = p.cU + (16 * w + fr) * 128 + vsl * 16 + 4 * fq;
        LDS_BARRIER();
        for (int i = t; i < 16 * CLD; i += 256) SbT[i] = 0;
        f32x4 sacc[2] = {(f32x4){0.f, 0.f, 0.f, 0.f}, (f32x4){0.f, 0.f, 0.f, 0.f}};
        ScanOwn PA, PB; bf16x8 F[14];
        for (int i = TID(); i < NCH; i += NTHREADS) glbuf[i] = p.cgl[cu0 + i];
        SCAN_LOAD(PA, cu0); { const long c1_ = cu0 + 1 < culast ? cu0 + 1 : culast; SCAN_LOAD(PB, c1_); }
#pragma unroll
        for (int j = 0; j < 7; ++j) *(bf16x8*)(xw + j * 512) = PA.f[j];
        *(u32x2*)ub = PA.uvr;
        LDS_BARRIER();
#pragma unroll
        for (int k = 0; k < 14; ++k) F[k] = *(const bf16x8*)(xr + k * 512);
        { const long c2_ = cu0 + 2 < culast ? cu0 + 2 : culast; SCAN_LOAD(PA, c2_); }
        int n = 0;
#pragma unroll 1
        for (; n + 2 <= NCH; n += 2) {
            SCAN_STEP(PB, n);
            SCAN_STEP(PA, n + 1);
        }
    }
}
#undef SCAN_STEP
#undef SCAN_LOAD

__device__ __forceinline__ void phase_gdn_post(const Params& p) {
    const int lane = TID() & 63; const int gw = blockIdx.x * NW + (TID() >> 6), nw = gridDim.x * NW;
    const f32x4 nw0 = *(const f32x4*)(p.gnorm + (lane & 15) * 8), nw1 = *(const f32x4*)(p.gnorm + (lane & 15) * 8 + 4);
    for (int g8 = gw; g8 < NT / 8; g8 += nw) {
        const long tok0 = (long)g8 * 8;
        u32x4 ov[8], zv[8];
#pragma unroll
        for (int k = 0; k < 8; ++k) { ov[k] = *(const u32x4*)(p.go + (tok0 + k) * 512 + lane * 8); zv[k] = *(const u32x4*)(p.proj + (tok0 + k) * PROJ_LD + 1536 + lane * 8); }
#pragma unroll
        for (int k = 0; k < 8; ++k) {
            float o[8], z[8];
#pragma unroll
            for (int e = 0; e < 4; ++e) { o[2 * e] = bf2f((bf16_t)(ov[k][e] & 0xffff)); o[2 * e + 1] = bf2f((bf16_t)(ov[k][e] >> 16)); z[2 * e] = bf2f((bf16_t)(zv[k][e] & 0xffff)); z[2 * e + 1] = bf2f((bf16_t)(zv[k][e] >> 16)); }
            float ss = 0.f;
#pragma unroll
            for (int e = 0; e < 8; ++e) ss += o[e] * o[e];
            ss += __shfl_xor(ss, 1); ss += __shfl_xor(ss, 2); ss += __shfl_xor(ss, 4); ss += __shfl_xor(ss, 8);
            const float rs = rsqrtf(ss * (1.0f / 128.0f) + 1e-6f);
            float r[8];
#pragma unroll
            for (int e = 0; e < 4; ++e) { r[e] = o[e] * rs * nw0[e] * siluf_(z[e]); r[4 + e] = o[4 + e] * rs * nw1[e] * siluf_(z[4 + e]); }
            *(u32x4*)(p.ycat + (tok0 + k) * 1024 + lane * 8) = (u32x4){pack2(r[0], r[1]), pack2(r[2], r[3]), pack2(r[4], r[5]), pack2(r[6], r[7])};
        }
    }
}

__device__ __forceinline__ float gelu_tanh(float x) { return 0.5f * x * (1.0f + tanhf(0.7978845608028654f * (x + 0.044715f * x * x * x))); }
#ifndef S5_CARRY
#define S5_CARRY 1
#endif
#ifdef EMU
#define CARRY_PIN(a, b) do { } while (0)
#else
#define CARRY_PIN(a, b) asm volatile("" : "+v"(a), "+v"(b))
#endif
#define WAVE_SYNC() LDS_BARRIER()
constexpr int S5_NSEG1 = NCH >= 16 ? 8 : NCH / 2, S5_NSEG2 = NCH >= 8 ? 4 : NCH / 2;
struct S5Task { bf16x8 bfm[8]; bf16x8 cf[4]; float ar, ai; f32x4 dsk; };
struct S5In { bf16x8 uf[4]; u32x2 uu[4]; };
template <int PASS>
__device__ __forceinline__ void s5_task_init(const Params& p, S5Task& T, int g, int lane, int fr, int fq) {
    bf16x8 zf;
#pragma unroll
    for (int e = 0; e < 8; ++e) zf[e] = 0;
#pragma unroll
    for (int nt = 0; nt < 8; ++nt) T.bfm[nt] = fq < 2 ? *(const bf16x8*)(p.s5bbm + ((long)g * 128 + 16 * nt + fr) * 16 + 8 * fq) : zf;
    if (PASS == 2) {
#pragma unroll
        for (int k4 = 0; k4 < 4; ++k4) T.cf[k4] = *(const bf16x8*)(p.s5cm + (g * 16 + fr) * 128 + k4 * 32 + fq * 8);
        T.dsk = *(const f32x4*)(p.s5d + g * 16 + 4 * fq);
    }
    T.ar = p.s5a[(g * 64 + lane) * 2]; T.ai = p.s5a[(g * 64 + lane) * 2 + 1];
}
template <int PASS>
__device__ __forceinline__ void s5_load(const Params& p, S5In& I, int g, long tok0, int fr, int fq) {
    bf16x8 zf;
#pragma unroll
    for (int e = 0; e < 8; ++e) zf[e] = 0;
#pragma unroll
    for (int mt = 0; mt < 4; ++mt) I.uf[mt] = fq < 2 ? *(const bf16x8*)(p.proj + (tok0 + 16 * mt + fr) * PROJ_LD + 2048 + g * 16 + 8 * fq) : zf;
    if (PASS == 2) {
#pragma unroll
        for (int mt = 0; mt < 4; ++mt) I.uu[mt] = *(const u32x2*)(p.proj + (tok0 + 16 * mt + fr) * PROJ_LD + 2048 + g * 16 + 4 * fq);
    }
}
template <int PASS>
__device__ __forceinline__ void s5_unit(const Params& p, bf16_t* hs, const S5Task& T, const S5In& I, int g, long tok0, float& hr, float& hi, int lane, int fr, int fq) {
#pragma unroll
    for (int nt = 0; nt < 8; ++nt)
#pragma unroll
        for (int mt = 0; mt < 4; ++mt) {
            f32x4 d = (f32x4){0.f, 0.f, 0.f, 0.f};
            d = __builtin_amdgcn_mfma_f32_16x16x32_bf16(T.bfm[nt], I.uf[mt], d, 0, 0, 0);
            *(u32x2*)(hs + (16 * mt + fr) * CLD + 16 * nt + 4 * fq) = (u32x2){pack2(d[0], d[1]), pack2(d[2], d[3])};
        }
    WAVE_SYNC();
    const float ar = T.ar, ai = T.ai;
#pragma unroll 8
    for (int j = 0; j < 64; ++j) {
        const float br = bf2f(hs[j * CLD + lane]), bi = bf2f(hs[j * CLD + 64 + lane]);
        const float nr = ar * hr - ai * hi + br, ni = ar * hi + ai * hr + bi;
        hr = nr; hi = ni;
        if (PASS == 2) { hs[j * CLD + lane] = f2bf(hr); hs[j * CLD + 64 + lane] = f2bf(hi); }
    }
    if (PASS == 2) {
        WAVE_SYNC();
        f32x4 acc[4];
#pragma unroll
        for (int mt = 0; mt < 4; ++mt) acc[mt] = (f32x4){0.f, 0.f, 0.f, 0.f};
#pragma unroll
        for (int k4 = 0; k4 < 4; ++k4)
#pragma unroll
            for (int mt = 0; mt < 4; ++mt) {
                const bf16x8 hf = *(const bf16x8*)(hs + (16 * mt + fr) * CLD + k4 * 32 + fq * 8);
                acc[mt] = __builtin_amdgcn_mfma_f32_16x16x32_bf16(T.cf[k4], hf, acc[mt], 0, 0, 0);
            }
#pragma unroll
        for (int mt = 0; mt < 4; ++mt) {
            const int j = 16 * mt + fr;
            const u32x2 uu = I.uu[mt];
            const float y0 = acc[mt][0] + T.dsk[0] * bf2f((bf16_t)(uu[0] & 0xffff)), y1 = acc[mt][1] + T.dsk[1] * bf2f((bf16_t)(uu[0] >> 16));
            const float y2 = acc[mt][2] + T.dsk[2] * bf2f((bf16_t)(uu[1] & 0xffff)), y3 = acc[mt][3] + T.dsk[3] * bf2f((bf16_t)(uu[1] >> 16));
            *(u32x2*)(p.ygelu + (tok0 + j) * 512 + g * 16 + 4 * fq) = (u32x2){pack2(gelu_tanh(y0), gelu_tanh(y1)), pack2(gelu_tanh(y2), gelu_tanh(y3))};
        }
    }
    WAVE_SYNC();
}
template <int PASS>
__device__ __forceinline__ void phase_s5_pass(const Params& p, int blk0) {
    const int t = TID(), lane = t & 63, w = t >> 6, fr = lane & 15, fq = lane >> 4;
    bf16_t* hs = (bf16_t*)(LDS_BASE() + w * (64 * CLD * 2));
    constexpr int S5_NSEG = PASS == 1 ? S5_NSEG1 : S5_NSEG2, S5_CPS = NCH / S5_NSEG;
    const int ntasks = NB_ * 32 * S5_NSEG;
    if ((int)blockIdx.x < blk0) return;
    for (int bt = (int)blockIdx.x - blk0; bt < ntasks / NW; bt += (int)gridDim.x - blk0) {
        const int task = bt * NW + w;
        const int g = task & 31, seg = (task >> 5) % S5_NSEG, b = task / (32 * S5_NSEG);
        S5Task T; s5_task_init<PASS>(p, T, g, lane, fr, fq);
        const int c0 = seg * S5_CPS;
        S5In IA, IB;
        s5_load<PASS>(p, IA, g, ((long)b * NCH + c0) * 64, fr, fq);
        float hr = 0.f, hi = 0.f;
        if (PASS == 2 && S5_CARRY) {
            const float a64r = p.s5a64[(g * 64 + lane) * 2], a64i = p.s5a64[(g * 64 + lane) * 2 + 1];
            const long base = ((long)b * NCH * 32 + g) * 64 + lane;
            constexpr int CG = S5_CPS >= 8 ? 8 : S5_CPS;
#pragma unroll 1
            for (int c8 = 0; c8 < c0; c8 += CG) {
                float lr[CG], li[CG];
#pragma unroll
                for (int k = 0; k < CG; ++k) { lr[k] = p.s5loc[(base + (long)(c8 + k) * 2048) * 2]; li[k] = p.s5loc[(base + (long)(c8 + k) * 2048) * 2 + 1]; }
#pragma unroll
                for (int k = 0; k < CG; ++k) {
                    float nr = fmaf(a64r, hr, lr[k]), ni = fmaf(a64r, hi, li[k]);
                    CARRY_PIN(nr, ni);
                    nr = fmaf(-a64i, hi, nr); ni = fmaf(a64i, hr, ni);
                    CARRY_PIN(nr, ni);
                    hr = nr; hi = ni;
                }
            }
        }
#pragma unroll 1
        for (int c = c0; c < c0 + S5_CPS; c += 2) {
            const long tokA = ((long)b * NCH + c) * 64, tokB = tokA + 64;
            s5_load<PASS>(p, IB, g, tokB, fr, fq);
            if (PASS == 1) { hr = 0.f; hi = 0.f; }
            s5_unit<PASS>(p, hs, T, IA, g, tokA, hr, hi, lane, fr, fq);
            if (PASS == 1) { const long unit = ((long)b * NCH + c) * 32 + g; p.s5loc[(unit * 64 + lane) * 2] = hr; p.s5loc[(unit * 64 + lane) * 2 + 1] = hi; hr = 0.f; hi = 0.f; }
            if (c + 2 < c0 + S5_CPS) s5_load<PASS>(p, IA, g, tokB + 64, fr, fq);
            s5_unit<PASS>(p, hs, T, IB, g, tokB, hr, hi, lane, fr, fq);
            if (PASS == 1) { const long unit = ((long)b * NCH + c + 1) * 32 + g; p.s5loc[(unit * 64 + lane) * 2] = hr; p.s5loc[(unit * 64 + lane) * 2 + 1] = hi; }
        }
    }
}

struct LnrRow { f32x4 xf[4]; u32x2 xh[4]; u32x2 mm[4]; };
template <bool F32IN>
__device__ __forceinline__ void lnr_load(const Params& p, LnrRow& R, const float* hin, const bf16_t* mixp, long tok, int lane) {
#pragma unroll
    for (int i = 0; i < 4; ++i) {
        const int k = 4 * lane + 256 * i;
        if (F32IN) R.xf[i] = *(const f32x4*)(hin + tok * DM + k); else R.xh[i] = *(const u32x2*)(p.hb + tok * DM + k);
        R.mm[i] = *(const u32x2*)(mixp + tok * DM + k);
    }
}
template <bool F32IN>
__device__ __forceinline__ void lnr_process(const Params& p, int layer, const LnrRow& R, const f32x4 (&gv)[4], const f32x4 (&bv)[4], const float* Wr,
                                            int* lcount, int* le, int* lrank, float* lgate, int lt, long tok, int lane, bool dry = false) {
    float h[16];
    float s = 0.f;
#pragma unroll
    for (int i = 0; i < 4; ++i) {
        f32x4 xv;
        if (F32IN) xv = R.xf[i];
        else { const u32x2 xx = R.xh[i]; xv = (f32x4){bf2f((bf16_t)(xx[0] & 0xffff)), bf2f((bf16_t)(xx[0] >> 16)), bf2f((bf16_t)(xx[1] & 0xffff)), bf2f((bf16_t)(xx[1] >> 16))}; }
        const u32x2 mm = R.mm[i];
        h[4 * i + 0] = ALPHA * xv[0] + bf2f((bf16_t)(mm[0] & 0xffff)); h[4 * i + 1] = ALPHA * xv[1] + bf2f((bf16_t)(mm[0] >> 16));
        h[4 * i + 2] = ALPHA * xv[2] + bf2f((bf16_t)(mm[1] & 0xffff)); h[4 * i + 3] = ALPHA * xv[3] + bf2f((bf16_t)(mm[1] >> 16));
        s += (h[4 * i] + h[4 * i + 1]) + (h[4 * i + 2] + h[4 * i + 3]);
    }
    const float mean = wave_sum(s) * (1.0f / DM);
    float q = 0.f;
#pragma unroll
    for (int e = 0; e < 16; ++e) { const float d = h[e] - mean; q += d * d; }
    const float rstd = rsqrtf(wave_sum(q) * (1.0f / DM) + LN_EPS);
#pragma unroll
    for (int i = 0; i < 4; ++i) {
        const int k = 4 * lane + 256 * i;
#pragma unroll
        for (int e = 0; e < 4; ++e) h[4 * i + e] = (h[4 * i + e] - mean) * rstd * gv[i][e] + bv[i][e];
        if (!dry) NT_STORE((u32x2*)(p.hb + tok * DM + k), ((u32x2){pack2(h[4 * i], h[4 * i + 1]), pack2(h[4 * i + 2], h[4 * i + 3])}));
        else NT_STORE((u32x2*)(p.H + tok * DM + k), ((u32x2){pack2(h[4 * i], h[4 * i + 1]), pack2(h[4 * i + 2], h[4 * i + 3])}));
    }
    float gl[4];
#pragma unroll
    for (int n = 0; n < 4; ++n) {
        float a = 0.f;
#pragma unroll
        for (int i = 0; i < 4; ++i) { const f32x4 wv = *(const f32x4*)(Wr + n * 1024 + 4 * lane + 256 * i); a += h[4 * i] * wv[0] + h[4 * i + 1] * wv[1] + h[4 * i + 2] * wv[2] + h[4 * i + 3] * wv[3]; }
        gl[n] = a;
    }
#pragma unroll
    for (int o = 32; o > 0; o >>= 1)
#pragma unroll
        for (int n = 0; n < 4; ++n) gl[n] += __shfl_xor(gl[n], o);
#pragma unroll
    for (int n = 0; n < 4; ++n) gl[n] += p.rgb[layer * 4 + n];
    int grp = 0; float gm = gl[0];
#pragma unroll
    for (int n = 1; n < 4; ++n) if (gl[n] > gm) { gm = gl[n]; grp = n; }
    float den = 0.f;
#pragma unroll
    for (int n = 0; n < 4; ++n) den += expf(gl[n] - gm);
    const float pg = 1.0f / den;
    float m1 = -3.0e38f, m2 = -3.0e38f; int i1 = 0, i2 = 0;
    float el8[8];
#pragma unroll
    for (int j = 0; j < 8; ++j) {
        const float* wrow = Wr + (long)(4 + grp * 8 + j) * 1024;
        float a = 0.f;
#pragma unroll
        for (int i = 0; i < 4; ++i) { const f32x4 wv = *(const f32x4*)(wrow + 4 * lane + 256 * i); a += h[4 * i] * wv[0] + h[4 * i + 1] * wv[1] + h[4 * i + 2] * wv[2] + h[4 * i + 3] * wv[3]; }
        el8[j] = a;
    }
#pragma unroll
    for (int o = 32; o > 0; o >>= 1)
#pragma unroll
        for (int j = 0; j < 8; ++j) el8[j] += __shfl_xor(el8[j], o);
#pragma unroll
    for (int j = 0; j < 8; ++j) {
        const float el = el8[j] + p.reb[layer * 32 + grp * 8 + j];
        if (el > m1) { m2 = m1; i2 = i1; m1 = el; i1 = j; } else if (el > m2) { m2 = el; i2 = j; }
    }
    if (lane == 0) {
        const float g1 = 1.0f / (1.0f + expf(m2 - m1));
        const int e0 = grp * 8 + i1, e1 = grp * 8 + i2;
        le[lt * 2] = e0; le[lt * 2 + 1] = e1; lgate[lt * 2] = pg * g1; lgate[lt * 2 + 1] = pg * (1.0f - g1);
        lrank[lt * 2] = atomicAdd(&lcount[e0], 1); lrank[lt * 2 + 1] = atomicAdd(&lcount[e1], 1);
    }
}
__device__ __forceinline__ void phase_ln_router(const Params& p, int layer, const float* hin, const bf16_t* mixp, bool dry = false) {
    float* Wr = (float*)LDS_BASE();
    int* li = (int*)(LDS_BASE() + 36 * 1024 * 4);
    int* lcount = li; int* lbase = li + 32; int* le = li + 64; int* lrank = li + 64 + 128; float* lgate = (float*)(li + 64 + 256);
    const int t = TID(), lane = t & 63, w = t >> 6;
    f32x4 gv[4], bv[4];
#pragma unroll
    for (int i = 0; i < 4; ++i) { gv[i] = *(const f32x4*)(p.lnmg + layer * DM + 4 * lane + 256 * i); bv[i] = *(const f32x4*)(p.lnmb + layer * DM + 4 * lane + 256 * i); }
    { const f32x4* src = (const f32x4*)(p.WrT + (long)layer * 36 * 1024); f32x4* dst = (f32x4*)Wr;
#pragma unroll
      for (int r = 0; r < 2; ++r) {
          f32x4 v[9];
#pragma unroll
          for (int j = 0; j < 9; ++j) v[j] = src[t + NTHREADS * (9 * r + j)];
#pragma unroll
          for (int j = 0; j < 9; ++j) dst[t + NTHREADS * (9 * r + j)] = v[j];
      } }
    for (int bb = blockIdx.x; bb < NT / 64; bb += gridDim.x) {
        __syncthreads();
        if (t < 32) lcount[t] = 0;
        __syncthreads();
        {
            const long tokb = (long)bb * 64 + w * (64 / NW);
            LnrRow RA, RB;
            if (hin) lnr_load<true>(p, RA, hin, mixp, tokb, lane); else lnr_load<false>(p, RA, hin, mixp, tokb, lane);
#pragma unroll 1
            for (int it = 0; it < 64 / NW; it += 2) {
                const long tn = tokb + (it + 2 < 64 / NW ? it + 2 : it + 1);
                if (hin) {
                    lnr_load<true>(p, RB, hin, mixp, tokb + it + 1, lane);
                    lnr_process<true>(p, layer, RA, gv, bv, Wr, lcount, le, lrank, lgate, w * (64 / NW) + it, tokb + it, lane, dry);
                    lnr_load<true>(p, RA, hin, mixp, tn, lane);
                    lnr_process<true>(p, layer, RB, gv, bv, Wr, lcount, le, lrank, lgate, w * (64 / NW) + it + 1, tokb + it + 1, lane, dry);
                } else {
                    lnr_load<false>(p, RB, hin, mixp, tokb + it + 1, lane);
                    lnr_process<false>(p, layer, RA, gv, bv, Wr, lcount, le, lrank, lgate, w * (64 / NW) + it, tokb + it, lane, dry);
                    lnr_load<false>(p, RA, hin, mixp, tn, lane);
                    lnr_process<false>(p, layer, RB, gv, bv, Wr, lcount, le, lrank, lgate, w * (64 / NW) + it + 1, tokb + it + 1, lane, dry);
                }
            }
        }
        __syncthreads();
        if (t < 32) lbase[t] = (lcount[t] > 0 && !dry) ? atomicAdd(p.cnt + layer * 32 + t, lcount[t]) : 0;
        __syncthreads();
        if (t < 128 && !dry) {
            const int e = le[t], pos = lbase[e] + lrank[t]; const long tok = (long)bb * 64 + (t >> 1);
            p.tok_e[tok * 2 + (t & 1)] = e; p.tok_pos[tok * 2 + (t & 1)] = pos; p.tok_gate[tok * 2 + (t & 1)] = lgate[t];
            WT_STORE_I(p.list + (long)e * LIST_CAP + pos, (int)tok); WT_STORE_F(p.list_gate + (long)e * LIST_CAP + pos, lgate[t]);
        }
    }
}

__device__ __forceinline__ void moe_map(const Params& p, int layer, int* ustart, int* rbase, int* cntl, int npn) {
    __syncthreads();
    if (TID() < 64) {
        const int l_ = TID(), e = l_ & 31;
        const int c = l_ < 32 ? p.cnt[layer * 32 + e] : 0;
        const int tiles = ((c + 255) >> 8) * npn;
        int us = tiles, rb = c;
#pragma unroll
        for (int o = 1; o < 32; o <<= 1) { const int a = __shfl_up(us, o), b = __shfl_up(rb, o); if ((l_ & 31) >= o) { us += a; rb += b; } }
        if (l_ < 32) { ustart[e] = us - tiles; rbase[e] = rb - c; cntl[e] = c; if (e == 31) { ustart[32] = us; rbase[32] = rb; } }
    }
    __syncthreads();
}
constexpr int MAP_OFF = 131072;

__device__ __forceinline__ void phase_moe_gather(const Params& p, int layer) {
    int* ustart = (int*)(LDS_BASE() + MAP_OFF); int* rbase = ustart + 33; int* cntl = rbase + 33;
    moe_map(p, layer, ustart, rbase, cntl, 4);
    const int lane = TID() & 63, gw = blockIdx.x * NW + (TID() >> 6), nw = gridDim.x * NW, total = rbase[32];
    for (int s = gw; s < total; s += nw) {
        int e = 0; while (rbase[e + 1] <= s) ++e;
        const int pos = s - rbase[e]; const long tok = p.list[(long)e * LIST_CAP + pos];
        const u32x4 v0 = *(const u32x4*)(p.hb + tok * DM + lane * 8), v1 = *(const u32x4*)(p.hb + tok * DM + 512 + lane * 8);
        *(u32x4*)(p.Xg + (long)s * DM + lane * 8) = v0; *(u32x4*)(p.Xg + (long)s * DM + 512 + lane * 8) = v1;
        if (lane == 0) p.slot_gate[s] = p.list_gate[(long)e * LIST_CAP + pos];
    }
}

__device__ __forceinline__ void phase_moe1(const Params& p, int layer) {
    int* ustart = (int*)(LDS_BASE() + MAP_OFF); int* rbase = ustart + 33; int* cntl = rbase + 33;
    moe_map(p, layer, ustart, rbase, cntl, 4);
    pg8::MoeOrder S{ustart, rbase, cntl, (int)gridDim.x, (int)blockIdx.x, 4, 1024};
    pg8::gemm_phase<pg8::EpiMoe1, pg8::MoeOrder, true>((PG8_LAS unsigned char*)LDS_BASE(), p.hb, p.WguT, 1024, S, pg8::EpiMoe1{p.H}, p.list);
}
__device__ __forceinline__ void phase_moe2(const Params& p, int layer) {
    int* ustart = (int*)(LDS_BASE() + MAP_OFF); int* rbase = ustart + 33; int* cntl = rbase + 33;
    moe_map(p, layer, ustart, rbase, cntl, 4);
    pg8::MoeOrder S{ustart, rbase, cntl, (int)gridDim.x, (int)blockIdx.x, 4, 1024};
    pg8::gemm_phase<pg8::EpiMoe2, pg8::MoeOrder>((PG8_LAS unsigned char*)LDS_BASE(), p.H, p.WdT, EFF, S, pg8::EpiMoe2{p.Y, p.list_gate});
}

__device__ __forceinline__ void phase_ln_ffn(const Params& p, int layer, bool write_hb, bool dry = false) {
    int* ustart = (int*)(LDS_BASE() + MAP_OFF); int* rbase = ustart + 33; int* cntl = rbase + 33;
    moe_map(p, layer, ustart, rbase, cntl, 4);
    const int lane = TID() & 63, gw = blockIdx.x * NW + (TID() >> 6), nw = gridDim.x * NW;
    const float* gam = p.lnfg + layer * DM; const float* bet = p.lnfb + layer * DM;
    for (int tok = gw; tok < NT; tok += nw) {
        const long s0 = rbase[p.tok_e[(long)tok * 2]] + p.tok_pos[(long)tok * 2], s1 = rbase[p.tok_e[(long)tok * 2 + 1]] + p.tok_pos[(long)tok * 2 + 1];
        float h[16]; float s = 0.f;
#pragma unroll
        for (int i = 0; i < 4; ++i) {
            const int k = 4 * lane + 256 * i;
            const u32x2 xx = *(const u32x2*)(p.hb + (long)tok * DM + k);
            const f32x4 xv = (f32x4){bf2f((bf16_t)(xx[0] & 0xffff)), bf2f((bf16_t)(xx[0] >> 16)), bf2f((bf16_t)(xx[1] & 0xffff)), bf2f((bf16_t)(xx[1] >> 16))};
            const u32x2 ya = *(const u32x2*)(p.Y + s0 * DM + k), yb = *(const u32x2*)(p.Y + s1 * DM + k);
            h[4 * i + 0] = ALPHA * xv[0] + (bf2f((bf16_t)(ya[0] & 0xffff)) + bf2f((bf16_t)(yb[0] & 0xffff)));
            h[4 * i + 1] = ALPHA * xv[1] + (bf2f((bf16_t)(ya[0] >> 16)) + bf2f((bf16_t)(yb[0] >> 16)));
            h[4 * i + 2] = ALPHA * xv[2] + (bf2f((bf16_t)(ya[1] & 0xffff)) + bf2f((bf16_t)(yb[1] & 0xffff)));
            h[4 * i + 3] = ALPHA * xv[3] + (bf2f((bf16_t)(ya[1] >> 16)) + bf2f((bf16_t)(yb[1] >> 16)));
            s += (h[4 * i] + h[4 * i + 1]) + (h[4 * i + 2] + h[4 * i + 3]);
        }
        const float mean = wave_sum(s) * (1.0f / DM);
        float q = 0.f;
#pragma unroll
        for (int e = 0; e < 16; ++e) { const float d = h[e] - mean; q += d * d; }
        const float rstd = rsqrtf(wave_sum(q) * (1.0f / DM) + LN_EPS);
#pragma unroll
        for (int i = 0; i < 4; ++i) {
            const int k = 4 * lane + 256 * i;
            const f32x4 gv = *(const f32x4*)(gam + k), bv = *(const f32x4*)(bet + k);
#pragma unroll
            for (int e = 0; e < 4; ++e) h[4 * i + e] = (h[4 * i + e] - mean) * rstd * gv[e] + bv[e];
            if (dry) *(u32x2*)(p.H + (long)tok * DM + k) = (u32x2){pack2(h[4 * i], h[4 * i + 1]), pack2(h[4 * i + 2], h[4 * i + 3])};
            else if (write_hb) NT_STORE((u32x2*)(p.hb + (long)tok * DM + k), ((u32x2){pack2(h[4 * i], h[4 * i + 1]), pack2(h[4 * i + 2], h[4 * i + 3])}));
            else NT_STORE((f32x4*)(p.out + (long)tok * DM + k), ((f32x4){h[4 * i], h[4 * i + 1], h[4 * i + 2], h[4 * i + 3]}));
        }
    }
}


typedef float f32x16 __attribute__((ext_vector_type(16)));
typedef short s16x4 __attribute__((ext_vector_type(4)));
__device__ __forceinline__ s16x4 lds_tr_read(const bf16_t* p) {
#ifdef EMU
    return emu_ds_read_tr16_b64(p);
#else
    typedef short v4i16_t __attribute__((ext_vector_type(4)));
    return __builtin_bit_cast(s16x4, __builtin_amdgcn_ds_read_tr16_b64_v4i16((__attribute__((address_space(3))) v4i16_t*)p));
#endif
}
constexpr int KLD = 72;
struct AttnUnit { int c, d, r, grp, tpr, Ld, h, b; };
__device__ __forceinline__ AttnUnit attn_decode(int u, int g0, int g1, int g2) {
    constexpr int TPB = NS_ / 32;
    const int gper = g0 + g1 + g2; int gi = u % gper; const int bh = u / gper;
    AttnUnit a; a.h = bh & 15; a.b = bh >> 4;
    if (gi < g0) { a.c = 0; a.d = 1; } else if (gi < g0 + g1) { a.c = 1; a.d = 4; gi -= g0; } else { a.c = 2; a.d = 16; gi -= g0 + g1; }
    a.tpr = TPB / a.d; const int gpr = (a.tpr + 7) / 8; a.r = gi / gpr; a.grp = gi % gpr; a.Ld = NS_ / a.d;
    return a;
}
__device__ __forceinline__ void attn_loads(const Params& p, const AttnUnit& a, int t, int w, int q, int hh, u32x4 (&kr)[6], u32x4 (&vr)[6], bf16x8 (&qf)[4]) {
    const long tb = (long)a.b * NS_; const int M0 = 256 * a.grp;
#pragma unroll
    for (int i = 0; i < 6; ++i) {
        const int id = t + 512 * i, row = id >> 3, ch = (id & 7) * 8;
        int mk = M0 - 128 + row; mk = mk < 0 ? 0 : (mk >= a.Ld ? a.Ld - 1 : mk);
        const bf16_t* src = p.qkv + (tb + (long)mk * a.d + a.r) * 3072 + 1024 + a.h * 64 + ch;
        kr[i] = *(const u32x4*)src; vr[i] = *(const u32x4*)(src + 1024);
    }
    const int mt = 8 * a.grp + w, mtc = mt < a.tpr ? mt : a.tpr - 1;
    const long tokq = tb + (long)(32 * mtc + q) * a.d + a.r;
#pragma unroll
    for (int s = 0; s < 4; ++s) qf[s] = *(const bf16x8*)(p.qkv + tokq * 3072 + a.h * 64 + 16 * s + 8 * hh);
}
__device__ __forceinline__ void phase_attn(const Params& p) {
    constexpr int TPB = NS_ / 32;
    const int t = TID(), lane = t & 63, w = t >> 6, q = lane & 31, hh = lane >> 5;
    bf16_t* Ks = (bf16_t*)LDS_BASE(); bf16_t* Vs = Ks + 384 * KLD;
    const int g0 = (TPB + 7) / 8, g1 = 4 * ((TPB / 4 + 7) / 8), g2 = 16 * ((TPB / 16 + 7) / 8), gper = g0 + g1 + g2;
    const int nunits = NB_ * 16 * gper;
    const float C = 0.125f * 1.4426950408889634f;
    u32x4 kr[6], vr[6]; bf16x8 qn[4];
    const int G = (int)gridDim.x, nbh = NB_ * 16;
#ifndef ATTN_XCD
#define ATTN_XCD 1
#endif
    const bool xcdmap = ATTN_XCD && (G % 8 == 0) && (nbh % 8 == 0);
    const int xcd = (int)blockIdx.x & 7, lb = (int)blockIdx.x >> 3, nlb = G >> 3, nloc = (nbh / 8) * gper;
    const int nit = xcdmap ? (nloc + nlb - 1) / nlb : (nunits + G - 1) / G;
#define ATTN_UNIT_OF(it_) (xcdmap ? (((it_) * nlb + lb) < nloc ? ((((it_) * nlb + lb) / gper) * 8 + xcd) * gper + (((it_) * nlb + lb) % gper) : -1) \
                                  : (((it_) * G + (int)blockIdx.x) < nunits ? ((it_) * G + (int)blockIdx.x) : -1))
    { const int u0 = ATTN_UNIT_OF(0); if (u0 >= 0) { const AttnUnit a0 = attn_decode(u0, g0, g1, g2); attn_loads(p, a0, t, w, q, hh, kr, vr, qn); } }
    for (int it = 0; it < nit; ++it) {
        const int u = ATTN_UNIT_OF(it); if (u < 0) break;
        const AttnUnit a = attn_decode(u, g0, g1, g2);
        const int c = a.c, d = a.d, r = a.r, h = a.h, tpr = a.tpr;
        const int mt = 8 * a.grp + w;
        const long tb = (long)a.b * NS_;
        LDS_BARRIER();
#pragma unroll
        for (int i = 0; i < 6; ++i) {
            const int id = t + 512 * i, row = id >> 3, ch = (id & 7) * 8;
            *(u32x4*)(Ks + row * KLD + ch) = kr[i]; *(u32x4*)(Vs + row * KLD + ch) = vr[i];
        }
        bf16x8 qf[4];
#pragma unroll
        for (int s = 0; s < 4; ++s) qf[s] = qn[s];
        const bool active = mt < tpr;
        const int mtc = active ? mt : tpr - 1;
        const long tokq = tb + (long)(32 * mtc + q) * d + r;
        LDS_BARRIER();
        { const int un = (it + 1 < nit) ? ATTN_UNIT_OF(it + 1) : -1; if (un >= 0) { const AttnUnit an = attn_decode(un, g0, g1, g2); attn_loads(p, an, t, w, q, hh, kr, vr, qn); } }
        if (active) {
            f32x16 sc[5];
#pragma unroll
            for (int j = 0; j < 5; ++j) {
                const int mk0 = 32 * mt - 128 + 32 * j;
                if (mk0 >= 0) {
                    const bf16_t* kp = Ks + (32 * (w + j) + q) * KLD + 8 * hh;
                    f32x16 acc;
#pragma unroll
                    for (int i = 0; i < 16; ++i) acc[i] = 0.f;
#pragma unroll
                    for (int s = 0; s < 4; ++s) acc = __builtin_amdgcn_mfma_f32_32x32x16_bf16(*(const bf16x8*)(kp + 16 * s), qf[s], acc, 0, 0, 0);
                    sc[j] = acc;
                } else {
#pragma unroll
                    for (int i = 0; i < 16; ++i) sc[j][i] = -1.0e30f;
                }
            }
            float mx = -1.0e30f;
#pragma unroll
            for (int j = 0; j < 5; ++j)
#pragma unroll
                for (int i = 0; i < 16; ++i) {
                    const int kk = (i & 3) + 8 * (i >> 2) + 4 * hh;
                    if (j == 0) { if (kk < q) sc[j][i] = -1.0e30f; }
                    if (j == 4) { if (kk > q) sc[j][i] = -1.0e30f; }
                    mx = fmaxf(mx, sc[j][i]);
                }
            mx = fmaxf(mx, __shfl_xor(mx, 32));
            const float nmx = -mx * C;
            mx = mx * C;
            float l = 0.f;
#pragma unroll
            for (int j = 0; j < 5; ++j)
#pragma unroll
                for (int i = 0; i < 16; ++i) { const float e = __builtin_amdgcn_exp2f(fmaf(sc[j][i], C, nmx)); sc[j][i] = e; l += e; }
            l += __shfl_xor(l, 32);
            f32x16 o[2];
#pragma unroll
            for (int i = 0; i < 16; ++i) { o[0][i] = 0.f; o[1][i] = 0.f; }
#pragma unroll
            for (int j = 0; j < 5; ++j) {
                const int mk0 = 32 * mt - 128 + 32 * j;
                if (mk0 >= 0) {
#pragma unroll
                    for (int s = 0; s < 2; ++s) {
                        const unsigned w0 = pack2(sc[j][8 * s + 0], sc[j][8 * s + 1]), w1 = pack2(sc[j][8 * s + 2], sc[j][8 * s + 3]);
                        const unsigned w2 = pack2(sc[j][8 * s + 4], sc[j][8 * s + 5]), w3 = pack2(sc[j][8 * s + 6], sc[j][8 * s + 7]);
                        const bf16x8 pa = __builtin_bit_cast(bf16x8, (u32x4){w0, w1, w2, w3});
#pragma unroll
                        for (int db = 0; db < 2; ++db) {
                            const bf16_t* vp = Vs + (32 * (w + j) + 16 * s + 4 * hh + ((lane & 15) >> 2)) * KLD + 32 * db + 16 * ((lane >> 4) & 1) + 4 * (lane & 3);
                            const s16x4 lo = lds_tr_read(vp), hi = lds_tr_read(vp + 8 * KLD);
                            const bf16x8 vb = (bf16x8){lo[0], lo[1], lo[2], lo[3], hi[0], hi[1], hi[2], hi[3]};
                            o[db] = __builtin_amdgcn_mfma_f32_32x32x16_bf16(vb, pa, o[db], 0, 0, 0);
                        }
                    }
                }
            }
            bf16_t* ob = p.obr[c] + tokq * 1024 + h * 64 + 4 * hh;
#pragma unroll
            for (int db = 0; db < 2; ++db)
#pragma unroll
                for (int cq = 0; cq < 4; ++cq)
                    *(u32x2*)(ob + 32 * db + 8 * cq) = (u32x2){pack2(o[db][4 * cq], o[db][4 * cq + 1]), pack2(o[db][4 * cq + 2], o[db][4 * cq + 3])};
            if (hh == 0) { float* st = p.ost + ((long)c * NT + tokq) * 32 + h * 2; WT_STORE_F2(st, mx, l); }
        }
    }
}

__device__ __forceinline__ void phase_attn_merge(const Params& p) {
    const long gtid = (long)blockIdx.x * NTHREADS + TID(), gsz = (long)gridDim.x * NTHREADS;
    for (long idx = gtid; idx < (long)NT * 16 * 8; idx += gsz) {
        const long th = idx >> 3; const int ch = (int)(idx & 7);
        const long tok = th >> 4; const int h = (int)(th & 15);
        float m[3], l[3];
#pragma unroll
        for (int c = 0; c < 3; ++c) { const float* st = p.ost + ((long)c * NT + tok) * 32 + h * 2; m[c] = st[0]; l[c] = st[1]; }
        const float M = fmaxf(m[0], fmaxf(m[1], m[2]));
        float wgt[3], den = 0.f;
#pragma unroll
        for (int c = 0; c < 3; ++c) { wgt[c] = __builtin_amdgcn_exp2f(m[c] - M); den += wgt[c] * l[c]; }
        const float inv = 1.0f / den;
        float acc[8];
#pragma unroll
        for (int e = 0; e < 8; ++e) acc[e] = 0.f;
#pragma unroll
        for (int c = 0; c < 3; ++c) {
            const u32x4 v = *(const u32x4*)(p.obr[c] + tok * 1024 + h * 64 + ch * 8);
#pragma unroll
            for (int e = 0; e < 4; ++e) { acc[2 * e] += wgt[c] * bf2f((bf16_t)(v[e] & 0xffff)); acc[2 * e + 1] += wgt[c] * bf2f((bf16_t)(v[e] >> 16)); }
        }
        *(u32x4*)(p.attno + tok * 1024 + h * 64 + ch * 8) = (u32x4){pack2(acc[0] * inv, acc[1] * inv), pack2(acc[2] * inv, acc[3] * inv), pack2(acc[4] * inv, acc[5] * inv), pack2(acc[6] * inv, acc[7] * inv)};
    }
}

constexpr int NPHASES = 19;
__device__ __forceinline__ void run_phase(const Params& p, int ph, const XcdBarrier& xb) {
    switch (ph) {
    case 0:
#if defined(P0_VARIANT)
        _Pragma("unroll 1") for (int rep = 0; rep < 2; ++rep) { phase_prologue(p); __syncthreads(); }
#else
        phase_prologue(p);
#endif
        __syncthreads(); phase_ba(p);
        break;
    case 1: gemm_dense(p.hb, p.WinT, NT, 2560, 1024, pg8::EpiStore{p.proj, 2560}); break;
    case 2:
#if !FUSE_PREP
        phase_gdn_prep(p);
#endif
        break;
    case 3:
#if defined(P3_VARIANT) && P3_VARIANT == 1
        _Pragma("unroll 1") for (int rep = 0; rep < 2; ++rep) { phase_gdn_chunk(p); __syncthreads(); }
        phase_s5_pass<1>(p, 0);
#elif defined(P3_VARIANT) && P3_VARIANT == 2
        phase_gdn_chunk(p); __syncthreads();
        _Pragma("unroll 1") for (int rep = 0; rep < 2; ++rep) { phase_s5_pass<1>(p, 0); __syncthreads(); }
#else
        phase_gdn_chunk(p); __syncthreads(); phase_s5_pass<1>(p, 0);
#endif
        break;
    case 4: {
        int nscan = NB_ * 16; if (nscan > (int)gridDim.x / 2) nscan = (int)gridDim.x / 2;
#if defined(P4_VARIANT) && P4_VARIANT == 1
        if ((int)blockIdx.x < nscan) { phase_gdn_scan(p, nscan); LDS_BARRIER(); phase_gdn_scan(p, nscan); } else phase_s5_pass<2>(p, nscan);
#elif defined(P4_VARIANT) && P4_VARIANT == 2
        if ((int)blockIdx.x < nscan) phase_gdn_scan(p, nscan); else { phase_s5_pass<2>(p, nscan); LDS_BARRIER(); phase_s5_pass<2>(p, nscan); }
#else
        if ((int)blockIdx.x < nscan) phase_gdn_scan(p, nscan); else phase_s5_pass<2>(p, nscan);
#endif
        break; }
    case 5: phase_gdn_post(p); __syncthreads(); gemm_dense(p.ygelu, p.WgluT, NT, 512, 512, pg8::EpiGlu{p.ygelu, p.ycat}); break;
    case 6: gemm_dense(p.ycat, p.WoutT, NT, 1024, 1024, pg8::EpiStore{p.mix, 1024}); __syncthreads(); transpose_tiles<3>(p.moejobs[0]);
#if defined(P6_VARIANT)
        __syncthreads(); transpose_tiles<3>(p.moejobs[0]);
#endif
        break;
    case 7:
#if defined(P7_VARIANT)
        phase_ln_router(p, 0, p.x, p.mix, true); __syncthreads();
#endif
        phase_ln_router(p, 0, p.x, p.mix); break;
    case 8: phase_moe1(p, 0); break;
    case 9: phase_moe2(p, 0); break;
    case 10:
#if defined(P11_VARIANT)
        phase_ln_ffn(p, 0, true, true); __syncthreads();
#endif
        phase_ln_ffn(p, 0, true); break;
    case 11: gemm_dense(p.hb, p.WqkvT, NT, 3072, 1024, pg8::EpiStore{p.qkv, 3072}); break;
    case 12: phase_attn(p); break;
    case 13: phase_attn_merge(p); break;
    case 14: gemm_dense(p.attno, p.WoutcT, NT, 1024, 1024, pg8::EpiStore{p.mix1, 1024}); __syncthreads(); transpose_tiles<3>(p.moejobs[1]); break;
    case 15: phase_ln_router(p, 1, nullptr, p.mix1); break;
    case 16: phase_moe1(p, 1); break;
    case 17: phase_moe2(p, 1); break;
    case 18: phase_ln_ffn(p, 1, false); break;
    default: break;
    }
}

#if N_LAUNCH_MODE == 0
template <int PH> __global__ void __launch_bounds__(NTHREADS, 2) k_ph(Params p) { XcdBarrier xb{}; run_phase(p, PH, xb); }
template <int PH> static void launch_from(const Params& p, int grid, hipStream_t stream, int maxph) {
    if constexpr (PH < NPHASES) {
        if (PH <= maxph) {
#ifdef EMU
            emu::launch(dim3(32), dim3(NTHREADS), LDS_BYTES, [=] { k_ph<PH>(p); }, false); fprintf(stderr, "phase %d done\n", PH);
#else
            hipFuncSetAttribute((const void*)k_ph<PH>, hipFuncAttributeMaxDynamicSharedMemorySize, LDS_BYTES);
            hipLaunchKernelGGL(k_ph<PH>, dim3(grid), dim3(NTHREADS), LDS_BYTES, stream, p);
#endif
        }
        launch_from<PH + 1>(p, grid, stream, maxph);
    }
}
#else
template <int PH> __device__ __forceinline__ void mega_from(const Params& p, const XcdBarrier& xb) {
    if constexpr (PH < NPHASES && FUSE_PREP && PH == 2) { mega_from<PH + 1>(p, xb); }
    else if constexpr (PH < NPHASES) {
        run_phase(p, PH, xb);
#ifdef PROBE_MASK
        if constexpr (((PROBE_MASK) >> PH) & 1) { GRID_SYNC(); run_phase(p, PH, xb); }
#endif
        if constexpr (PH == 0) { GRID_SYNC_CG(); }
        else if constexpr (PH + 1 < NPHASES) { GRID_SYNC(); }
        mega_from<PH + 1>(p, xb);
    }
}
__global__ void __launch_bounds__(NTHREADS, 2) k_mega(Params p) {
#ifdef EMU
    XcdBarrier xb{0};
#else
    volatile XB_LAS unsigned* st = (volatile XB_LAS unsigned*)(lds_raw + XB_ST_OFF);
    if (threadIdx.x == 0) { st[0] = 0u; st[1] = 0u; }
    __syncthreads();
    const XcdBarrier xb = xcd_barrier_post(p.bar, st);
#endif
    mega_from<0>(p, xb);
}
#endif

#ifdef EMU
Params g_emu_params;
#endif

static inline size_t al256(size_t x) { return (x + 255) & ~(size_t)255; }

extern "C" void kernel_launch(void* const* d_in, const int* in_sizes, int n_in, void* d_out, int out_size, void* d_ws, size_t ws_size, hipStream_t stream) {
    Params p; memset(&p, 0, sizeof(p));
    const float* const* in = (const float* const*)d_in;
    p.x = in[0]; p.w_in = in[1]; p.conv = in[2]; p.a_log = in[3]; p.dt_bias = in[4]; p.gnorm = in[5]; p.lam_re = in[6]; p.lam_im = in[7]; p.log_dt = in[8];
    p.b_re = in[9]; p.b_im = in[10]; p.c_re = in[11]; p.c_im = in[12]; p.s5d = in[13]; p.wglu = in[14]; p.wout = in[15]; p.wqkv = in[16]; p.woutc = in[17];
    p.lnmg = in[18]; p.lnmb = in[19]; p.rgw = in[20]; p.rgb = in[21]; p.rew = in[22]; p.reb = in[23]; p.mg = in[24]; p.mu = in[25]; p.md = in[26]; p.lnfg = in[27]; p.lnfb = in[28];
    p.out = (float*)d_out;
    char* ws = (char*)d_ws; size_t off = 0;
    auto take = [&](size_t bytes) { char* r = ws + off; off += al256(bytes); return r; };
    p.WinT = (bf16_t*)take((size_t)2560 * 1024 * 2); p.WoutT = (bf16_t*)take((size_t)1024 * 1024 * 2); p.WgluT = (bf16_t*)take((size_t)512 * 512 * 2);
    p.WqkvT = (bf16_t*)take((size_t)3072 * 1024 * 2); p.WoutcT = (bf16_t*)take((size_t)1024 * 1024 * 2);
    p.WrT = (float*)take((size_t)2 * 36 * 1024 * 4);
    p.s5a = (float*)take(2048 * 2 * 4); p.s5a64 = (float*)take(2048 * 2 * 4); p.s5bbr = (float*)take(2048 * 16 * 4); p.s5bbi = (float*)take(2048 * 16 * 4); p.s5cm = (bf16_t*)take(32 * 16 * 128 * 2); p.s5bbm = (bf16_t*)take(32 * 128 * 16 * 2);
    p.cnt = (int*)take(64 * 4);
    p.bar = (unsigned*)take(4096 * 4);
    p.tok_e = (int*)take((size_t)NT * 2 * 4); p.tok_pos = (int*)take((size_t)NT * 2 * 4); p.tok_gate = (float*)take((size_t)NT * 2 * 4);
    p.list = (int*)take((size_t)32 * LIST_CAP * 4); p.list_gate = (float*)take((size_t)32 * LIST_CAP * 4);
    char* hbreg = take((size_t)NT * 1024 * 2);
    p.hb = (bf16_t*)hbreg;
    p.go = (bf16_t*)hbreg;
    p.s5loc = (float*)(hbreg + (size_t)NT * 512 * 2); p.s5in = p.s5loc + (size_t)NB_ * NCH * 2048 * 2;
    char* moew = take((size_t)32 * 1024 * 1024 * 2 + (size_t)32 * 1024 * 512 * 2);
    p.WguT = (bf16_t*)moew; p.WdT = (bf16_t*)(moew + (size_t)32 * 1024 * 1024 * 2);
    p.gq = (bf16_t*)moew; p.gk = p.gq + (size_t)NT * 512; p.gv = p.gk + (size_t)NT * 512;
    p.ygelu = (bf16_t*)moew;
    char* ar = ws + off;
    size_t a = 0;
    auto atake = [&](size_t bytes) { char* r = ar + a; a += al256(bytes); return r; };
    p.proj = (bf16_t*)atake((size_t)NT * PROJ_LD * 2);
    char* chunk0 = ar + a;
    p.cU = (bf16_t*)atake((size_t)NT * 512 * 2); p.cW = (bf16_t*)atake((size_t)NT * 512 * 2); p.cQd = (bf16_t*)atake((size_t)NT * 512 * 2); p.cKdT = (bf16_t*)atake((size_t)NT * 512 * 2);
    p.cQK = (bf16_t*)atake((size_t)NT * 512 * 2); p.cgl = (float*)atake((size_t)NB_ * 4 * NCH * 4);
    p.gbeta = (float*)atake((size_t)NT * 4 * 4); p.gg = (float*)atake((size_t)NT * 4 * 4);
    size_t amax = a;
    p.ycat = (bf16_t*)chunk0;
    p.mix = (bf16_t*)ar;
    p.Xg = (bf16_t*)ar; p.Y = (bf16_t*)ar; p.H = (bf16_t*)(ar + al256((size_t)(2 * NT + 256) * DM * 2)); p.slot_gate = (float*)((char*)p.H + al256((size_t)(2 * NT + 256) * EFF * 2));
    { size_t e = al256((size_t)(2 * NT + 256) * DM * 2) + al256((size_t)(2 * NT + 256) * EFF * 2) + (size_t)2 * NT * 4; if (e > amax) amax = e; }
    p.qkv = (bf16_t*)ar; p.attno = (bf16_t*)ar; p.mix1 = (bf16_t*)(ar + (size_t)NT * 1024 * 2);
    p.obr[0] = (bf16_t*)(ar + al256((size_t)NT * 3072 * 2) + (size_t)NT * 1024 * 2); p.obr[1] = (bf16_t*)moew; p.ost = (float*)(moew + (size_t)NT * 1024 * 2); p.obr[2] = (bf16_t*)(ar + al256((size_t)NT * 3072 * 2));
    { size_t e = al256((size_t)NT * 3072 * 2) + (size_t)2 * NT * 1024 * 2; if (e > amax) amax = e; }
    if (off + amax > ws_size) { fprintf(stderr, "workspace too small: need %zu have %zu\n", off + amax, ws_size); return; }
    auto job = [](const float* src, bf16_t* dst, int K, int N, int ldsrc, int ldd, int rb, int rs, int roff, int batch, long sbs, long dbs) {
        TJob j; memset(&j, 0, sizeof(j)); j.src = src; j.dst = dst; j.K = K; j.N = N; j.ldsrc = ldsrc; j.ldd = ldd; j.rb = rb; j.rs = rs; j.roff = roff; j.batch = batch; j.sbs = sbs; j.dbs = dbs; return j; };
    p.jobs[0] = job(p.w_in, p.WinT, 1024, 2048, 2568, 1024, 2048, 0, 0, 1, 0, 0);
    p.jobs[1] = job(p.w_in + 2056, p.WinT + (size_t)2048 * 1024, 1024, 512, 2568, 1024, 512, 0, 0, 1, 0, 0);
    p.jobs[2] = job(p.wout, p.WoutT, 1024, 1024, 1024, 1024, 1024, 0, 0, 1, 0, 0);
    p.jobs[3] = job(p.wglu, p.WgluT, 512, 512, 512, 512, 512, 0, 0, 1, 0, 0);
    p.jobs[4] = job(p.wqkv, p.WqkvT, 1024, 3072, 3072, 1024, 3072, 0, 0, 1, 0, 0);
    p.jobs[5] = job(p.woutc, p.WoutcT, 1024, 1024, 1024, 1024, 1024, 0, 0, 1, 0, 0);
    p.njobs = 6;
    for (int l = 0; l < 2; ++l) {
        p.moejobs[l][0] = job(p.mg + (size_t)l * 32 * 1024 * 512, p.WguT, 1024, 512, 512, 1024, 128, 256, 0, 32, 1024L * 512, 1024L * 1024);
        p.moejobs[l][1] = job(p.mu + (size_t)l * 32 * 1024 * 512, p.WguT, 1024, 512, 512, 1024, 128, 256, 128, 32, 1024L * 512, 1024L * 1024);
        p.moejobs[l][2] = job(p.md + (size_t)l * 32 * 512 * 1024, p.WdT, 512, 1024, 1024, 512, 1024, 0, 0, 32, 512L * 1024, 1024L * 512);
    }
#ifdef EMU
    g_emu_params = p;
#if N_LAUNCH_MODE == 1
    emu::launch(dim3(16), dim3(NTHREADS), LDS_BYTES, [=] { k_mega(p); }, true);
#else
    { const char* e = getenv("EMU_MAXPHASE"); launch_from<0>(p, 64, stream, e ? atoi(e) : NPHASES - 1); }
#endif
#else
#if N_LAUNCH_MODE == 1
    static int grid_blocks = 0;
    if (!grid_blocks) {
        int dev = 0, cus = 0, per_cu = 0;
        (void)hipGetDevice(&dev); (void)hipDeviceGetAttribute(&cus, hipDeviceAttributeMultiprocessorCount, dev);
        (void)hipFuncSetAttribute((const void*)k_mega, hipFuncAttributeMaxDynamicSharedMemorySize, LDS_BYTES);
        (void)hipOccupancyMaxActiveBlocksPerMultiprocessor(&per_cu, k_mega, NTHREADS, LDS_BYTES);
        per_cu = 1;
        grid_blocks = cus * per_cu;
    }
    (void)hipMemsetAsync(p.bar, 0, 4096 * 4, stream);
    void* args[] = {(void*)&p};
    hipError_t e = hipLaunchCooperativeKernel((void*)k_mega, dim3(grid_blocks), dim3(NTHREADS), args, LDS_BYTES, stream);
    if (e != hipSuccess) fprintf(stderr, "cooperative launch failed: %s (grid %d)\n", hipGetErrorString(e), grid_blocks);
#else
    launch_from<0>(p, 256, stream, NPHASES - 1);
#endif
#endif
}
```

```cpp
#ifndef EMU
#include <hip/hip_runtime.h>
#include <hip/hip_cooperative_groups.h>
#endif
#include <cstdint>
#include <cstdio>
#include <cmath>
#include <cstring>
#include <cstdlib>

#ifndef CFG_BATCH
#define CFG_BATCH 8
#endif
#ifndef CFG_SEQ
#define CFG_SEQ 4096
#endif
#ifndef N_LAUNCH_MODE
#define N_LAUNCH_MODE 1
#endif

typedef unsigned short bf16_t;
typedef short bf16x8 __attribute__((ext_vector_type(8)));
typedef float f32x4 __attribute__((ext_vector_type(4)));
typedef unsigned u32x4 __attribute__((ext_vector_type(4)));
typedef unsigned u32x2 __attribute__((ext_vector_type(2)));

constexpr int NB_ = CFG_BATCH, NS_ = CFG_SEQ, NT = NB_ * NS_, DM = 1024;
constexpr int NCH = NS_ / 64;
constexpr int PROJ_LD = 2560;
constexpr int NEXP = 32, EFF = 512;
constexpr int LIST_CAP = NT * 2;
constexpr float ALPHA = 1.41421356237f;
constexpr float LN_EPS = 1e-5f;
constexpr int NTHREADS = 512, NW = 8;
constexpr int LDS_BYTES = 160 * 1024;

#ifdef EMU
#define LDS_BASE() (emu::cur->blk->smem)
#define GRID_SYNC_CG() emu::grid_sync()
#define GRID_SYNC() emu::grid_sync()
struct XcdBarrier { int dummy; };
#else
extern __shared__ __attribute__((aligned(16))) char lds_raw[];
#define LDS_BASE() (lds_raw)
#define GRID_SYNC_CG() cooperative_groups::this_grid().sync()
#define GRID_SYNC() xcd_barrier(xb)
#define XB_TMO      128
#define XB_XCNT(j)  (256  + 64 * (j))
#define XB_XSUB(j)  (1280 + 64 * (j))
#define XB_XGEN(j)  (2304 + 64 * (j))
#define XB_TOP      3328
#define XB_TOPGEN   3392
#define XCD_BAR_WORDS 3456
#define XB_SPIN_CAP (1u << 18)
#define XB_LAS __attribute__((address_space(3)))
#define XB_ACQUIRE() __builtin_amdgcn_fence(__ATOMIC_ACQUIRE, "agent")
__device__ __forceinline__ unsigned xb_ld(unsigned* p)              { return __hip_atomic_load(p, __ATOMIC_RELAXED, __HIP_MEMORY_SCOPE_AGENT); }
__device__ __forceinline__ unsigned xb_add(unsigned* p, unsigned v) { return __hip_atomic_fetch_add(p, v, __ATOMIC_RELAXED, __HIP_MEMORY_SCOPE_AGENT); }
__device__ __forceinline__ unsigned xb_xcc_id() { return (unsigned)__builtin_amdgcn_s_getreg((3 << 11) | 20) & 0xFu; }
#define XB_SPIN(cond, bar) do { unsigned _sp = 0; while (cond) { __builtin_amdgcn_s_sleep(1); \
    if ((++_sp & 255u) == 0u) { if (xb_ld(&(bar)[XB_TMO])) break; if (_sp > XB_SPIN_CAP) { atomicAdd(&(bar)[XB_TMO], 1u); break; } } } } while (0)
struct XcdBarrier { unsigned* bar; unsigned x; volatile XB_LAS unsigned* st; };
__device__ __forceinline__ XcdBarrier xcd_barrier_post(unsigned* bar, volatile XB_LAS unsigned* st) {
    XcdBarrier b; b.bar = bar; b.x = xb_xcc_id(); b.st = st;
    if (threadIdx.x == 0) (void)xb_add(&bar[XB_XCNT(b.x)], 1u);
    return b;
}
__device__ __forceinline__ void xcd_barrier_complete(unsigned* bar, unsigned x, unsigned& nloc, unsigned& nx) {
    const unsigned G = gridDim.x * gridDim.y * gridDim.z;
    unsigned sum, cnt, mine, sp = 0u;
    for (;;) {
        sum = 0u; cnt = 0u; mine = 0u;
#pragma unroll
        for (unsigned j = 0; j < 16; ++j) { const unsigned c = xb_ld(&bar[XB_XCNT(j)]); sum += c; cnt += (c > 0u) ? 1u : 0u; mine = (j == x) ? c : mine; }
        if (sum == G) break;
        __builtin_amdgcn_s_sleep(1);
        if ((++sp & 255u) == 0u) { if (xb_ld(&bar[XB_TMO])) break; if (sp > XB_SPIN_CAP) { atomicAdd(&bar[XB_TMO], 1u); break; } }
    }
    nloc = mine > 0u ? mine : 1u; nx = cnt > 0u ? cnt : 1u;
}
__device__ __forceinline__ void xcd_barrier(const XcdBarrier& b) {
    asm volatile("s_waitcnt vmcnt(0)" ::: "memory");
    __syncthreads();
    if (threadIdx.x == 0) {
        unsigned* bar = b.bar;
        __builtin_amdgcn_s_waitcnt(0);
        unsigned nloc = b.st[0], nx = b.st[1];
        if (nloc == 0u) { xcd_barrier_complete(bar, b.x, nloc, nx); b.st[0] = nloc; b.st[1] = nx; }
        const unsigned old = xb_add(&bar[XB_XSUB(b.x)], 1u);
        const unsigned gen = old / nloc;
        if (old + 1u == (gen + 1u) * nloc) {
            __builtin_amdgcn_fence(__ATOMIC_RELEASE, "agent");
            asm volatile("s_waitcnt vmcnt(0)" ::: "memory");
            const unsigned og = xb_add(&bar[XB_TOP], 1u);
            const unsigned tg = og / nx;
            if (og + 1u == (tg + 1u) * nx) xb_add(&bar[XB_TOPGEN], 1u);
            else XB_SPIN(xb_ld(&bar[XB_TOPGEN]) == tg, bar);
            XB_ACQUIRE();
            xb_add(&bar[XB_XGEN(b.x)], 1u);
            asm volatile("s_waitcnt vmcnt(0)" ::: "memory");
        } else {
            XB_SPIN(xb_ld(&bar[XB_XGEN(b.x)]) == gen, bar);
            XB_ACQUIRE();
            asm volatile("s_waitcnt vmcnt(0)" ::: "memory");
        }
    }
    __syncthreads();
}
#endif
#ifdef EMU
#define NT_STORE(ptr, val) (*(ptr) = (val))
#else
#define NT_STORE(ptr, val) __builtin_nontemporal_store((val), (ptr))
#endif
#ifndef WT_PLAIN
#define WT_PLAIN 0
#endif
#ifdef EMU
#define WT_STORE_I(ptr, val) (*(ptr) = (val))
#define WT_STORE_F(ptr, val) (*(ptr) = (val))
#define WT_STORE_F2(ptr, a, b) ((ptr)[0] = (a), (ptr)[1] = (b))
#else
#if WT_PLAIN
#define WT_STORE_F2(ptr, a, b) ((ptr)[0] = (a), (ptr)[1] = (b))
#define WT_STORE_I(ptr, val) (*(ptr) = (val))
#define WT_STORE_F(ptr, val) (*(ptr) = (val))
#else
#define WT_STORE_F2(ptr, a, b) __hip_atomic_store((unsigned long long*)(ptr), ((unsigned long long)__float_as_uint(b) << 32) | (unsigned long long)__float_as_uint(a), __ATOMIC_RELAXED, __HIP_MEMORY_SCOPE_AGENT)
#define WT_STORE_I(ptr, val) __hip_atomic_store((ptr), (val), __ATOMIC_RELAXED, __HIP_MEMORY_SCOPE_AGENT)
#define WT_STORE_F(ptr, val) __hip_atomic_store((ptr), (val), __ATOMIC_RELAXED, __HIP_MEMORY_SCOPE_AGENT)
#endif
#endif
#ifdef EMU
#define LDS_BARRIER() emu::syncthreads()
#else
#define LDS_BARRIER() asm volatile("s_waitcnt lgkmcnt(0)\n\ts_barrier" ::: "memory")
#endif
constexpr int XB_ST_OFF = 160 * 1024 - 16;

__device__ __forceinline__ int TID() {
#ifdef EMU
    return (int)emu::cur->tid.x;
#else
    int t = (int)threadIdx.x; asm volatile("" : "+v"(t)); return t;
#endif
}
__device__ __forceinline__ float bf2f(bf16_t v) { return __builtin_bit_cast(float, (unsigned)v << 16); }
__device__ __forceinline__ bf16_t f2bf(float f) { unsigned u = __builtin_bit_cast(unsigned, f); u += 0x7fffu + ((u >> 16) & 1u); return (bf16_t)(u >> 16); }
#ifdef EMU
__device__ __forceinline__ unsigned pack2(float a, float b) { return (unsigned)f2bf(a) | ((unsigned)f2bf(b) << 16); }
#else
typedef float f32x2_t_ __attribute__((ext_vector_type(2))); typedef __bf16 bf16x2_t_ __attribute__((ext_vector_type(2)));
__device__ __forceinline__ unsigned pack2(float a, float b) { f32x2_t_ v = {a, b}; bf16x2_t_ r = __builtin_convertvector(v, bf16x2_t_); return __builtin_bit_cast(unsigned, r); }
#endif
__device__ __forceinline__ float sigmoidf_(float x) { return 1.0f / (1.0f + __expf(-x)); }
__device__ __forceinline__ float siluf_(float x) { return x / (1.0f + __expf(-x)); }
__device__ __forceinline__ float wave_sum(float v) {
#pragma unroll
    for (int o = 32; o > 0; o >>= 1) v += __shfl_xor(v, o);
    return v;
}

struct TJob { const float* src; bf16_t* dst; int K, N, ldsrc, ldd, rb, rs, roff, batch; long sbs, dbs; };

struct Params {
    const float *x, *w_in, *conv, *a_log, *dt_bias, *gnorm, *lam_re, *lam_im, *log_dt, *b_re, *b_im, *c_re, *c_im, *s5d, *wglu, *wout,
        *wqkv, *woutc, *lnmg, *lnmb, *rgw, *rgb, *rew, *reb, *mg, *mu, *md, *lnfg, *lnfb;
    float* out;
    bf16_t *WinT, *WoutT, *WgluT, *WqkvT, *WoutcT;
    float* WrT;
    float *s5a, *s5a64, *s5bbr, *s5bbi;
    bf16_t* s5cm;
    bf16_t* s5bbm;
    bf16_t* hb;
    bf16_t *WguT, *WdT;
    int* cnt;
    int *tok_e, *tok_pos; float* tok_gate;
    int* list; float* list_gate;
    bf16_t* proj;
    float *gbeta, *gg;
    bf16_t *gq, *gk, *gv;
    bf16_t *cU, *cW, *cQd, *cKdT;
    bf16_t* cQK;
    float* cgl;
    bf16_t* go;
    float *s5loc, *s5in;
    bf16_t* ygelu;
    bf16_t* ycat;
    bf16_t* mix;
    bf16_t* H;
    bf16_t* Y;
    bf16_t* qkv;
    bf16_t* attno;
    bf16_t* obr[3];
    float* ost;
    bf16_t* mix1;
    bf16_t* Xg;
    float* slot_gate;
    unsigned* bar;
    TJob jobs[8]; int njobs; int pad0;
    TJob moejobs[2][3];
};

struct TTile { const float* src; bf16_t* dst; int ldsrc, ldd, rb, rs, roff, k0, n0; };
template <int NJ>
__device__ __forceinline__ TTile tt_decode(const TJob* jobs, int g) {
    TJob J = jobs[0]; int rem = g; bool found = false;
#pragma unroll
    for (int j = 0; j < NJ; ++j) { const int nt = jobs[j].batch * (jobs[j].K / 64) * (jobs[j].N / 64); if (!found) { if (rem < nt) { J = jobs[j]; found = true; } else rem -= nt; } }
    const int tk = J.K / 64, tn = J.N / 64;
    const int b = rem / (tk * tn), r2 = rem % (tk * tn);
    TTile T; T.k0 = (r2 / tn) * 64; T.n0 = (r2 % tn) * 64; T.src = J.src + (long)b * J.sbs; T.dst = J.dst + (long)b * J.dbs;
    T.ldsrc = J.ldsrc; T.ldd = J.ldd; T.rb = J.rb; T.rs = J.rs; T.roff = J.roff; return T;
}
__device__ __forceinline__ void tt_load(const TTile& T, int t, f32x4 (&r)[4]) {
#pragma unroll
    for (int i = 0; i < 4; ++i) r[i] = *(const f32x4*)(T.src + (long)(T.k0 + (t >> 4) + 16 * i) * T.ldsrc + T.n0 + (t & 15) * 4);
}
__device__ __forceinline__ void tt_emit(const TTile& T, int t, float* ts, const f32x4 (&r)[4], bool active) {
    LDS_BARRIER();
    if (active) {
#pragma unroll
        for (int i = 0; i < 4; ++i) { const int k = (t >> 4) + 16 * i, n4 = (t & 15) * 4; ts[k * 65 + n4 + 0] = r[i][0]; ts[k * 65 + n4 + 1] = r[i][1]; ts[k * 65 + n4 + 2] = r[i][2]; ts[k * 65 + n4 + 3] = r[i][3]; }
    }
    LDS_BARRIER();
    if (active) {
        const int n = t >> 2, kq = (t & 3) * 16;
        unsigned w[8];
#pragma unroll
        for (int i = 0; i < 8; ++i) w[i] = pack2(ts[(kq + 2 * i) * 65 + n], ts[(kq + 2 * i + 1) * 65 + n]);
        const int nn = T.n0 + n, row = (nn / T.rb) * T.rs + T.roff + nn % T.rb;
        u32x4* o = (u32x4*)(T.dst + (long)row * T.ldd + T.k0 + kq);
        o[0] = (u32x4){w[0], w[1], w[2], w[3]}; o[1] = (u32x4){w[4], w[5], w[6], w[7]};
    }
}
template <int NJ>
__device__ __forceinline__ void transpose_tiles(const TJob* jobs) {
    const int t = TID() & 255, half = TID() >> 8;
    float* ts = (float*)LDS_BASE() + half * (64 * 65 + 16);
    int total = 0;
#pragma unroll
    for (int j = 0; j < NJ; ++j) total += jobs[j].batch * (jobs[j].K / 64) * (jobs[j].N / 64);
    const int G = (int)gridDim.x;
    f32x4 ra[4], rb[4];
    int gp = (int)blockIdx.x;
    if (gp * 2 + half < total) { const TTile T0 = tt_decode<NJ>(jobs, gp * 2 + half); tt_load(T0, t, ra); }
#pragma unroll 1
    for (; gp * 2 < total; gp += 2 * G) {
        {
            const int g = gp * 2 + half, gn = (gp + G) * 2 + half; const bool active = g < total;
            if (gn < total) { const TTile Tn = tt_decode<NJ>(jobs, gn); tt_load(Tn, t, rb); }
            const TTile T = tt_decode<NJ>(jobs, active ? g : 0);
            tt_emit(T, t, ts, ra, active);
        }
        if ((gp + G) * 2 < total) {
            const int g = (gp + G) * 2 + half, gn = (gp + 2 * G) * 2 + half; const bool active = g < total;
            if (gn < total) { const TTile Tn = tt_decode<NJ>(jobs, gn); tt_load(Tn, t, ra); }
            const TTile T = tt_decode<NJ>(jobs, active ? g : 0);
            tt_emit(T, t, ts, rb, active);
        }
    }
}

__device__ __forceinline__ void phase_prologue(const Params& p) {
    transpose_tiles<6>(p.jobs);
    const long gtid = (long)blockIdx.x * NTHREADS + TID(), gsz = (long)gridDim.x * NTHREADS;
    for (long i = gtid; i < 2L * 36 * 1024; i += gsz) {
        const int l = (int)(i / (36 * 1024)), n = (int)((i / 1024) % 36), k = (int)(i % 1024);
        p.WrT[i] = n < 4 ? p.rgw[((long)l * 1024 + k) * 4 + n] : p.rew[((long)l * 1024 + k) * 32 + (n - 4)];
    }
    for (long idx = gtid; idx < 32 * 64 * 16; idx += gsz) {
        const long i = idx >> 4; const int h = (int)(idx & 15);
        const int g = (int)(i / 64);
        const float dt = expf(p.log_dt[g]);
        const float lr = p.lam_re[i], li = p.lam_im[i];
        const float mag = expf(lr * dt), ar = mag * cosf(li * dt), ai = mag * sinf(li * dt);
        if (h == 0) {
            const float mag64 = expf(64.0f * lr * dt), ph64 = 64.0f * li * dt;
            p.s5a[i * 2] = ar; p.s5a[i * 2 + 1] = ai;
            p.s5a64[i * 2] = mag64 * cosf(ph64); p.s5a64[i * 2 + 1] = mag64 * sinf(ph64);
        }
        const float den = lr * lr + li * li, nr = ar - 1.0f, ni = ai;
        const float cr = (nr * lr + ni * li) / den, ci = (ni * lr - nr * li) / den;
        const float br = p.b_re[i * 16 + h], bi = p.b_im[i * 16 + h];
        p.s5bbr[i * 16 + h] = cr * br - ci * bi; p.s5bbi[i * 16 + h] = cr * bi + ci * br;
        const int pp = (int)(i % 64);
        p.s5bbm[((long)g * 128 + pp) * 16 + h] = f2bf(cr * br - ci * bi); p.s5bbm[((long)g * 128 + 64 + pp) * 16 + h] = f2bf(cr * bi + ci * br);
    }
    for (long i = gtid; i < 32 * 16 * 128; i += gsz) {
        const int p2 = (int)(i % 128); const long gk = i / 128;
        p.s5cm[i] = f2bf(p2 < 64 ? p.c_re[gk * 64 + p2] : -p.c_im[gk * 64 + (p2 - 64)]);
    }
    for (long i = gtid; i < 64; i += gsz) p.cnt[i] = 0;
}

#ifndef MOE_XCD
#define MOE_XCD 1
#endif
namespace pg8 {
#ifdef EMU
#define PG8_LAS
#define PG8_WAIT_V(n) do { } while (0)
#define PG8_WAIT_L(n) do { } while (0)
#else
#define PG8_LAS __attribute__((address_space(3)))
#define PG8_WAIT_V(n) asm volatile("s_waitcnt vmcnt(" #n ")" ::: "memory")
#define PG8_WAIT_L(n) asm volatile("s_waitcnt lgkmcnt(" #n ")" ::: "memory")
#endif
constexpr int BM = 256, BK = 64, HALF = 128, HTB = HALF * BK * 2  , STAGE_BYTES = 8 * HTB, NXCD = 8, WGM = 8;
__host__ __device__ __forceinline__ int lds_byte(int r, int c) { const int st = (r >> 4) * 2 + (c >> 5), rr = r & 15, cc = c & 31, ob = rr * 64 + cc * 2; return st * 1024 + (ob ^ (((ob >> 9) & 1) << 5)); }
__host__ __device__ __forceinline__ void stage_rc(int b, int& R, int& C) { const int st = b / 1024, sb = b % 1024, swz = sb ^ (((sb >> 9) & 1) << 5); R = (st >> 1) * 16 + swz / 64; C = (st & 1) * 32 + (swz % 64) / 2; }
__host__ __device__ __forceinline__ int perm32(int rho) { const int n = rho >> 4, i = rho & 15; return 8 * (i >> 2) + 4 * n + (i & 3); }

struct Unit { int arow, brow, pn, nvalid, lrow; };

struct DenseOrder {
    int nM, nN, nwg, G, c;
    __device__ __forceinline__ void init(int M, int N, int G_, int c_) { nM = M / BM; nN = N / BM; nwg = nM * nN; G = G_; c = c_; }
    __device__ __forceinline__ bool next(int i, Unit& u) const {
        const long L = (long)i * G + c; if (L >= nwg) return false;
        int wgid = (int)L; { const int q = nwg / NXCD, r = nwg % NXCD, xcd = wgid % NXCD, off = wgid / NXCD; wgid = (xcd < r ? xcd * (q + 1) : r * (q + 1) + (xcd - r) * q) + off; }
        const int nig = WGM * nN, gid = wgid / nig, fm = gid * WGM, gsz = (nM - fm) < WGM ? (nM - fm) : WGM;
        const int pm = fm + ((wgid % nig) % gsz), pn = (wgid % nig) / gsz;
        u.arow = pm * BM; u.brow = pn * BM; u.pn = pn; u.nvalid = BM; u.lrow = 0; return true;
    }
};
struct MoeOrder {
    const int* ustart; const int* rbase; const int* cntp; int G, c, npn, brows;
    __device__ __forceinline__ bool next(int i, Unit& u) const {
        const int L0 = i * G + c, nwg = ustart[32]; if (L0 >= nwg) return false;
        int L = L0; if (MOE_XCD) { const int q = nwg / NXCD, r = nwg % NXCD, xcd = L0 % NXCD, off = L0 / NXCD; L = (xcd < r ? xcd * (q + 1) : r * (q + 1) + (xcd - r) * q) + off; }
        int e = 0; while (ustart[e + 1] <= L) ++e;
        const int cn = cntp[e], ntile = (cn + BM - 1) / BM, local = L - ustart[e], ti = local % ntile, pn = local / ntile;
        u.arow = rbase[e] + ti * BM; u.brow = e * brows + pn * BM; u.pn = pn; u.nvalid = cn - ti * BM < BM ? cn - ti * BM : BM; u.lrow = e * LIST_CAP + ti * BM; return true;
    }
};

template <class Epi, class Sched, bool GATHER = false>
__device__ __forceinline__ void gemm_phase(PG8_LAS unsigned char* lds, const bf16_t* gA, const bf16_t* gBt, const int K, const Sched& S, const Epi& E, const int* list = nullptr) {
    const int tid = TID(), wid = __builtin_amdgcn_readfirstlane(tid >> 6), lane = tid & 63, wr = wid >> 2, wc = wid & 3, fr = lane & 15, fq = lane >> 4;
    const int nt = K / BK;
    unsigned voffA[2], voffB[2]; int Rl[2], Cl[2];
#pragma unroll
    for (int i = 0; i < 2; ++i) { int R, C; stage_rc(tid * 16 + i * 8192, R, C); const int Rb = Epi::PERM ? ((R & ~31) + perm32(R & 31)) : R;
        voffA[i] = (unsigned)(R * K + C) * 2u; voffB[i] = (unsigned)(Rb * K + C) * 2u; Rl[i] = R; Cl[i] = C; }
    unsigned aoC[2][2], aoN[2][2];
#define PG8_GATHER_OFFS(ao, u_) do { _Pragma("unroll") for (int h_ = 0; h_ < 2; ++h_) _Pragma("unroll") for (int i_ = 0; i_ < 2; ++i_) { \
        int pos_ = h_ * HALF + Rl[i_]; pos_ = pos_ < (u_).nvalid ? pos_ : (u_).nvalid - 1; \
        ao[h_][i_] = (unsigned)list[(u_).lrow + pos_] * (unsigned)(K * 2) + (unsigned)(Cl[i_] * 2); } } while (0)
#define PG8_STAGE_A(bufoff, aptr, h, kb, nx) do { if constexpr (GATHER) { unsigned ao_[2] = {(nx) ? aoN[h][0] : aoC[h][0], (nx) ? aoN[h][1] : aoC[h][1]}; \
        PG8_STAGE(bufoff, (const char*)gA + (kb), ao_); } else { PG8_STAGE(bufoff, (aptr) + (h) * hstep, voffA); } } while (0)
    const size_t kstep = (size_t)(BK * 2);
    const size_t hstep = (size_t)HALF * K * 2;
    const unsigned ldsw = (unsigned)wid * 1024u;
    const int aoff = lds_byte(wr * 64 + fr, fq * 8), boff = lds_byte(wc * 32 + fr, fq * 8);
#define PG8_SA(b, h) (((b) * 2 + (h)) * HTB)
#define PG8_SB(b, h) ((4 + (b) * 2 + (h)) * HTB)
#define PG8_STAGE(bufoff, gbase, voff) do { _Pragma("unroll") for (int _i = 0; _i < 2; ++_i) \
        __builtin_amdgcn_global_load_lds((const unsigned*)((const char*)(gbase) + (voff)[_i]), (PG8_LAS unsigned*)(lds + (bufoff) + ldsw + _i * 8192), 16, 0, 0); } while (0)
#define PG8_LDA(dst, b, h) do { _Pragma("unroll") for (int m = 0; m < 4; ++m) _Pragma("unroll") for (int k = 0; k < 2; ++k) dst[m][k] = *(const PG8_LAS bf16x8*)(lds + PG8_SA(b, h) + aoff + m * 2048 + k * 1024); } while (0)
#define PG8_LDB(dst, b, h) do { _Pragma("unroll") for (int n = 0; n < 2; ++n) _Pragma("unroll") for (int k = 0; k < 2; ++k) dst[n][k] = *(const PG8_LAS bf16x8*)(lds + PG8_SB(b, h) + boff + n * 2048 + k * 1024); } while (0)
#define PG8_MMA(ai, bj, At, Bt) do { __builtin_amdgcn_s_setprio(1); _Pragma("unroll") for (int m = 0; m < 4; ++m) _Pragma("unroll") for (int n = 0; n < 2; ++n) _Pragma("unroll") for (int k = 0; k < 2; ++k) \
        acc[ai][bj][m][n] = __builtin_amdgcn_mfma_f32_16x16x32_bf16(Bt[n][k], At[m][k], acc[ai][bj][m][n], 0, 0, 0); __builtin_amdgcn_s_setprio(0); } while (0)
#define PG8_BAR __builtin_amdgcn_s_barrier()
#define PG8_SCHED __builtin_amdgcn_sched_barrier(0)
    Unit cur, nxt; int ui = 0;
    if (!S.next(0, cur)) return;
    f32x4 acc[2][2][4][2];
#pragma unroll
    for (int a = 0; a < 2; ++a)
#pragma unroll
        for (int b = 0; b < 2; ++b)
#pragma unroll
            for (int m = 0; m < 4; ++m)
#pragma unroll
                for (int n = 0; n < 2; ++n) acc[a][b][m][n] = (f32x4){0.f, 0.f, 0.f, 0.f};
    bf16x8 At[4][2], B0[2][2], B1[2][2];
    const char* cA = (const char*)gA + (size_t)cur.arow * K * 2; const char* cB = (const char*)gBt + (size_t)cur.brow * K * 2;
    if constexpr (GATHER) { PG8_GATHER_OFFS(aoC, cur); }
    PG8_STAGE(PG8_SB(0, 0), cB, voffB); PG8_STAGE(PG8_SB(0, 1), cB + hstep, voffB); PG8_STAGE_A(PG8_SA(0, 0), cA, 0, 0, false); PG8_STAGE_A(PG8_SA(0, 1), cA, 1, 0, false);
    if (wr == 1) PG8_BAR;
    PG8_WAIT_V(2); PG8_BAR;
    PG8_STAGE(PG8_SB(1, 0), cB + kstep, voffB); PG8_STAGE_A(PG8_SA(1, 0), cA + kstep, 0, kstep, false); PG8_STAGE(PG8_SB(1, 1), cB + hstep + kstep, voffB);
    PG8_WAIT_V(6); PG8_BAR;
    for (;;) {
        const bool has_next = S.next(ui + 1, nxt);
        const char* nA = has_next ? (const char*)gA + (size_t)nxt.arow * K * 2 : cA; const char* nB = has_next ? (const char*)gBt + (size_t)nxt.brow * K * 2 : cB;
        if constexpr (GATHER) { if (has_next) { PG8_GATHER_OFFS(aoN, nxt); } }
        for (int t = 0; t < nt; t += 2) {
            const bool last = (t == nt - 2);
            const bool nx = last && has_next;
            const char* a1 = cA + (size_t)(t + 1) * kstep;
            const char* a2 = last ? nA : cA + (size_t)(t + 2) * kstep; const char* b2 = last ? nB : cB + (size_t)(t + 2) * kstep;
            const char* a3 = a2 + kstep; const char* b3 = b2 + kstep;
            const size_t k1 = (size_t)(t + 1) * kstep, k2 = last ? 0 : (size_t)(t + 2) * kstep, k3 = k2 + kstep;
            PG8_LDB(B0, 0, 0); PG8_LDB(B1, 0, 1); PG8_SCHED; PG8_LDA(At, 0, 0); PG8_STAGE_A(PG8_SA(1, 1), a1, 1, k1, false);
            PG8_WAIT_V(8); PG8_WAIT_L(0); PG8_BAR; PG8_MMA(0, 0, At, B0); PG8_MMA(0, 1, At, B1); PG8_BAR; PG8_SCHED;
            PG8_LDA(At, 0, 1); PG8_STAGE(PG8_SB(0, 0), b2, voffB); PG8_STAGE(PG8_SB(0, 1), b2 + hstep, voffB); PG8_STAGE_A(PG8_SA(0, 0), a2, 0, k2, nx);
            PG8_WAIT_V(8); PG8_WAIT_L(0); PG8_BAR; PG8_MMA(1, 0, At, B0); PG8_MMA(1, 1, At, B1); PG8_BAR; PG8_SCHED;
            PG8_LDB(B0, 1, 0); PG8_LDB(B1, 1, 1); PG8_SCHED; PG8_LDA(At, 1, 0); PG8_STAGE_A(PG8_SA(0, 1), a2, 1, k2, nx);
            PG8_WAIT_V(8); PG8_WAIT_L(0); PG8_BAR; PG8_MMA(0, 0, At, B0); PG8_MMA(0, 1, At, B1); PG8_BAR; PG8_SCHED;
            PG8_LDA(At, 1, 1); PG8_STAGE(PG8_SB(1, 0), b3, voffB); PG8_STAGE(PG8_SB(1, 1), b3 + hstep, voffB); PG8_STAGE_A(PG8_SA(1, 0), a3, 0, k3, nx);
            PG8_WAIT_V(8); PG8_WAIT_L(0); PG8_BAR; PG8_MMA(1, 0, At, B0); PG8_MMA(1, 1, At, B1); PG8_BAR; PG8_SCHED;
        }
        if (wr == 0) PG8_BAR;
        E(acc, cur, wr, wc, fr, fq);
        if (!has_next) break;
#pragma unroll
        for (int a = 0; a < 2; ++a)
#pragma unroll
            for (int b = 0; b < 2; ++b)
#pragma unroll
                for (int m = 0; m < 4; ++m)
#pragma unroll
                    for (int n = 0; n < 2; ++n) acc[a][b][m][n] = (f32x4){0.f, 0.f, 0.f, 0.f};
        cur = nxt; cA = nA; cB = nB; ++ui;
        if constexpr (GATHER) { _Pragma("unroll") for (int h_ = 0; h_ < 2; ++h_) _Pragma("unroll") for (int i_ = 0; i_ < 2; ++i_) aoC[h_][i_] = aoN[h_][i_]; }
        if (wr == 1) PG8_BAR;
    }
    PG8_WAIT_V(0);
    PG8_BAR;
#undef PG8_SA
#undef PG8_SB
#undef PG8_STAGE
#undef PG8_STAGE_A
#undef PG8_GATHER_OFFS
#undef PG8_LDA
#undef PG8_LDB
#undef PG8_MMA
#undef PG8_BAR
#undef PG8_SCHED
}

struct EpiStore {
    static constexpr bool PERM = true;
    bf16_t* C; int ldc;
    __device__ __forceinline__ void operator()(const f32x4 (&acc)[2][2][4][2], const Unit& u, int wr, int wc, int fr, int fq) const {
#pragma unroll
        for (int ai = 0; ai < 2; ++ai)
#pragma unroll
            for (int m = 0; m < 4; ++m) {
                bf16_t* rowp = C + (long)(u.arow + ai * HALF + wr * 64 + m * 16 + fr) * ldc + u.pn * BM + wc * 32 + 8 * fq;
#pragma unroll
                for (int bj = 0; bj < 2; ++bj) { const f32x4 v0 = acc[ai][bj][m][0], v1 = acc[ai][bj][m][1];
                    *(u32x4*)(rowp + bj * HALF) = (u32x4){pack2(v0[0], v0[1]), pack2(v0[2], v0[3]), pack2(v1[0], v1[1]), pack2(v1[2], v1[3])}; }
            }
    }
};
struct EpiGlu {
    static constexpr bool PERM = true;
    const bf16_t* y; bf16_t* ycat;
    __device__ __forceinline__ void operator()(const f32x4 (&acc)[2][2][4][2], const Unit& u, int wr, int wc, int fr, int fq) const {
#pragma unroll
        for (int ai = 0; ai < 2; ++ai)
#pragma unroll
            for (int m = 0; m < 4; ++m) {
                const long row = u.arow + ai * HALF + wr * 64 + m * 16 + fr;
#pragma unroll
                for (int bj = 0; bj < 2; ++bj) {
                    const int col = u.pn * BM + bj * HALF + wc * 32 + 8 * fq;
                    const u32x4 yy = *(const u32x4*)(y + row * 512 + col);
                    const f32x4 v0 = acc[ai][bj][m][0], v1 = acc[ai][bj][m][1];
                    float o[8];
#pragma unroll
                    for (int e = 0; e < 4; ++e) { o[e] = sigmoidf_(v0[e]); o[4 + e] = sigmoidf_(v1[e]); }
#pragma unroll
                    for (int e = 0; e < 4; ++e) { o[2 * e] *= bf2f((bf16_t)(yy[e] & 0xffff)); o[2 * e + 1] *= bf2f((bf16_t)(yy[e] >> 16)); }
                    *(u32x4*)(ycat + row * 1024 + 512 + col) = (u32x4){pack2(o[0], o[1]), pack2(o[2], o[3]), pack2(o[4], o[5]), pack2(o[6], o[7])};
                }
            }
    }
};
struct EpiMoe1 {
    static constexpr bool PERM = true;
    bf16_t* H;
    __device__ __forceinline__ void operator()(const f32x4 (&acc)[2][2][4][2], const Unit& u, int wr, int wc, int fr, int fq) const {
#pragma unroll
        for (int ai = 0; ai < 2; ++ai)
#pragma unroll
            for (int m = 0; m < 4; ++m) {
                const int rl = ai * HALF + wr * 64 + m * 16 + fr;
                if (rl < u.nvalid) {
                    float o[8];
#pragma unroll
                    for (int n = 0; n < 2; ++n)
#pragma unroll
                        for (int e = 0; e < 4; ++e) o[4 * n + e] = siluf_(acc[ai][0][m][n][e]) * acc[ai][1][m][n][e];
                    *(u32x4*)(H + (long)(u.arow + rl) * EFF + u.pn * HALF + wc * 32 + 8 * fq) = (u32x4){pack2(o[0], o[1]), pack2(o[2], o[3]), pack2(o[4], o[5]), pack2(o[6], o[7])};
                }
            }
    }
};
struct EpiMoe2 {
    static constexpr bool PERM = true;
    bf16_t* Y; const float* gate;
    __device__ __forceinline__ void operator()(const f32x4 (&acc)[2][2][4][2], const Unit& u, int wr, int wc, int fr, int fq) const {
#pragma unroll
        for (int ai = 0; ai < 2; ++ai)
#pragma unroll
            for (int m = 0; m < 4; ++m) {
                const int rl = ai * HALF + wr * 64 + m * 16 + fr;
                if (rl < u.nvalid) {
                    const float g = gate[u.lrow + rl];
                    bf16_t* rowp = Y + (long)(u.arow + rl) * DM + u.pn * BM + wc * 32 + 8 * fq;
#pragma unroll
                    for (int bj = 0; bj < 2; ++bj) { const f32x4 v0 = acc[ai][bj][m][0] * g, v1 = acc[ai][bj][m][1] * g;
                        *(u32x4*)(rowp + bj * HALF) = (u32x4){pack2(v0[0], v0[1]), pack2(v0[2], v0[3]), pack2(v1[0], v1[1]), pack2(v1[2], v1[3])}; }
                }
            }
    }
};
}

template <class Epi>
__device__ __forceinline__ void gemm_dense(const bf16_t* A, const bf16_t* Bt, int M, int N, int K, const Epi& E) {
    pg8::DenseOrder S; S.init(M, N, (int)gridDim.x, (int)blockIdx.x);
    pg8::gemm_phase<Epi, pg8::DenseOrder>((PG8_LAS unsigned char*)LDS_BASE(), A, Bt, K, S, E);
}

__device__ __forceinline__ void phase_ba(const Params& p) {
    float* wl = (float*)LDS_BASE();
    {
        float v_[16];
#pragma unroll
        for (int j = 0; j < 16; ++j) { const int i = TID() + NTHREADS * j; v_[j] = p.w_in[(long)(i >> 3) * 2568 + 2048 + (i & 7)]; }
#pragma unroll
        for (int j = 0; j < 16; ++j) { const int i = TID() + NTHREADS * j; wl[(i & 7) * 1024 + (i >> 3)] = v_[j]; }
    }
    __syncthreads();
    const int lane = TID() & 63, gw = blockIdx.x * NW + (TID() >> 6), nw = gridDim.x * NW;
    constexpr int TPI = 4;
    for (int grp = gw; grp < NT / TPI; grp += nw) {
        const long tok0 = (long)grp * TPI;
        f32x4 xv[TPI][4];
#pragma unroll
        for (int tt = 0; tt < TPI; ++tt)
#pragma unroll
            for (int i = 0; i < 4; ++i) xv[tt][i] = *(const f32x4*)(p.x + (tok0 + tt) * DM + 4 * lane + 256 * i);
#pragma unroll
        for (int tt = 0; tt < TPI; ++tt)
#pragma unroll
            for (int i = 0; i < 4; ++i) *(u32x2*)(p.hb + (tok0 + tt) * DM + 4 * lane + 256 * i) = (u32x2){pack2(xv[tt][i][0], xv[tt][i][1]), pack2(xv[tt][i][2], xv[tt][i][3])};
        float acc[TPI][8];
#pragma unroll
        for (int tt = 0; tt < TPI; ++tt)
#pragma unroll
            for (int n = 0; n < 8; ++n) acc[tt][n] = 0.f;
#pragma unroll
        for (int i = 0; i < 4; ++i)
#pragma unroll
            for (int n = 0; n < 8; ++n) {
                const f32x4 wv = *(const f32x4*)(wl + n * 1024 + 4 * lane + 256 * i);
#pragma unroll
                for (int tt = 0; tt < TPI; ++tt) acc[tt][n] += (xv[tt][i][0] * wv[0] + xv[tt][i][1] * wv[1]) + (xv[tt][i][2] * wv[2] + xv[tt][i][3] * wv[3]);
            }
#pragma unroll
        for (int o = 32; o > 0; o >>= 1)
#pragma unroll
            for (int tt = 0; tt < TPI; ++tt)
#pragma unroll
                for (int n = 0; n < 8; ++n) acc[tt][n] += __shfl_xor(acc[tt][n], o);
        if (lane < 4) {
#pragma unroll
            for (int tt = 0; tt < TPI; ++tt) {
                const float bl = lane == 0 ? acc[tt][0] : lane == 1 ? acc[tt][1] : lane == 2 ? acc[tt][2] : acc[tt][3];
                const float al = lane == 0 ? acc[tt][4] : lane == 1 ? acc[tt][5] : lane == 2 ? acc[tt][6] : acc[tt][7];
                const float xx = al + p.dt_bias[lane];
                const float sp = xx > 20.f ? xx : log1pf(expf(xx));
                p.gbeta[(tok0 + tt) * 4 + lane] = 1.0f / (1.0f + expf(-bl));
                p.gg[(tok0 + tt) * 4 + lane] = -expf(p.a_log[lane]) * sp;
            }
        }
    }
}

__device__ __forceinline__ void phase_gdn_prep(const Params& p) {
    const int t = TID(), lane = t & 63, w = t >> 6;
    constexpr int RUN = 16;
    const int nitems = (NT / RUN) * 3;
    for (int item = (int)blockIdx.x * NW + w; item < nitems; item += (int)gridDim.x * NW) {
        const int i = item % 3, run = item / 3;
        const long tok0 = (long)run * RUN; const int s0 = (int)(tok0 % NS_);
        const int cb = i * 512 + lane * 8;
        u32x4 x[RUN + 3];
#pragma unroll
        for (int j = 0; j < 3; ++j) x[j] = s0 > 0 ? *(const u32x4*)(p.proj + (tok0 - 3 + j) * PROJ_LD + cb) : (u32x4){0u, 0u, 0u, 0u};
#pragma unroll
        for (int k = 0; k < RUN; ++k) x[3 + k] = *(const u32x4*)(p.proj + (tok0 + k) * PROJ_LD + cb);
        f32x4 wv[4][2];
#pragma unroll
        for (int j = 0; j < 4; ++j) { wv[j][0] = *(const f32x4*)(p.conv + j * 1536 + cb); wv[j][1] = *(const f32x4*)(p.conv + j * 1536 + cb + 4); }
        bf16_t* dst = (i == 0 ? p.gq : i == 1 ? p.gk : p.gv) + tok0 * 512 + lane * 8;
#pragma unroll
        for (int k = 0; k < RUN; ++k) {
            float a[8];
#pragma unroll
            for (int e = 0; e < 8; ++e) a[e] = 0.f;
#pragma unroll
            for (int j = 0; j < 4; ++j) {
                const u32x4 xv = x[k + j];
                a[0] += wv[j][0][0] * bf2f((bf16_t)(xv[0] & 0xffff)); a[1] += wv[j][0][1] * bf2f((bf16_t)(xv[0] >> 16));
                a[2] += wv[j][0][2] * bf2f((bf16_t)(xv[1] & 0xffff)); a[3] += wv[j][0][3] * bf2f((bf16_t)(xv[1] >> 16));
                a[4] += wv[j][1][0] * bf2f((bf16_t)(xv[2] & 0xffff)); a[5] += wv[j][1][1] * bf2f((bf16_t)(xv[2] >> 16));
                a[6] += wv[j][1][2] * bf2f((bf16_t)(xv[3] & 0xffff)); a[7] += wv[j][1][3] * bf2f((bf16_t)(xv[3] >> 16));
            }
            float ss = 0.f;
#pragma unroll
            for (int e = 0; e < 8; ++e) { a[e] = siluf_(a[e]); ss += a[e] * a[e]; }
            if (i < 2) {
                ss += __shfl_xor(ss, 1); ss += __shfl_xor(ss, 2); ss += __shfl_xor(ss, 4); ss += __shfl_xor(ss, 8);
                const float sc = rsqrtf(ss + 1e-6f);
#pragma unroll
                for (int e = 0; e < 8; ++e) a[e] *= sc;
            }
            *(u32x4*)(dst + (long)k * 512) = (u32x4){pack2(a[0], a[1]), pack2(a[2], a[3]), pack2(a[4], a[5]), pack2(a[6], a[7])};
        }
    }
}

#ifndef FUSE_PREP
#define FUSE_PREP 1
#endif
constexpr int CLD = 136;
__device__ __forceinline__ void phase_gdn_chunk(const Params& p) {
    const int half = TID() >> 8;
    char* lds = LDS_BASE() + half * 70656;
    float* gc = (float*)lds; float* be = gc + 64; float* eg = be + 64; float* ek = eg + 64; float* bek = ek + 64;
    float* Ls = (float*)(lds + 1280);
    bf16_t* vs = (bf16_t*)(lds + 1280 + 16384); bf16_t* ks = vs + 64 * CLD; bf16_t* qs = ks + 64 * CLD;
    const int t = TID() & 255, lane = t & 63, w = t >> 6, fr = lane & 15, fq = lane >> 4;
    const int nunits = NB_ * 4 * NCH;
    for (int up = blockIdx.x; up * 2 < nunits; up += gridDim.x) {
        const int u = up * 2 + half;
        const int n = u % NCH, hh = (u / NCH) & 3, b = u / (NCH * 4);
        const long tok0 = (long)b * NS_ + n * 64;
        LDS_BARRIER();
#if FUSE_PREP
        {
            const int rg = t >> 4, ch = (t & 15) * 8;
            const int s0 = n * 64 + 4 * rg;
#pragma unroll
            for (int X = 0; X < 3; ++X) {
                const int col = X * 512 + hh * 128 + ch;
                u32x4 x[7];
#pragma unroll
                for (int j = 0; j < 7; ++j) x[j] = (s0 - 3 + j) >= 0 ? *(const u32x4*)(p.proj + (tok0 + 4 * rg - 3 + j) * PROJ_LD + col) : (u32x4){0u, 0u, 0u, 0u};
                f32x4 wv[4][2];
#pragma unroll
                for (int j = 0; j < 4; ++j) { wv[j][0] = *(const f32x4*)(p.conv + j * 1536 + col); wv[j][1] = *(const f32x4*)(p.conv + j * 1536 + col + 4); }
                bf16_t* dl = X == 0 ? qs : X == 1 ? ks : vs;
#pragma unroll
                for (int i = 0; i < 4; ++i) {
                    float a[8];
#pragma unroll
                    for (int e = 0; e < 8; ++e) a[e] = 0.f;
#pragma unroll
                    for (int j = 0; j < 4; ++j) {
                        const u32x4 xv = x[i + j];
                        a[0] += wv[j][0][0] * bf2f((bf16_t)(xv[0] & 0xffff)); a[1] += wv[j][0][1] * bf2f((bf16_t)(xv[0] >> 16));
                        a[2] += wv[j][0][2] * bf2f((bf16_t)(xv[1] & 0xffff)); a[3] += wv[j][0][3] * bf2f((bf16_t)(xv[1] >> 16));
                        a[4] += wv[j][1][0] * bf2f((bf16_t)(xv[2] & 0xffff)); a[5] += wv[j][1][1] * bf2f((bf16_t)(xv[2] >> 16));
                        a[6] += wv[j][1][2] * bf2f((bf16_t)(xv[3] & 0xffff)); a[7] += wv[j][1][3] * bf2f((bf16_t)(xv[3] >> 16));
                    }
                    float ss = 0.f;
#pragma unroll
                    for (int e = 0; e < 8; ++e) { a[e] = siluf_(a[e]); ss += a[e] * a[e]; }
                    if (X < 2) {
                        ss += __shfl_xor(ss, 1); ss += __shfl_xor(ss, 2); ss += __shfl_xor(ss, 4); ss += __shfl_xor(ss, 8);
                        const float sc = rsqrtf(ss + 1e-6f);
#pragma unroll
                        for (int e = 0; e < 8; ++e) a[e] *= sc;
                    }
                    *(u32x4*)(dl + (4 * rg + i) * CLD + ch) = (u32x4){pack2(a[0], a[1]), pack2(a[2], a[3]), pack2(a[4], a[5]), pack2(a[6], a[7])};
                }
            }
        }
#else
#pragma unroll
        for (int i = 0; i < 4; ++i) {
            const int c = t + 256 * i, row = c >> 4, ch = (c & 15) * 8;
            const long go_ = (tok0 + row) * 512 + hh * 128 + ch;
            *(u32x4*)(qs + row * CLD + ch) = *(const u32x4*)(p.gq + go_);
            *(u32x4*)(ks + row * CLD + ch) = *(const u32x4*)(p.gk + go_);
            *(u32x4*)(vs + row * CLD + ch) = *(const u32x4*)(p.gv + go_);
        }
#endif
        if (w == 0) {
            float v = p.gg[(tok0 + lane) * 4 + hh];
#pragma unroll
            for (int o = 1; o < 64; o <<= 1) { const float nb = __shfl_up(v, o); if (lane >= o) v += nb; }
            const float gl = __shfl(v, 63);
            const float bt = p.gbeta[(tok0 + lane) * 4 + hh];
            gc[lane] = v; be[lane] = bt; eg[lane] = expf(v); ek[lane] = expf(gl - v); bek[lane] = bt * expf(v);
            if (lane == 0) WT_STORE_F(p.cgl + u, expf(gl));
        }
        LDS_BARRIER();
        {
            f32x4 akk[4], aqk[4];
#pragma unroll
            for (int nn = 0; nn < 4; ++nn) { akk[nn] = (f32x4){0.f, 0.f, 0.f, 0.f}; aqk[nn] = (f32x4){0.f, 0.f, 0.f, 0.f}; }
#pragma unroll
            for (int k4 = 0; k4 < 4; ++k4) {
                const bf16x8 afk = *(const bf16x8*)(ks + (16 * w + fr) * CLD + k4 * 32 + fq * 8);
                const bf16x8 afq = *(const bf16x8*)(qs + (16 * w + fr) * CLD + k4 * 32 + fq * 8);
#pragma unroll
                for (int nn = 0; nn < 4; ++nn) {
                    const bf16x8 bfr = *(const bf16x8*)(ks + (16 * nn + fr) * CLD + k4 * 32 + fq * 8);
                    akk[nn] = __builtin_amdgcn_mfma_f32_16x16x32_bf16(bfr, afk, akk[nn], 0, 0, 0);
                    aqk[nn] = __builtin_amdgcn_mfma_f32_16x16x32_bf16(bfr, afq, aqk[nn], 0, 0, 0);
                }
            }
            const int i = 16 * w + fr; const float gci = gc[i], bei = be[i];
#pragma unroll
            for (int nn = 0; nn < 4; ++nn) {
                const int j0 = 16 * nn + 4 * fq;
                f32x4 lv; float qv[4];
#pragma unroll
                for (int r = 0; r < 4; ++r) {
                    const int j = j0 + r;
                    const float dec = i >= j ? expf(gci - gc[j]) : 0.f;
                    lv[r] = i > j ? bei * akk[nn][r] * dec : 0.f;
                    qv[r] = 0.08838834764831845f * aqk[nn][r] * dec;
                }
                *(f32x4*)(Ls + i * 64 + j0) = lv;
                *(u32x2*)(p.cQK + (long)u * 8192 + i * 64 + j0) = (u32x2){pack2(qv[0], qv[1]), pack2(qv[2], qv[3])};
            }
        }
        LDS_BARRIER();
        {
            const int c = t & 127; const bf16_t* src = t < 128 ? vs : ks; const float* mulp = t < 128 ? be : bek;
            float x[64];
#pragma unroll
            for (int i = 0; i < 64; ++i) {
                float a = mulp[i] * bf2f(src[i * CLD + c]);
#pragma unroll
                for (int j4 = 0; j4 < (i + 3) / 4; ++j4) {
                    const f32x4 l4 = *(const f32x4*)(Ls + i * 64 + 4 * j4);
                    if (4 * j4 + 0 < i) a = fmaf(-l4[0], x[4 * j4 + 0], a);
                    if (4 * j4 + 1 < i) a = fmaf(-l4[1], x[4 * j4 + 1], a);
                    if (4 * j4 + 2 < i) a = fmaf(-l4[2], x[4 * j4 + 2], a);
                    if (4 * j4 + 3 < i) a = fmaf(-l4[3], x[4 * j4 + 3], a);
                }
                x[i] = a;
                asm volatile("" ::: "memory");
            }
            LDS_BARRIER();
            bf16_t* Wt = (bf16_t*)Ls;
            if (t < 128) {
#pragma unroll
                for (int i = 0; i < 64; ++i) vs[i * CLD + c] = f2bf(x[i]);
            } else {
#pragma unroll
                for (int i = 0; i < 64; ++i) Wt[i * 128 + c] = f2bf(x[i]);
            }
        }
        LDS_BARRIER();
#pragma unroll
        for (int e = 0; e < 4; ++e) {
            const int id = t + 256 * e, row = id >> 4, ch = (id & 15) * 8;
            *(u32x4*)(p.cU + (long)u * 8192 + row * 128 + ch) = *(const u32x4*)(vs + row * CLD + ch);
            *(u32x4*)(p.cW + (long)u * 8192 + row * 128 + ch) = *(const u32x4*)((const bf16_t*)Ls + row * 128 + ch);
            {
                const u32x4 qv = *(const u32x4*)(qs + row * CLD + ch); const float sc = 0.08838834764831845f * eg[row];
                unsigned o4[4];
#pragma unroll
                for (int k = 0; k < 4; ++k) o4[k] = pack2(bf2f((bf16_t)(qv[k] & 0xffff)) * sc, bf2f((bf16_t)(qv[k] >> 16)) * sc);
                *(u32x4*)(p.cQd + (long)u * 8192 + row * 128 + ch) = (u32x4){o4[0], o4[1], o4[2], o4[3]};
            }
            {
                const int d = id >> 3, i0 = (id & 7) * 8;
                float kv[8];
#pragma unroll
                for (int k = 0; k < 8; ++k) kv[k] = bf2f(ks[(i0 + k) * CLD + d]) * ek[i0 + k];
                *(u32x4*)(p.cKdT + (long)u * 8192 + d * 64 + i0) = (u32x4){pack2(kv[0], kv[1]), pack2(kv[2], kv[3]), pack2(kv[4], kv[5]), pack2(kv[6], kv[7])};
            }
        }
    }
}

#define GO_STORE(ptr, lo, hi) (*(u32x2*)(ptr) = (u32x2){(lo), (hi)})
#ifndef SCAN_XCD_REMAP
#define SCAN_XCD_REMAP 1
#endif
struct ScanOwn { bf16x8 f[7]; u32x2 uvr; };
__device__ __forceinline__ const bf16_t* scan_slot_ptr(const Params& p, int s, int w, int fr, int fq) {
    if (s < 4) return p.cW + (16 * w + fr) * 128 + s * 32 + fq * 8;
    if (s < 8) return p.cQd + (16 * w + fr) * 128 + (s - 4) * 32 + fq * 8;
    if (s < 12) return p.cKdT + (32 * w + 16 * ((s - 8) >> 1) + fr) * 64 + ((s - 8) & 1) * 32 + fq * 8;
    return p.cQK + (16 * w + fr) * 64 + (s - 12) * 32 + fq * 8;
}
#define SCAN_LOAD(P, cu_) do { const long co_ = (long)(cu_) * 8192; \
        _Pragma("unroll") for (int j = 0; j < 7; ++j) P.f[j] = *(const bf16x8*)(sp[j] + co_); \
        P.uvr = *(const u32x2*)(up + co_); } while (0)
#define SCAN_STEP(Pw, n_) do { \
        const long cu_ = cu0 + (n_); const long tokr = (long)b * NS_ + (n_) * 64 + 16 * w + fr; \
        bf16x8 sb[4]; \
        _Pragma("unroll") for (int k4 = 0; k4 < 4; ++k4) sb[k4] = *(const bf16x8*)(SbT + fr * CLD + k4 * 32 + fq * 8); \
        f32x4 vw = (f32x4){0.f, 0.f, 0.f, 0.f}, o = (f32x4){0.f, 0.f, 0.f, 0.f}; \
        _Pragma("unroll") for (int k4 = 0; k4 < 4; ++k4) { vw = __builtin_amdgcn_mfma_f32_16x16x32_bf16(sb[k4], F[k4], vw, 0, 0, 0); o = __builtin_amdgcn_mfma_f32_16x16x32_bf16(sb[k4], F[4 + k4], o, 0, 0, 0); } \
          \
        { const u32x2 uvc = *(const u32x2*)ub; const unsigned u0_ = uvc[0], u1_ = uvc[1]; \
          VnT[(4 * fq + 0) * 72 + 16 * w + fr] = f2bf(bf2f((bf16_t)(u0_ & 0xffff)) - vw[0]); VnT[(4 * fq + 1) * 72 + 16 * w + fr] = f2bf(bf2f((bf16_t)(u0_ >> 16)) - vw[1]); \
          VnT[(4 * fq + 2) * 72 + 16 * w + fr] = f2bf(bf2f((bf16_t)(u1_ & 0xffff)) - vw[2]); VnT[(4 * fq + 3) * 72 + 16 * w + fr] = f2bf(bf2f((bf16_t)(u1_ >> 16)) - vw[3]); } \
        LDS_BARRIER(); \
        _Pragma("unroll") for (int j = 0; j < 7; ++j) *(bf16x8*)(xw + j * 512) = Pw.f[j];                   \
        *(u32x2*)ub = Pw.uvr;                                                                                \
        const float glc = glbuf[(n_)]; \
        bf16x8 vb[2]; \
        _Pragma("unroll") for (int k2 = 0; k2 < 2; ++k2) vb[k2] = *(const bf16x8*)(VnT + fr * 72 + k2 * 32 + fq * 8); \
        _Pragma("unroll") for (int k2 = 0; k2 < 2; ++k2) o = __builtin_amdgcn_mfma_f32_16x16x32_bf16(vb[k2], F[12 + k2], o, 0, 0, 0); \
        GO_STORE((p.go + tokr * 512 + hh * 128 + vsl * 16 + 4 * fq), pack2(o[0], o[1]), pack2(o[2], o[3])); \
        _Pragma("unroll") for (int m = 0; m < 2; ++m) { \
            sacc[m] = sacc[m] * glc; \
            _Pragma("unroll") for (int k2 = 0; k2 < 2; ++k2) sacc[m] = __builtin_amdgcn_mfma_f32_16x16x32_bf16(F[8 + 2 * m + k2], vb[k2], sacc[m], 0, 0, 0); \
            *(u32x2*)(SbT + fr * CLD + 32 * w + 16 * m + 4 * fq) = (u32x2){pack2(sacc[m][0], sacc[m][1]), pack2(sacc[m][2], sacc[m][3])}; \
        } \
        LDS_BARRIER(); \
        _Pragma("unroll") for (int k = 0; k < 14; ++k) F[k] = *(const bf16x8*)(xr + k * 512);                \
        { const long c3_ = cu_ + 3 < culast ? cu_ + 3 : culast; SCAN_LOAD(Pw, c3_); } \
    } while (0)
#ifdef EMU
#define PIN2(a, b) do { } while (0)
#else
#define PIN2(a, b) asm volatile("" : "+v"(a), "+v"(b))
#endif
__device__ __forceinline__ void phase_gdn_scan(const Params& p, int nblk) {
    const int half = TID() >> 8;
    bf16_t* SbT = (bf16_t*)(LDS_BASE() + half * 8192);
    bf16_t* VnT = SbT + 16 * CLD;
    const int t = TID() & 255, lane = t & 63, w = t >> 6, fr = lane & 15, fq = lane >> 4;
    bf16_t* xbuf = (bf16_t*)(LDS_BASE() + 16384) + w * (14 * 512);
    bf16_t* xw = xbuf + half * (7 * 512) + lane * 8; const bf16_t* xr = xbuf + lane * 8;
    unsigned* ub = (unsigned*)(LDS_BASE() + 16384 + 4 * 14336) + ((half * 4 + w) * 64 + lane) * 2;
    float* glbuf = (float*)(LDS_BASE() + 16384 + 4 * 14336 + 4096);
    const int nunits = NB_ * 4 * 8;
    for (int x = blockIdx.x; x * 2 < nunits; x += nblk) {
        int up_ = x;
        if (SCAN_XCD_REMAP && (nblk & 31) == 0 && (nunits & 63) == 0) { const int xcd = x & 7, slot = x >> 3; up_ = 4 * ((slot >> 2) * 8 + xcd) + (slot & 3); }
        const int u = up_ * 2 + half;
        const int vsl = u & 7, hh = (u >> 3) & 3, b = u >> 5;
        const long cu0 = (long)(b * 4 + hh) * NCH, culast = cu0 + NCH - 1;
        const bf16_t* sp[7];
#pragma unroll
        for (int j = 0; j < 7; ++j) { const bf16_t* p0 = scan_slot_ptr(p, j, w, fr, fq); const bf16_t* p1 = scan_slot_ptr(p, 7 + j, w, fr, fq); sp[j] = half ? p1 : p0; }
        const bf16_t* up = p.cU + (16 * w + fr) * 128 + vsl * 16 + 4 * fq;
        LDS_BARRIER();
        for (int i = t; i < 16 * CLD; i += 256) SbT[i] = 0;
        f32x4 sacc[2] = {(f32x4){0.f, 0.f, 0.f, 0.f}, (f32x4){0.f, 0.f, 0.f, 0.f}};
        ScanOwn PA, PB; bf16x8 F[14];
        for (int i = TID(); i < NCH; i += NTHREADS) glbuf[i] = p.cgl[cu0 + i];
        SCAN_LOAD(PA, cu0); { const long c1_ = cu0 + 1 < culast ? cu0 + 1 : culast; SCAN_LOAD(PB, c1_); }
#pragma unroll
        for (int j = 0; j < 7; ++j) *(bf16x8*)(xw + j * 512) = PA.f[j];
        *(u32x2*)ub = PA.uvr;
        LDS_BARRIER();
#pragma unroll
        for (int k = 0; k < 14; ++k) F[k] = *(const bf16x8*)(xr + k * 512);
        { const long c2_ = cu0 + 2 < culast ? cu0 + 2 : culast; SCAN_LOAD(PA, c2_); }
        int n = 0;
#pragma unroll 1
        for (; n + 2 <= NCH; n += 2) {
            SCAN_STEP(PB, n);
            SCAN_STEP(PA, n + 1);
        }
    }
}
#undef SCAN_STEP
#undef SCAN_LOAD

__device__ __forceinline__ void phase_gdn_post(const Params& p) {
    const int lane = TID() & 63; const int gw = blockIdx.x * NW + (TID() >> 6), nw = gridDim.x * NW;
    const f32x4 nw0 = *(const f32x4*)(p.gnorm + (lane & 15) * 8), nw1 = *(const f32x4*)(p.gnorm + (lane & 15) * 8 + 4);
    for (int g8 = gw; g8 < NT / 8; g8 += nw) {
        const long tok0 = (long)g8 * 8;
        u32x4 ov[8], zv[8];
#pragma unroll
        for (int k = 0; k < 8; ++k) { ov[k] = *(const u32x4*)(p.go + (tok0 + k) * 512 + lane * 8); zv[k] = *(const u32x4*)(p.proj + (tok0 + k) * PROJ_LD + 1536 + lane * 8); }
#pragma unroll
        for (int k = 0; k < 8; ++k) {
            float o[8], z[8];
#pragma unroll
            for (int e = 0; e < 4; ++e) { o[2 * e] = bf2f((bf16_t)(ov[k][e] & 0xffff)); o[2 * e + 1] = bf2f((bf16_t)(ov[k][e] >> 16)); z[2 * e] = bf2f((bf16_t)(zv[k][e] & 0xffff)); z[2 * e + 1] = bf2f((bf16_t)(zv[k][e] >> 16)); }
            float ss = 0.f;
#pragma unroll
            for (int e = 0; e < 8; ++e) ss += o[e] * o[e];
            ss += __shfl_xor(ss, 1); ss += __shfl_xor(ss, 2); ss += __shfl_xor(ss, 4); ss += __shfl_xor(ss, 8);
            const float rs = rsqrtf(ss * (1.0f / 128.0f) + 1e-6f);
            float r[8];
#pragma unroll
            for (int e = 0; e < 4; ++e) { r[e] = o[e] * rs * nw0[e] * siluf_(z[e]); r[4 + e] = o[4 + e] * rs * nw1[e] * siluf_(z[4 + e]); }
            *(u32x4*)(p.ycat + (tok0 + k) * 1024 + lane * 8) = (u32x4){pack2(r[0], r[1]), pack2(r[2], r[3]), pack2(r[4], r[5]), pack2(r[6], r[7])};
        }
    }
}

__device__ __forceinline__ float gelu_tanh(float x) { return 0.5f * x * (1.0f + tanhf(0.7978845608028654f * (x + 0.044715f * x * x * x))); }
#ifndef S5_CARRY
#define S5_CARRY 1
#endif
#ifdef EMU
#define CARRY_PIN(a, b) do { } while (0)
#else
#define CARRY_PIN(a, b) asm volatile("" : "+v"(a), "+v"(b))
#endif
#define WAVE_SYNC() LDS_BARRIER()
constexpr int S5_NSEG1 = NCH >= 16 ? 8 : NCH / 2, S5_NSEG2 = NCH >= 8 ? 4 : NCH / 2;
struct S5Task { bf16x8 bfm[8]; bf16x8 cf[4]; float ar, ai; f32x4 dsk; };
struct S5In { bf16x8 uf[4]; u32x2 uu[4]; };
template <int PASS>
__device__ __forceinline__ void s5_task_init(const Params& p, S5Task& T, int g, int lane, int fr, int fq) {
    bf16x8 zf;
#pragma unroll
    for (int e = 0; e < 8; ++e) zf[e] = 0;
#pragma unroll
    for (int nt = 0; nt < 8; ++nt) T.bfm[nt] = fq < 2 ? *(const bf16x8*)(p.s5bbm + ((long)g * 128 + 16 * nt + fr) * 16 + 8 * fq) : zf;
    if (PASS == 2) {
#pragma unroll
        for (int k4 = 0; k4 < 4; ++k4) T.cf[k4] = *(const bf16x8*)(p.s5cm + (g * 16 + fr) * 128 + k4 * 32 + fq * 8);
        T.dsk = *(const f32x4*)(p.s5d + g * 16 + 4 * fq);
    }
    T.ar = p.s5a[(g * 64 + lane) * 2]; T.ai = p.s5a[(g * 64 + lane) * 2 + 1];
}
template <int PASS>
__device__ __forceinline__ void s5_load(const Params& p, S5In& I, int g, long tok0, int fr, int fq) {
    bf16x8 zf;
#pragma unroll
    for (int e = 0; e < 8; ++e) zf[e] = 0;
#pragma unroll
    for (int mt = 0; mt < 4; ++mt) I.uf[mt] = fq < 2 ? *(const bf16x8*)(p.proj + (tok0 + 16 * mt + fr) * PROJ_LD + 2048 + g * 16 + 8 * fq) : zf;
    if (PASS == 2) {
#pragma unroll
        for (int mt = 0; mt < 4; ++mt) I.uu[mt] = *(const u32x2*)(p.proj + (tok0 + 16 * mt + fr) * PROJ_LD + 2048 + g * 16 + 4 * fq);
    }
}
template <int PASS>
__device__ __forceinline__ void s5_unit(const Params& p, bf16_t* hs, const S5Task& T, const S5In& I, int g, long tok0, float& hr, float& hi, int lane, int fr, int fq) {
#pragma unroll
    for (int nt = 0; nt < 8; ++nt)
#pragma unroll
        for (int mt = 0; mt < 4; ++mt) {
            f32x4 d = (f32x4){0.f, 0.f, 0.f, 0.f};
            d = __builtin_amdgcn_mfma_f32_16x16x32_bf16(T.bfm[nt], I.uf[mt], d, 0, 0, 0);
            *(u32x2*)(hs + (16 * mt + fr) * CLD + 16 * nt + 4 * fq) = (u32x2){pack2(d[0], d[1]), pack2(d[2], d[3])};
        }
    WAVE_SYNC();
    const float ar = T.ar, ai = T.ai;
#pragma unroll 8
    for (int j = 0; j < 64; ++j) {
        const float br = bf2f(hs[j * CLD + lane]), bi = bf2f(hs[j * CLD + 64 + lane]);
        const float nr = ar * hr - ai * hi + br, ni = ar * hi + ai * hr + bi;
        hr = nr; hi = ni;
        if (PASS == 2) { hs[j * CLD + lane] = f2bf(hr); hs[j * CLD + 64 + lane] = f2bf(hi); }
    }
    if (PASS == 2) {
        WAVE_SYNC();
        f32x4 acc[4];
#pragma unroll
        for (int mt = 0; mt < 4; ++mt) acc[mt] = (f32x4){0.f, 0.f, 0.f, 0.f};
#pragma unroll
        for (int k4 = 0; k4 < 4; ++k4)
#pragma unroll
            for (int mt = 0; mt < 4; ++mt) {
                const bf16x8 hf = *(const bf16x8*)(hs + (16 * mt + fr) * CLD + k4 * 32 + fq * 8);
                acc[mt] = __builtin_amdgcn_mfma_f32_16x16x32_bf16(T.cf[k4], hf, acc[mt], 0, 0, 0);
            }
#pragma unroll
        for (int mt = 0; mt < 4; ++mt) {
            const int j = 16 * mt + fr;
            const u32x2 uu = I.uu[mt];
            const float y0 = acc[mt][0] + T.dsk[0] * bf2f((bf16_t)(uu[0] & 0xffff)), y1 = acc[mt][1] + T.dsk[1] * bf2f((bf16_t)(uu[0] >> 16));
            const float y2 = acc[mt][2] + T.dsk[2] * bf2f((bf16_t)(uu[1] & 0xffff)), y3 = acc[mt][3] + T.dsk[3] * bf2f((bf16_t)(uu[1] >> 16));
            *(u32x2*)(p.ygelu + (tok0 + j) * 512 + g * 16 + 4 * fq) = (u32x2){pack2(gelu_tanh(y0), gelu_tanh(y1)), pack2(gelu_tanh(y2), gelu_tanh(y3))};
        }
    }
    WAVE_SYNC();
}
template <int PASS>
__device__ __forceinline__ void phase_s5_pass(const Params& p, int blk0) {
    const int t = TID(), lane = t & 63, w = t >> 6, fr = lane & 15, fq = lane >> 4;
    bf16_t* hs = (bf16_t*)(LDS_BASE() + w * (64 * CLD * 2));
    constexpr int S5_NSEG = PASS == 1 ? S5_NSEG1 : S5_NSEG2, S5_CPS = NCH / S5_NSEG;
    const int ntasks = NB_ * 32 * S5_NSEG;
    if ((int)blockIdx.x < blk0) return;
    for (int bt = (int)blockIdx.x - blk0; bt < ntasks / NW; bt += (int)gridDim.x - blk0) {
        const int task = bt * NW + w;
        const int g = task & 31, seg = (task >> 5) % S5_NSEG, b = task / (32 * S5_NSEG);
        S5Task T; s5_task_init<PASS>(p, T, g, lane, fr, fq);
        const int c0 = seg * S5_CPS;
        S5In IA, IB;
        s5_load<PASS>(p, IA, g, ((long)b * NCH + c0) * 64, fr, fq);
        float hr = 0.f, hi = 0.f;
        if (PASS == 2 && S5_CARRY) {
            const float a64r = p.s5a64[(g * 64 + lane) * 2], a64i = p.s5a64[(g * 64 + lane) * 2 + 1];
            const long base = ((long)b * NCH * 32 + g) * 64 + lane;
            constexpr int CG = S5_CPS >= 8 ? 8 : S5_CPS;
#pragma unroll 1
            for (int c8 = 0; c8 < c0; c8 += CG) {
                float lr[CG], li[CG];
#pragma unroll
                for (int k = 0; k < CG; ++k) { lr[k] = p.s5loc[(base + (long)(c8 + k) * 2048) * 2]; li[k] = p.s5loc[(base + (long)(c8 + k) * 2048) * 2 + 1]; }
#pragma unroll
                for (int k = 0; k < CG; ++k) {
                    float nr = fmaf(a64r, hr, lr[k]), ni = fmaf(a64r, hi, li[k]);
                    CARRY_PIN(nr, ni);
                    nr = fmaf(-a64i, hi, nr); ni = fmaf(a64i, hr, ni);
                    CARRY_PIN(nr, ni);
                    hr = nr; hi = ni;
                }
            }
        }
#pragma unroll 1
        for (int c = c0; c < c0 + S5_CPS; c += 2) {
            const long tokA = ((long)b * NCH + c) * 64, tokB = tokA + 64;
            s5_load<PASS>(p, IB, g, tokB, fr, fq);
            if (PASS == 1) { hr = 0.f; hi = 0.f; }
            s5_unit<PASS>(p, hs, T, IA, g, tokA, hr, hi, lane, fr, fq);
            if (PASS == 1) { const long unit = ((long)b * NCH + c) * 32 + g; p.s5loc[(unit * 64 + lane) * 2] = hr; p.s5loc[(unit * 64 + lane) * 2 + 1] = hi; hr = 0.f; hi = 0.f; }
            if (c + 2 < c0 + S5_CPS) s5_load<PASS>(p, IA, g, tokB + 64, fr, fq);
            s5_unit<PASS>(p, hs, T, IB, g, tokB, hr, hi, lane, fr, fq);
            if (PASS == 1) { const long unit = ((long)b * NCH + c + 1) * 32 + g; p.s5loc[(unit * 64 + lane) * 2] = hr; p.s5loc[(unit * 64 + lane) * 2 + 1] = hi; }
        }
    }
}

struct LnrRow { f32x4 xf[4]; u32x2 xh[4]; u32x2 mm[4]; };
template <bool F32IN>
__device__ __forceinline__ void lnr_load(const Params& p, LnrRow& R, const float* hin, const bf16_t* mixp, long tok, int lane) {
#pragma unroll
    for (int i = 0; i < 4; ++i) {
        const int k = 4 * lane + 256 * i;
        if (F32IN) R.xf[i] = *(const f32x4*)(hin + tok * DM + k); else R.xh[i] = *(const u32x2*)(p.hb + tok * DM + k);
        R.mm[i] = *(const u32x2*)(mixp + tok * DM + k);
    }
}
template <bool F32IN>
__device__ __forceinline__ void lnr_process(const Params& p, int layer, const LnrRow& R, const f32x4 (&gv)[4], const f32x4 (&bv)[4], const float* Wr,
                                            int* lcount, int* le, int* lrank, float* lgate, int lt, long tok, int lane, bool dry = false) {
    float h[16];
    float s = 0.f;
#pragma unroll
    for (int i = 0; i < 4; ++i) {
        f32x4 xv;
        if (F32IN) xv = R.xf[i];
        else { const u32x2 xx = R.xh[i]; xv = (f32x4){bf2f((bf16_t)(xx[0] & 0xffff)), bf2f((bf16_t)(xx[0] >> 16)), bf2f((bf16_t)(xx[1] & 0xffff)), bf2f((bf16_t)(xx[1] >> 16))}; }
        const u32x2 mm = R.mm[i];
        h[4 * i + 0] = ALPHA * xv[0] + bf2f((bf16_t)(mm[0] & 0xffff)); h[4 * i + 1] = ALPHA * xv[1] + bf2f((bf16_t)(mm[0] >> 16));
        h[4 * i + 2] = ALPHA * xv[2] + bf2f((bf16_t)(mm[1] & 0xffff)); h[4 * i + 3] = ALPHA * xv[3] + bf2f((bf16_t)(mm[1] >> 16));
        s += (h[4 * i] + h[4 * i + 1]) + (h[4 * i + 2] + h[4 * i + 3]);
    }
    const float mean = wave_sum(s) * (1.0f / DM);
    float q = 0.f;
#pragma unroll
    for (int e = 0; e < 16; ++e) { const float d = h[e] - mean; q += d * d; }
    const float rstd = rsqrtf(wave_sum(q) * (1.0f / DM) + LN_EPS);
#pragma unroll
    for (int i = 0; i < 4; ++i) {
        const int k = 4 * lane + 256 * i;
#pragma unroll
        for (int e = 0; e < 4; ++e) h[4 * i + e] = (h[4 * i + e] - mean) * rstd * gv[i][e] + bv[i][e];
        if (!dry) NT_STORE((u32x2*)(p.hb + tok * DM + k), ((u32x2){pack2(h[4 * i], h[4 * i + 1]), pack2(h[4 * i + 2], h[4 * i + 3])}));
        else NT_STORE((u32x2*)(p.H + tok * DM + k), ((u32x2){pack2(h[4 * i], h[4 * i + 1]), pack2(h[4 * i + 2], h[4 * i + 3])}));
    }
    float gl[4];
#pragma unroll
    for (int n = 0; n < 4; ++n) {
        float a = 0.f;
#pragma unroll
        for (int i = 0; i < 4; ++i) { const f32x4 wv = *(const f32x4*)(Wr + n * 1024 + 4 * lane + 256 * i); a += h[4 * i] * wv[0] + h[4 * i + 1] * wv[1] + h[4 * i + 2] * wv[2] + h[4 * i + 3] * wv[3]; }
        gl[n] = a;
    }
#pragma unroll
    for (int o = 32; o > 0; o >>= 1)
#pragma unroll
        for (int n = 0; n < 4; ++n) gl[n] += __shfl_xor(gl[n], o);
#pragma unroll
    for (int n = 0; n < 4; ++n) gl[n] += p.rgb[layer * 4 + n];
    int grp = 0; float gm = gl[0];
#pragma unroll
    for (int n = 1; n < 4; ++n) if (gl[n] > gm) { gm = gl[n]; grp = n; }
    float den = 0.f;
#pragma unroll
    for (int n = 0; n < 4; ++n) den += expf(gl[n] - gm);
    const float pg = 1.0f / den;
    float m1 = -3.0e38f, m2 = -3.0e38f; int i1 = 0, i2 = 0;
    float el8[8];
#pragma unroll
    for (int j = 0; j < 8; ++j) {
        const float* wrow = Wr + (long)(4 + grp * 8 + j) * 1024;
        float a = 0.f;
#pragma unroll
        for (int i = 0; i < 4; ++i) { const f32x4 wv = *(const f32x4*)(wrow + 4 * lane + 256 * i); a += h[4 * i] * wv[0] + h[4 * i + 1] * wv[1] + h[4 * i + 2] * wv[2] + h[4 * i + 3] * wv[3]; }
        el8[j] = a;
    }
#pragma unroll
    for (int o = 32; o > 0; o >>= 1)
#pragma unroll
        for (int j = 0; j < 8; ++j) el8[j] += __shfl_xor(el8[j], o);
#pragma unroll
    for (int j = 0; j < 8; ++j) {
        const float el = el8[j] + p.reb[layer * 32 + grp * 8 + j];
        if (el > m1) { m2 = m1; i2 = i1; m1 = el; i1 = j; } else if (el > m2) { m2 = el; i2 = j; }
    }
    if (lane == 0) {
        const float g1 = 1.0f / (1.0f + expf(m2 - m1));
        const int e0 = grp * 8 + i1, e1 = grp * 8 + i2;
        le[lt * 2] = e0; le[lt * 2 + 1] = e1; lgate[lt * 2] = pg * g1; lgate[lt * 2 + 1] = pg * (1.0f - g1);
        lrank[lt * 2] = atomicAdd(&lcount[e0], 1); lrank[lt * 2 + 1] = atomicAdd(&lcount[e1], 1);
    }
}
__device__ __forceinline__ void phase_ln_router(const Params& p, int layer, const float* hin, const bf16_t* mixp, bool dry = false) {
    float* Wr = (float*)LDS_BASE();
    int* li = (int*)(LDS_BASE() + 36 * 1024 * 4);
    int* lcount = li; int* lbase = li + 32; int* le = li + 64; int* lrank = li + 64 + 128; float* lgate = (float*)(li + 64 + 256);
    const int t = TID(), lane = t & 63, w = t >> 6;
    f32x4 gv[4], bv[4];
#pragma unroll
    for (int i = 0; i < 4; ++i) { gv[i] = *(const f32x4*)(p.lnmg + layer * DM + 4 * lane + 256 * i); bv[i] = *(const f32x4*)(p.lnmb + layer * DM + 4 * lane + 256 * i); }
    { const f32x4* src = (const f32x4*)(p.WrT + (long)layer * 36 * 1024); f32x4* dst = (f32x4*)Wr;
#pragma unroll
      for (int r = 0; r < 2; ++r) {
          f32x4 v[9];
#pragma unroll
          for (int j = 0; j < 9; ++j) v[j] = src[t + NTHREADS * (9 * r + j)];
#pragma unroll
          for (int j = 0; j < 9; ++j) dst[t + NTHREADS * (9 * r + j)] = v[j];
      } }
    for (int bb = blockIdx.x; bb < NT / 64; bb += gridDim.x) {
        __syncthreads();
        if (t < 32) lcount[t] = 0;
        __syncthreads();
        {
            const long tokb = (long)bb * 64 + w * (64 / NW);
            LnrRow RA, RB;
            if (hin) lnr_load<true>(p, RA, hin, mixp, tokb, lane); else lnr_load<false>(p, RA, hin, mixp, tokb, lane);
#pragma unroll 1
            for (int it = 0; it < 64 / NW; it += 2) {
                const long tn = tokb + (it + 2 < 64 / NW ? it + 2 : it + 1);
                if (hin) {
                    lnr_load<true>(p, RB, hin, mixp, tokb + it + 1, lane);
                    lnr_process<true>(p, layer, RA, gv, bv, Wr, lcount, le, lrank, lgate, w * (64 / NW) + it, tokb + it, lane, dry);
                    lnr_load<true>(p, RA, hin, mixp, tn, lane);
                    lnr_process<true>(p, layer, RB, gv, bv, Wr, lcount, le, lrank, lgate, w * (64 / NW) + it + 1, tokb + it + 1, lane, dry);
                } else {
                    lnr_load<false>(p, RB, hin, mixp, tokb + it + 1, lane);
                    lnr_process<false>(p, layer, RA, gv, bv, Wr, lcount, le, lrank, lgate, w * (64 / NW) + it, tokb + it, lane, dry);
                    lnr_load<false>(p, RA, hin, mixp, tn, lane);
                    lnr_process<false>(p, layer, RB, gv, bv, Wr, lcount, le, lrank, lgate, w * (64 / NW) + it + 1, tokb + it + 1, lane, dry);
                }
            }
        }
        __syncthreads();
        if (t < 32) lbase[t] = (lcount[t] > 0 && !dry) ? atomicAdd(p.cnt + layer * 32 + t, lcount[t]) : 0;
        __syncthreads();
        if (t < 128 && !dry) {
            const int e = le[t], pos = lbase[e] + lrank[t]; const long tok = (long)bb * 64 + (t >> 1);
            p.tok_e[tok * 2 + (t & 1)] = e; p.tok_pos[tok * 2 + (t & 1)] = pos; p.tok_gate[tok * 2 + (t & 1)] = lgate[t];
            WT_STORE_I(p.list + (long)e * LIST_CAP + pos, (int)tok); WT_STORE_F(p.list_gate + (long)e * LIST_CAP + pos, lgate[t]);
        }
    }
}

__device__ __forceinline__ void moe_map(const Params& p, int layer, int* ustart, int* rbase, int* cntl, int npn) {
    __syncthreads();
    if (TID() < 64) {
        const int l_ = TID(), e = l_ & 31;
        const int c = l_ < 32 ? p.cnt[layer * 32 + e] : 0;
        const int tiles = ((c + 255) >> 8) * npn;
        int us = tiles, rb = c;
#pragma unroll
        for (int o = 1; o < 32; o <<= 1) { const int a = __shfl_up(us, o), b = __shfl_up(rb, o); if ((l_ & 31) >= o) { us += a; rb += b; } }
        if (l_ < 32) { ustart[e] = us - tiles; rbase[e] = rb - c; cntl[e] = c; if (e == 31) { ustart[32] = us; rbase[32] = rb; } }
    }
    __syncthreads();
}
constexpr int MAP_OFF = 131072;

__device__ __forceinline__ void phase_moe_gather(const Params& p, int layer) {
    int* ustart = (int*)(LDS_BASE() + MAP_OFF); int* rbase = ustart + 33; int* cntl = rbase + 33;
    moe_map(p, layer, ustart, rbase, cntl, 4);
    const int lane = TID() & 63, gw = blockIdx.x * NW + (TID() >> 6), nw = gridDim.x * NW, total = rbase[32];
    for (int s = gw; s < total; s += nw) {
        int e = 0; while (rbase[e + 1] <= s) ++e;
        const int pos = s - rbase[e]; const long tok = p.list[(long)e * LIST_CAP + pos];
        const u32x4 v0 = *(const u32x4*)(p.hb + tok * DM + lane * 8), v1 = *(const u32x4*)(p.hb + tok * DM + 512 + lane * 8);
        *(u32x4*)(p.Xg + (long)s * DM + lane * 8) = v0; *(u32x4*)(p.Xg + (long)s * DM + 512 + lane * 8) = v1;
        if (lane == 0) p.slot_gate[s] = p.list_gate[(long)e * LIST_CAP + pos];
    }
}

__device__ __forceinline__ void phase_moe1(const Params& p, int layer) {
    int* ustart = (int*)(LDS_BASE() + MAP_OFF); int* rbase = ustart + 33; int* cntl = rbase + 33;
    moe_map(p, layer, ustart, rbase, cntl, 4);
    pg8::MoeOrder S{ustart, rbase, cntl, (int)gridDim.x, (int)blockIdx.x, 4, 1024};
    pg8::gemm_phase<pg8::EpiMoe1, pg8::MoeOrder, true>((PG8_LAS unsigned char*)LDS_BASE(), p.hb, p.WguT, 1024, S, pg8::EpiMoe1{p.H}, p.list);
}
__device__ __forceinline__ void phase_moe2(const Params& p, int layer) {
    int* ustart = (int*)(LDS_BASE() + MAP_OFF); int* rbase = ustart + 33; int* cntl = rbase + 33;
    moe_map(p, layer, ustart, rbase, cntl, 4);
    pg8::MoeOrder S{ustart, rbase, cntl, (int)gridDim.x, (int)blockIdx.x, 4, 1024};
    pg8::gemm_phase<pg8::EpiMoe2, pg8::MoeOrder>((PG8_LAS unsigned char*)LDS_BASE(), p.H, p.WdT, EFF, S, pg8::EpiMoe2{p.Y, p.list_gate});
}

__device__ __forceinline__ void phase_ln_ffn(const Params& p, int layer, bool write_hb, bool dry = false) {
    int* ustart = (int*)(LDS_BASE() + MAP_OFF); int* rbase = ustart + 33; int* cntl = rbase + 33;
    moe_map(p, layer, ustart, rbase, cntl, 4);
    const int lane = TID() & 63, gw = blockIdx.x * NW + (TID() >> 6), nw = gridDim.x * NW;
    const float* gam = p.lnfg + layer * DM; const float* bet = p.lnfb + layer * DM;
    for (int tok = gw; tok < NT; tok += nw) {
        const long s0 = rbase[p.tok_e[(long)tok * 2]] + p.tok_pos[(long)tok * 2], s1 = rbase[p.tok_e[(long)tok * 2 + 1]] + p.tok_pos[(long)tok * 2 + 1];
        float h[16]; float s = 0.f;
#pragma unroll
        for (int i = 0; i < 4; ++i) {
            const int k = 4 * lane + 256 * i;
            const u32x2 xx = *(const u32x2*)(p.hb + (long)tok * DM + k);
            const f32x4 xv = (f32x4){bf2f((bf16_t)(xx[0] & 0xffff)), bf2f((bf16_t)(xx[0] >> 16)), bf2f((bf16_t)(xx[1] & 0xffff)), bf2f((bf16_t)(xx[1] >> 16))};
            const u32x2 ya = *(const u32x2*)(p.Y + s0 * DM + k), yb = *(const u32x2*)(p.Y + s1 * DM + k);
            h[4 * i + 0] = ALPHA * xv[0] + (bf2f((bf16_t)(ya[0] & 0xffff)) + bf2f((bf16_t)(yb[0] & 0xffff)));
            h[4 * i + 1] = ALPHA * xv[1] + (bf2f((bf16_t)(ya[0] >> 16)) + bf2f((bf16_t)(yb[0] >> 16)));
            h[4 * i + 2] = ALPHA * xv[2] + (bf2f((bf16_t)(ya[1] & 0xffff)) + bf2f((bf16_t)(yb[1] & 0xffff)));
            h[4 * i + 3] = ALPHA * xv[3] + (bf2f((bf16_t)(ya[1] >> 16)) + bf2f((bf16_t)(yb[1] >> 16)));
            s += (h[4 * i] + h[4 * i + 1]) + (h[4 * i + 2] + h[4 * i + 3]);
        }
        const float mean = wave_sum(s) * (1.0f / DM);
        float q = 0.f;
#pragma unroll
        for (int e = 0; e < 16; ++e) { const float d = h[e] - mean; q += d * d; }
        const float rstd = rsqrtf(wave_sum(q) * (1.0f / DM) + LN_EPS);
#pragma unroll
        for (int i = 0; i < 4; ++i) {
            const int k = 4 * lane + 256 * i;
            const f32x4 gv = *(const f32x4*)(gam + k), bv = *(const f32x4*)(bet + k);
#pragma unroll
            for (int e = 0; e < 4; ++e) h[4 * i + e] = (h[4 * i + e] - mean) * rstd * gv[e] + bv[e];
            if (dry) *(u32x2*)(p.H + (long)tok * DM + k) = (u32x2){pack2(h[4 * i], h[4 * i + 1]), pack2(h[4 * i + 2], h[4 * i + 3])};
            else if (write_hb) NT_STORE((u32x2*)(p.hb + (long)tok * DM + k), ((u32x2){pack2(h[4 * i], h[4 * i + 1]), pack2(h[4 * i + 2], h[4 * i + 3])}));
            else NT_STORE((f32x4*)(p.out + (long)tok * DM + k), ((f32x4){h[4 * i], h[4 * i + 1], h[4 * i + 2], h[4 * i + 3]}));
        }
    }
}


typedef float f32x16 __attribute__((ext_vector_type(16)));
typedef short s16x4 __attribute__((ext_vector_type(4)));
__device__ __forceinline__ s16x4 lds_tr_read(const bf16_t* p) {
#ifdef EMU
    return emu_ds_read_tr16_b64(p);
#else
    typedef short v4i16_t __attribute__((ext_vector_type(4)));
    return __builtin_bit_cast(s16x4, __builtin_amdgcn_ds_read_tr16_b64_v4i16((__attribute__((address_space(3))) v4i16_t*)p));
#endif
}
constexpr int KLD = 72;
struct AttnUnit { int c, d, r, grp, tpr, Ld, h, b; };
__device__ __forceinline__ AttnUnit attn_decode(int u, int g0, int g1, int g2) {
    constexpr int TPB = NS_ / 32;
    const int gper = g0 + g1 + g2; int gi = u % gper; const int bh = u / gper;
    AttnUnit a; a.h = bh & 15; a.b = bh >> 4;
    if (gi < g0) { a.c = 0; a.d = 1; } else if (gi < g0 + g1) { a.c = 1; a.d = 4; gi -= g0; } else { a.c = 2; a.d = 16; gi -= g0 + g1; }
    a.tpr = TPB / a.d; const int gpr = (a.tpr + 7) / 8; a.r = gi / gpr; a.grp = gi % gpr; a.Ld = NS_ / a.d;
    return a;
}
__device__ __forceinline__ void attn_loads(const Params& p, const AttnUnit& a, int t, int w, int q, int hh, u32x4 (&kr)[6], u32x4 (&vr)[6], bf16x8 (&qf)[4]) {
    const long tb = (long)a.b * NS_; const int M0 = 256 * a.grp;
#pragma unroll
    for (int i = 0; i < 6; ++i) {
        const int id = t + 512 * i, row = id >> 3, ch = (id & 7) * 8;
        int mk = M0 - 128 + row; mk = mk < 0 ? 0 : (mk >= a.Ld ? a.Ld - 1 : mk);
        const bf16_t* src = p.qkv + (tb + (long)mk * a.d + a.r) * 3072 + 1024 + a.h * 64 + ch;
        kr[i] = *(const u32x4*)src; vr[i] = *(const u32x4*)(src + 1024);
    }
    const int mt = 8 * a.grp + w, mtc = mt < a.tpr ? mt : a.tpr - 1;
    const long tokq = tb + (long)(32 * mtc + q) * a.d + a.r;
#pragma unroll
    for (int s = 0; s < 4; ++s) qf[s] = *(const bf16x8*)(p.qkv + tokq * 3072 + a.h * 64 + 16 * s + 8 * hh);
}
__device__ __forceinline__ void phase_attn(const Params& p) {
    constexpr int TPB = NS_ / 32;
    const int t = TID(), lane = t & 63, w = t >> 6, q = lane & 31, hh = lane >> 5;
    bf16_t* Ks = (bf16_t*)LDS_BASE(); bf16_t* Vs = Ks + 384 * KLD;
    const int g0 = (TPB + 7) / 8, g1 = 4 * ((TPB / 4 + 7) / 8), g2 = 16 * ((TPB / 16 + 7) / 8), gper = g0 + g1 + g2;
    const int nunits = NB_ * 16 * gper;
    const float C = 0.125f * 1.4426950408889634f;
    u32x4 kr[6], vr[6]; bf16x8 qn[4];
    const int G = (int)gridDim.x, nbh = NB_ * 16;
#ifndef ATTN_XCD
#define ATTN_XCD 1
#endif
    const bool xcdmap = ATTN_XCD && (G % 8 == 0) && (nbh % 8 == 0);
    const int xcd = (int)blockIdx.x & 7, lb = (int)blockIdx.x >> 3, nlb = G >> 3, nloc = (nbh / 8) * gper;
    const int nit = xcdmap ? (nloc + nlb - 1) / nlb : (nunits + G - 1) / G;
#define ATTN_UNIT_OF(it_) (xcdmap ? (((it_) * nlb + lb) < nloc ? ((((it_) * nlb + lb) / gper) * 8 + xcd) * gper + (((it_) * nlb + lb) % gper) : -1) \
                                  : (((it_) * G + (int)blockIdx.x) < nunits ? ((it_) * G + (int)blockIdx.x) : -1))
    { const int u0 = ATTN_UNIT_OF(0); if (u0 >= 0) { const AttnUnit a0 = attn_decode(u0, g0, g1, g2); attn_loads(p, a0, t, w, q, hh, kr, vr, qn); } }
    for (int it = 0; it < nit; ++it) {
        const int u = ATTN_UNIT_OF(it); if (u < 0) break;
        const AttnUnit a = attn_decode(u, g0, g1, g2);
        const int c = a.c, d = a.d, r = a.r, h = a.h, tpr = a.tpr;
        const int mt = 8 * a.grp + w;
        const long tb = (long)a.b * NS_;
        LDS_BARRIER();
#pragma unroll
        for (int i = 0; i < 6; ++i) {
            const int id = t + 512 * i, row = id >> 3, ch = (id & 7) * 8;
            *(u32x4*)(Ks + row * KLD + ch) = kr[i]; *(u32x4*)(Vs + row * KLD + ch) = vr[i];
        }
        bf16x8 qf[4];
#pragma unroll
        for (int s = 0; s < 4; ++s) qf[s] = qn[s];
        const bool active = mt < tpr;
        const int mtc = active ? mt : tpr - 1;
        const long tokq = tb + (long)(32 * mtc + q) * d + r;
        LDS_BARRIER();
        { const int un = (it + 1 < nit) ? ATTN_UNIT_OF(it + 1) : -1; if (un >= 0) { const AttnUnit an = attn_decode(un, g0, g1, g2); attn_loads(p, an, t, w, q, hh, kr, vr, qn); } }
        if (active) {
            f32x16 sc[5];
#pragma unroll
            for (int j = 0; j < 5; ++j) {
                const int mk0 = 32 * mt - 128 + 32 * j;
                if (mk0 >= 0) {
                    const bf16_t* kp = Ks + (32 * (w + j) + q) * KLD + 8 * hh;
                    f32x16 acc;
#pragma unroll
                    for (int i = 0; i < 16; ++i) acc[i] = 0.f;
#pragma unroll
                    for (int s = 0; s < 4; ++s) acc = __builtin_amdgcn_mfma_f32_32x32x16_bf16(*(const bf16x8*)(kp + 16 * s), qf[s], acc, 0, 0, 0);
                    sc[j] = acc;
                } else {
#pragma unroll
                    for (int i = 0; i < 16; ++i) sc[j][i] = -1.0e30f;
                }
            }
            float mx = -1.0e30f;
#pragma unroll
            for (int j = 0; j < 5; ++j)
#pragma unroll
                for (int i = 0; i < 16; ++i) {
                    const int kk = (i & 3) + 8 * (i >> 2) + 4 * hh;
                    if (j == 0) { if (kk < q) sc[j][i] = -1.0e30f; }
                    if (j == 4) { if (kk > q) sc[j][i] = -1.0e30f; }
                    mx = fmaxf(mx, sc[j][i]);
                }
            mx = fmaxf(mx, __shfl_xor(mx, 32));
            const float nmx = -mx * C;
            mx = mx * C;
            float l = 0.f;
#pragma unroll
            for (int j = 0; j < 5; ++j)
#pragma unroll
                for (int i = 0; i < 16; ++i) { const float e = __builtin_amdgcn_exp2f(fmaf(sc[j][i], C, nmx)); sc[j][i] = e; l += e; }
            l += __shfl_xor(l, 32);
            f32x16 o[2];
#pragma unroll
            for (int i = 0; i < 16; ++i) { o[0][i] = 0.f; o[1][i] = 0.f; }
#pragma unroll
            for (int j = 0; j < 5; ++j) {
                const int mk0 = 32 * mt - 128 + 32 * j;
                if (mk0 >= 0) {
#pragma unroll
                    for (int s = 0; s < 2; ++s) {
                        const unsigned w0 = pack2(sc[j][8 * s + 0], sc[j][8 * s + 1]), w1 = pack2(sc[j][8 * s + 2], sc[j][8 * s + 3]);
                        const unsigned w2 = pack2(sc[j][8 * s + 4], sc[j][8 * s + 5]), w3 = pack2(sc[j][8 * s + 6], sc[j][8 * s + 7]);
                        const bf16x8 pa = __builtin_bit_cast(bf16x8, (u32x4){w0, w1, w2, w3});
#pragma unroll
                        for (int db = 0; db < 2; ++db) {
                            const bf16_t* vp = Vs + (32 * (w + j) + 16 * s + 4 * hh + ((lane & 15) >> 2)) * KLD + 32 * db + 16 * ((lane >> 4) & 1) + 4 * (lane & 3);
                            const s16x4 lo = lds_tr_read(vp), hi = lds_tr_read(vp + 8 * KLD);
                            const bf16x8 vb = (bf16x8){lo[0], lo[1], lo[2], lo[3], hi[0], hi[1], hi[2], hi[3]};
                            o[db] = __builtin_amdgcn_mfma_f32_32x32x16_bf16(vb, pa, o[db], 0, 0, 0);
                        }
                    }
                }
            }
            bf16_t* ob = p.obr[c] + tokq * 1024 + h * 64 + 4 * hh;
#pragma unroll
            for (int db = 0; db < 2; ++db)
#pragma unroll
                for (int cq = 0; cq < 4; ++cq)
                    *(u32x2*)(ob + 32 * db + 8 * cq) = (u32x2){pack2(o[db][4 * cq], o[db][4 * cq + 1]), pack2(o[db][4 * cq + 2], o[db][4 * cq + 3])};
            if (hh == 0) { float* st = p.ost + ((long)c * NT + tokq) * 32 + h * 2; WT_STORE_F2(st, mx, l); }
        }
    }
}

__device__ __forceinline__ void phase_attn_merge(const Params& p) {
    const long gtid = (long)blockIdx.x * NTHREADS + TID(), gsz = (long)gridDim.x * NTHREADS;
    for (long idx = gtid; idx < (long)NT * 16 * 8; idx += gsz) {
        const long th = idx >> 3; const int ch = (int)(idx & 7);
        const long tok = th >> 4; const int h = (int)(th & 15);
        float m[3], l[3];
#pragma unroll
        for (int c = 0; c < 3; ++c) { const float* st = p.ost + ((long)c * NT + tok) * 32 + h * 2; m[c] = st[0]; l[c] = st[1]; }
        const float M = fmaxf(m[0], fmaxf(m[1], m[2]));
        float wgt[3], den = 0.f;
#pragma unroll
        for (int c = 0; c < 3; ++c) { wgt[c] = __builtin_amdgcn_exp2f(m[c] - M); den += wgt[c] * l[c]; }
        const float inv = 1.0f / den;
        float acc[8];
#pragma unroll
        for (int e = 0; e < 8; ++e) acc[e] = 0.f;
#pragma unroll
        for (int c = 0; c < 3; ++c) {
            const u32x4 v = *(const u32x4*)(p.obr[c] + tok * 1024 + h * 64 + ch * 8);
#pragma unroll
            for (int e = 0; e < 4; ++e) { acc[2 * e] += wgt[c] * bf2f((bf16_t)(v[e] & 0xffff)); acc[2 * e + 1] += wgt[c] * bf2f((bf16_t)(v[e] >> 16)); }
        }
        *(u32x4*)(p.attno + tok * 1024 + h * 64 + ch * 8) = (u32x4){pack2(acc[0] * inv, acc[1] * inv), pack2(acc[2] * inv, acc[3] * inv), pack2(acc[4] * inv, acc[5] * inv), pack2(acc[6] * inv, acc[7] * inv)};
    }
}

constexpr int NPHASES = 19;
__device__ __forceinline__ void run_phase(const Params& p, int ph, const XcdBarrier& xb) {
    switch (ph) {
    case 0:
#if defined(P0_VARIANT)
        _Pragma("unroll 1") for (int rep = 0; rep < 2; ++rep) { phase_prologue(p); __syncthreads(); }
#else
        phase_prologue(p);
#endif
        __syncthreads(); phase_ba(p);
        break;
    case 1: gemm_dense(p.hb, p.WinT, NT, 2560, 1024, pg8::EpiStore{p.proj, 2560}); break;
    case 2:
#if !FUSE_PREP
        phase_gdn_prep(p);
#endif
        break;
    case 3:
#if defined(P3_VARIANT) && P3_VARIANT == 1
        _Pragma("unroll 1") for (int rep = 0; rep < 2; ++rep) { phase_gdn_chunk(p); __syncthreads(); }
        phase_s5_pass<1>(p, 0);
#elif defined(P3_VARIANT) && P3_VARIANT == 2
        phase_gdn_chunk(p); __syncthreads();
        _Pragma("unroll 1") for (int rep = 0; rep < 2; ++rep) { phase_s5_pass<1>(p, 0); __syncthreads(); }
#else
        phase_gdn_chunk(p); __syncthreads(); phase_s5_pass<1>(p, 0);
#endif
        break;
    case 4: {
        int nscan = NB_ * 16; if (nscan > (int)gridDim.x / 2) nscan = (int)gridDim.x / 2;
#if defined(P4_VARIANT) && P4_VARIANT == 1
        if ((int)blockIdx.x < nscan) { phase_gdn_scan(p, nscan); LDS_BARRIER(); phase_gdn_scan(p, nscan); } else phase_s5_pass<2>(p, nscan);
#elif defined(P4_VARIANT) && P4_VARIANT == 2
        if ((int)blockIdx.x < nscan) phase_gdn_scan(p, nscan); else { phase_s5_pass<2>(p, nscan); LDS_BARRIER(); phase_s5_pass<2>(p, nscan); }
#else
        if ((int)blockIdx.x < nscan) phase_gdn_scan(p, nscan); else phase_s5_pass<2>(p, nscan);
#endif
        break; }
    case 5: phase_gdn_post(p); __syncthreads(); gemm_dense(p.ygelu, p.WgluT, NT, 512, 512, pg8::EpiGlu{p.ygelu, p.ycat}); break;
    case 6: gemm_dense(p.ycat, p.WoutT, NT, 1024, 1024, pg8::EpiStore{p.mix, 1024}); __syncthreads(); transpose_tiles<3>(p.moejobs[0]);
#if defined(P6_VARIANT)
        __syncthreads(); transpose_tiles<3>(p.moejobs[0]);
#endif
        break;
    case 7:
#if defined(P7_VARIANT)
        phase_ln_router(p, 0, p.x, p.mix, true); __syncthreads();
#endif
        phase_ln_router(p, 0, p.x, p.mix); break;
    case 8: phase_moe1(p, 0); break;
    case 9: phase_moe2(p, 0); break;
    case 10:
#if defined(P11_VARIANT)
        phase_ln_ffn(p, 0, true, true); __syncthreads();
#endif
        phase_ln_ffn(p, 0, true); break;
    case 11: gemm_dense(p.hb, p.WqkvT, NT, 3072, 1024, pg8::EpiStore{p.qkv, 3072}); break;
    case 12: phase_attn(p); break;
    case 13: phase_attn_merge(p); break;
    case 14: gemm_dense(p.attno, p.WoutcT, NT, 1024, 1024, pg8::EpiStore{p.mix1, 1024}); __syncthreads(); transpose_tiles<3>(p.moejobs[1]); break;
    case 15: phase_ln_router(p, 1, nullptr, p.mix1); break;
    case 16: phase_moe1(p, 1); break;
    case 17: phase_moe2(p, 1); break;
    case 18: phase_ln_ffn(p, 1, false); break;
    default: break;
    }
}

#if N_LAUNCH_MODE == 0
template <int PH> __global__ void __launch_bounds__(NTHREADS, 2) k_ph(Params p) { XcdBarrier xb{}; run_phase(p, PH, xb); }
template <int PH> static void launch_from(const Params& p, int grid, hipStream_t stream, int maxph) {
    if constexpr (PH < NPHASES) {
        if (PH <= maxph) {
#ifdef EMU
            emu::launch(dim3(32), dim3(NTHREADS), LDS_BYTES, [=] { k_ph<PH>(p); }, false); fprintf(stderr, "phase %d done\n", PH);
#else
            hipFuncSetAttribute((const void*)k_ph<PH>, hipFuncAttributeMaxDynamicSharedMemorySize, LDS_BYTES);
            hipLaunchKernelGGL(k_ph<PH>, dim3(grid), dim3(NTHREADS), LDS_BYTES, stream, p);
#endif
        }
        launch_from<PH + 1>(p, grid, stream, maxph);
    }
}
#else
template <int PH> __device__ __forceinline__ void mega_from(const Params& p, const XcdBarrier& xb) {
    if constexpr (PH < NPHASES && FUSE_PREP && PH == 2) { mega_from<PH + 1>(p, xb); }
    else if constexpr (PH < NPHASES) {
        run_phase(p, PH, xb);
#ifdef PROBE_MASK
        if constexpr (((PROBE_MASK) >> PH) & 1) { GRID_SYNC(); run_phase(p, PH, xb); }
#endif
        if constexpr (PH == 0) { GRID_SYNC_CG(); }
        else if constexpr (PH + 1 < NPHASES) { GRID_SYNC(); }
        mega_from<PH + 1>(p, xb);
    }
}
__global__ void __launch_bounds__(NTHREADS, 2) k_mega(Params p) {
#ifdef EMU
    XcdBarrier xb{0};
#else
    volatile XB_LAS unsigned* st = (volatile XB_LAS unsigned*)(lds_raw + XB_ST_OFF);
    if (threadIdx.x == 0) { st[0] = 0u; st[1] = 0u; }
    __syncthreads();
    const XcdBarrier xb = xcd_barrier_post(p.bar, st);
#endif
    mega_from<0>(p, xb);
}
#endif

#ifdef EMU
Params g_emu_params;
#endif

static inline size_t al256(size_t x) { return (x + 255) & ~(size_t)255; }

extern "C" void kernel_launch(void* const* d_in, const int* in_sizes, int n_in, void* d_out, int out_size, void* d_ws, size_t ws_size, hipStream_t stream) {
    Params p; memset(&p, 0, sizeof(p));
    const float* const* in = (const float* const*)d_in;
    p.x = in[0]; p.w_in = in[1]; p.conv = in[2]; p.a_log = in[3]; p.dt_bias = in[4]; p.gnorm = in[5]; p.lam_re = in[6]; p.lam_im = in[7]; p.log_dt = in[8];
    p.b_re = in[9]; p.b_im = in[10]; p.c_re = in[11]; p.c_im = in[12]; p.s5d = in[13]; p.wglu = in[14]; p.wout = in[15]; p.wqkv = in[16]; p.woutc = in[17];
    p.lnmg = in[18]; p.lnmb = in[19]; p.rgw = in[20]; p.rgb = in[21]; p.rew = in[22]; p.reb = in[23]; p.mg = in[24]; p.mu = in[25]; p.md = in[26]; p.lnfg = in[27]; p.lnfb = in[28];
    p.out = (float*)d_out;
    char* ws = (char*)d_ws; size_t off = 0;
    auto take = [&](size_t bytes) { char* r = ws + off; off += al256(bytes); return r; };
    p.WinT = (bf16_t*)take((size_t)2560 * 1024 * 2); p.WoutT = (bf16_t*)take((size_t)1024 * 1024 * 2); p.WgluT = (bf16_t*)take((size_t)512 * 512 * 2);
    p.WqkvT = (bf16_t*)take((size_t)3072 * 1024 * 2); p.WoutcT = (bf16_t*)take((size_t)1024 * 1024 * 2);
    p.WrT = (float*)take((size_t)2 * 36 * 1024 * 4);
    p.s5a = (float*)take(2048 * 2 * 4); p.s5a64 = (float*)take(2048 * 2 * 4); p.s5bbr = (float*)take(2048 * 16 * 4); p.s5bbi = (float*)take(2048 * 16 * 4); p.s5cm = (bf16_t*)take(32 * 16 * 128 * 2); p.s5bbm = (bf16_t*)take(32 * 128 * 16 * 2);
    p.cnt = (int*)take(64 * 4);
    p.bar = (unsigned*)take(4096 * 4);
    p.tok_e = (int*)take((size_t)NT * 2 * 4); p.tok_pos = (int*)take((size_t)NT * 2 * 4); p.tok_gate = (float*)take((size_t)NT * 2 * 4);
    p.list = (int*)take((size_t)32 * LIST_CAP * 4); p.list_gate = (float*)take((size_t)32 * LIST_CAP * 4);
    char* hbreg = take((size_t)NT * 1024 * 2);
    p.hb = (bf16_t*)hbreg;
    p.go = (bf16_t*)hbreg;
    p.s5loc = (float*)(hbreg + (size_t)NT * 512 * 2); p.s5in = p.s5loc + (size_t)NB_ * NCH * 2048 * 2;
    char* moew = take((size_t)32 * 1024 * 1024 * 2 + (size_t)32 * 1024 * 512 * 2);
    p.WguT = (bf16_t*)moew; p.WdT = (bf16_t*)(moew + (size_t)32 * 1024 * 1024 * 2);
    p.gq = (bf16_t*)moew; p.gk = p.gq + (size_t)NT * 512; p.gv = p.gk + (size_t)NT * 512;
    p.ygelu = (bf16_t*)moew;
    char* ar = ws + off;
    size_t a = 0;
    auto atake = [&](size_t bytes) { char* r = ar + a; a += al256(bytes); return r; };
    p.proj = (bf16_t*)atake((size_t)NT * PROJ_LD * 2);
    char* chunk0 = ar + a;
    p.cU = (bf16_t*)atake((size_t)NT * 512 * 2); p.cW = (bf16_t*)atake((size_t)NT * 512 * 2); p.cQd = (bf16_t*)atake((size_t)NT * 512 * 2); p.cKdT = (bf16_t*)atake((size_t)NT * 512 * 2);
    p.cQK = (bf16_t*)atake((size_t)NT * 512 * 2); p.cgl = (float*)atake((size_t)NB_ * 4 * NCH * 4);
    p.gbeta = (float*)atake((size_t)NT * 4 * 4); p.gg = (float*)atake((size_t)NT * 4 * 4);
    size_t amax = a;
    p.ycat = (bf16_t*)chunk0;
    p.mix = (bf16_t*)ar;
    p.Xg = (bf16_t*)ar; p.Y = (bf16_t*)ar; p.H = (bf16_t*)(ar + al256((size_t)(2 * NT + 256) * DM * 2)); p.slot_gate = (float*)((char*)p.H + al256((size_t)(2 * NT + 256) * EFF * 2));
    { size_t e = al256((size_t)(2 * NT + 256) * DM * 2) + al256((size_t)(2 * NT + 256) * EFF * 2) + (size_t)2 * NT * 4; if (e > amax) amax = e; }
    p.qkv = (bf16_t*)ar; p.attno = (bf16_t*)ar; p.mix1 = (bf16_t*)(ar + (size_t)NT * 1024 * 2);
    p.obr[0] = (bf16_t*)(ar + al256((size_t)NT * 3072 * 2) + (size_t)NT * 1024 * 2); p.obr[1] = (bf16_t*)moew; p.ost = (float*)(moew + (size_t)NT * 1024 * 2); p.obr[2] = (bf16_t*)(ar + al256((size_t)NT * 3072 * 2));
    { size_t e = al256((size_t)NT * 3072 * 2) + (size_t)2 * NT * 1024 * 2; if (e > amax) amax = e; }
    if (off + amax > ws_size) { fprintf(stderr, "workspace too small: need %zu have %zu\n", off + amax, ws_size); return; }
    auto job = [](const float* src, bf16_t* dst, int K, int N, int ldsrc, int ldd, int rb, int rs, int roff, int batch, long sbs, long dbs) {
        TJob j; memset(&j, 0, sizeof(j)); j.src = src; j.dst = dst; j.K = K; j.N = N; j.ldsrc = ldsrc; j.ldd = ldd; j.rb = rb; j.rs = rs; j.roff = roff; j.batch = batch; j.sbs = sbs; j.dbs = dbs; return j; };
    p.jobs[0] = job(p.w_in, p.WinT, 1024, 2048, 2568, 1024, 2048, 0, 0, 1, 0, 0);
    p.jobs[1] = job(p.w_in + 2056, p.WinT + (size_t)2048 * 1024, 1024, 512, 2568, 1024, 512, 0, 0, 1, 0, 0);
    p.jobs[2] = job(p.wout, p.WoutT, 1024, 1024, 1024, 1024, 1024, 0, 0, 1, 0, 0);
    p.jobs[3] = job(p.wglu, p.WgluT, 512, 512, 512, 512, 512, 0, 0, 1, 0, 0);
    p.jobs[4] = job(p.wqkv, p.WqkvT, 1024, 3072, 3072, 1024, 3072, 0, 0, 1, 0, 0);
    p.jobs[5] = job(p.woutc, p.WoutcT, 1024, 1024, 1024, 1024, 1024, 0, 0, 1, 0, 0);
    p.njobs = 6;
    for (int l = 0; l < 2; ++l) {
        p.moejobs[l][0] = job(p.mg + (size_t)l * 32 * 1024 * 512, p.WguT, 1024, 512, 512, 1024, 128, 256, 0, 32, 1024L * 512, 1024L * 1024);
        p.moejobs[l][1] = job(p.mu + (size_t)l * 32 * 1024 * 512, p.WguT, 1024, 512, 512, 1024, 128, 256, 128, 32, 1024L * 512, 1024L * 1024);
        p.moejobs[l][2] = job(p.md + (size_t)l * 32 * 512 * 1024, p.WdT, 512, 1024, 1024, 512, 1024, 0, 0, 32, 512L * 1024, 1024L * 512);
    }
#ifdef EMU
    g_emu_params = p;
#if N_LAUNCH_MODE == 1
    emu::launch(dim3(16), dim3(NTHREADS), LDS_BYTES, [=] { k_mega(p); }, true);
#else
    { const char* e = getenv("EMU_MAXPHASE"); launch_from<0>(p, 64, stream, e ? atoi(e) : NPHASES - 1); }
#endif
#else
#if N_LAUNCH_MODE == 1
    static int grid_blocks = 0;
    if (!grid_blocks) {
        int dev = 0, cus = 0, per_cu = 0;
        (void)hipGetDevice(&dev); (void)hipDeviceGetAttribute(&cus, hipDeviceAttributeMultiprocessorCount, dev);
        (void)hipFuncSetAttribute((const void*)k_mega, hipFuncAttributeMaxDynamicSharedMemorySize, LDS_BYTES);
        (void)hipOccupancyMaxActiveBlocksPerMultiprocessor(&per_cu, k_mega, NTHREADS, LDS_BYTES);
        per_cu = 1;
        grid_blocks = cus * per_cu;
    }
    (void)hipMemsetAsync(p.bar, 0, 4096 * 4, stream);
    void* args[] = {(void*)&p};
    hipError_t e = hipLaunchCooperativeKernel((void*)k_mega, dim3(grid_blocks), dim3(NTHREADS), args, LDS_BYTES, stream);
    if (e != hipSuccess) fprintf(stderr, "cooperative launch failed: %s (grid %d)\n", hipGetErrorString(e), grid_blocks);
#else
    launch_from<0>(p, 256, stream, NPHASES - 1);
#endif
#endif
}
```

```cpp
#ifndef EMU
#include <hip/hip_runtime.h>
#include <hip/hip_cooperative_groups.h>
#endif
#include <cstdint>
#include <cstdio>
#include <cmath>
#include <cstring>
#include <cstdlib>

#ifndef CFG_BATCH
#define CFG_BATCH 8
#endif
#ifndef CFG_SEQ
#define CFG_SEQ 4096
#endif
#ifndef N_LAUNCH_MODE
#define N_LAUNCH_MODE 1
#endif

typedef unsigned short bf16_t;
typedef short bf16x8 __attribute__((ext_vector_type(8)));
typedef float f32x4 __attribute__((ext_vector_type(4)));
typedef unsigned u32x4 __attribute__((ext_vector_type(4)));
typedef unsigned u32x2 __attribute__((ext_vector_type(2)));

constexpr int NB_ = CFG_BATCH, NS_ = CFG_SEQ, NT = NB_ * NS_, DM = 1024;
constexpr int NCH = NS_ / 64;
constexpr int PROJ_LD = 2560;
constexpr int NEXP = 32, EFF = 512;
constexpr int LIST_CAP = NT * 2;
constexpr float ALPHA = 1.41421356237f;
constexpr float LN_EPS = 1e-5f;
constexpr int NTHREADS = 512, NW = 8;
constexpr int LDS_BYTES = 160 * 1024;

#ifdef EMU
#define LDS_BASE() (emu::cur->blk->smem)
#define GRID_SYNC_CG() emu::grid_sync()
#define GRID_SYNC() emu::grid_sync()
struct XcdBarrier { int dummy; };
#else
extern __shared__ __attribute__((aligned(16))) char lds_raw[];
#define LDS_BASE() (lds_raw)
#define GRID_SYNC_CG() cooperative_groups::this_grid().sync()
#define GRID_SYNC() xcd_barrier(xb)
#define XB_TMO      128
#define XB_XCNT(j)  (256  + 64 * (j))
#define XB_XSUB(j)  (1280 + 64 * (j))
#define XB_XGEN(j)  (2304 + 64 * (j))
#define XB_TOP      3328
#define XB_TOPGEN   3392
#define XCD_BAR_WORDS 3456
#define XB_SPIN_CAP (1u << 18)
#define XB_LAS __attribute__((address_space(3)))
#define XB_ACQUIRE() __builtin_amdgcn_fence(__ATOMIC_ACQUIRE, "agent")
__device__ __forceinline__ unsigned xb_ld(unsigned* p)              { return __hip_atomic_load(p, __ATOMIC_RELAXED, __HIP_MEMORY_SCOPE_AGENT); }
__device__ __forceinline__ unsigned xb_add(unsigned* p, unsigned v) { return __hip_atomic_fetch_add(p, v, __ATOMIC_RELAXED, __HIP_MEMORY_SCOPE_AGENT); }
__device__ __forceinline__ unsigned xb_xcc_id() { return (unsigned)__builtin_amdgcn_s_getreg((3 << 11) | 20) & 0xFu; }
#define XB_SPIN(cond, bar) do { unsigned _sp = 0; while (cond) { __builtin_amdgcn_s_sleep(1); \
    if ((++_sp & 255u) == 0u) { if (xb_ld(&(bar)[XB_TMO])) break; if (_sp > XB_SPIN_CAP) { atomicAdd(&(bar)[XB_TMO], 1u); break; } } } } while (0)
struct XcdBarrier { unsigned* bar; unsigned x; volatile XB_LAS unsigned* st; };
__device__ __forceinline__ XcdBarrier xcd_barrier_post(unsigned* bar, volatile XB_LAS unsigned* st) {
    XcdBarrier b; b.bar = bar; b.x = xb_xcc_id(); b.st = st;
    if (threadIdx.x == 0) (void)xb_add(&bar[XB_XCNT(b.x)], 1u);
    return b;
}
__device__ __forceinline__ void xcd_barrier_complete(unsigned* bar, unsigned x, unsigned& nloc, unsigned& nx) {
    const unsigned G = gridDim.x * gridDim.y * gridDim.z;
    unsigned sum, cnt, mine, sp = 0u;
    for (;;) {
        sum = 0u; cnt = 0u; mine = 0u;
#pragma unroll
        for (unsigned j = 0; j < 16; ++j) { const unsigned c = xb_ld(&bar[XB_XCNT(j)]); sum += c; cnt += (c > 0u) ? 1u : 0u; mine = (j == x) ? c : mine; }
        if (sum == G) break;
        __builtin_amdgcn_s_sleep(1);
        if ((++sp & 255u) == 0u) { if (xb_ld(&bar[XB_TMO])) break; if (sp > XB_SPIN_CAP) { atomicAdd(&bar[XB_TMO], 1u); break; } }
    }
    nloc = mine > 0u ? mine : 1u; nx = cnt > 0u ? cnt : 1u;
}
__device__ __forceinline__ void xcd_barrier(const XcdBarrier& b) {
    asm volatile("s_waitcnt vmcnt(0)" ::: "memory");
    __syncthreads();
    if (threadIdx.x == 0) {
        unsigned* bar = b.bar;
        __builtin_amdgcn_s_waitcnt(0);
        unsigned nloc = b.st[0], nx = b.st[1];
        if (nloc == 0u) { xcd_barrier_complete(bar, b.x, nloc, nx); b.st[0] = nloc; b.st[1] = nx; }
        const unsigned old = xb_add(&bar[XB_XSUB(b.x)], 1u);
        const unsigned gen = old / nloc;
        if (old + 1u == (gen + 1u) * nloc) {
            __builtin_amdgcn_fence(__ATOMIC_RELEASE, "agent");
            asm volatile("s_waitcnt vmcnt(0)" ::: "memory");
            const unsigned og = xb_add(&bar[XB_TOP], 1u);
            const unsigned tg = og / nx;
            if (og + 1u == (tg + 1u) * nx) xb_add(&bar[XB_TOPGEN], 1u);
            else XB_SPIN(xb_ld(&bar[XB_TOPGEN]) == tg, bar);
            XB_ACQUIRE();
            xb_add(&bar[XB_XGEN(b.x)], 1u);
            asm volatile("s_waitcnt vmcnt(0)" ::: "memory");
        } else {
            XB_SPIN(xb_ld(&bar[XB_XGEN(b.x)]) == gen, bar);
            XB_ACQUIRE();
            asm volatile("s_waitcnt vmcnt(0)" ::: "memory");
        }
    }
    __syncthreads();
}
#endif
#ifdef EMU
#define NT_STORE(ptr, val) (*(ptr) = (val))
#else
#define NT_STORE(ptr, val) __builtin_nontemporal_store((val), (ptr))
#endif
#ifndef WT_PLAIN
#define WT_PLAIN 0
#endif
#ifdef EMU
#define WT_STORE_I(ptr, val) (*(ptr) = (val))
#define WT_STORE_F(ptr, val) (*(ptr) = (val))
#define WT_STORE_F2(ptr, a, b) ((ptr)[0] = (a), (ptr)[1] = (b))
#else
#if WT_PLAIN
#define WT_STORE_F2(ptr, a, b) ((ptr)[0] = (a), (ptr)[1] = (b))
#define WT_STORE_I(ptr, val) (*(ptr) = (val))
#define WT_STORE_F(ptr, val) (*(ptr) = (val))
#else
#define WT_STORE_F2(ptr, a, b) __hip_atomic_store((unsigned long long*)(ptr), ((unsigned long long)__float_as_uint(b) << 32) | (unsigned long long)__float_as_uint(a), __ATOMIC_RELAXED, __HIP_MEMORY_SCOPE_AGENT)
#define WT_STORE_I(ptr, val) __hip_atomic_store((ptr), (val), __ATOMIC_RELAXED, __HIP_MEMORY_SCOPE_AGENT)
#define WT_STORE_F(ptr, val) __hip_atomic_store((ptr), (val), __ATOMIC_RELAXED, __HIP_MEMORY_SCOPE_AGENT)
#endif
#endif
#ifdef EMU
#define LDS_BARRIER() emu::syncthreads()
#else
#define LDS_BARRIER() asm volatile("s_waitcnt lgkmcnt(0)\n\ts_barrier" ::: "memory")
#endif
constexpr int XB_ST_OFF = 160 * 1024 - 16;

__device__ __forceinline__ int TID() {
#ifdef EMU
    return (int)emu::cur->tid.x;
#else
    int t = (int)threadIdx.x; asm volatile("" : "+v"(t)); return t;
#endif
}
__device__ __forceinline__ float bf2f(bf16_t v) { return __builtin_bit_cast(float, (unsigned)v << 16); }
__device__ __forceinline__ bf16_t f2bf(float f) { unsigned u = __builtin_bit_cast(unsigned, f); u += 0x7fffu + ((u >> 16) & 1u); return (bf16_t)(u >> 16); }
#ifdef EMU
__device__ __forceinline__ unsigned pack2(float a, float b) { return (unsigned)f2bf(a) | ((unsigned)f2bf(b) << 16); }
#else
typedef float f32x2_t_ __attribute__((ext_vector_type(2))); typedef __bf16 bf16x2_t_ __attribute__((ext_vector_type(2)));
__device__ __forceinline__ unsigned pack2(float a, float b) { f32x2_t_ v = {a, b}; bf16x2_t_ r = __builtin_convertvector(v, bf16x2_t_); return __builtin_bit_cast(unsigned, r); }
#endif
__device__ __forceinline__ float sigmoidf_(float x) { return 1.0f / (1.0f + __expf(-x)); }
__device__ __forceinline__ float siluf_(float x) { return x / (1.0f + __expf(-x)); }
__device__ __forceinline__ float wave_sum(float v) {
#pragma unroll
    for (int o = 32; o > 0; o >>= 1) v += __shfl_xor(v, o);
    return v;
}

struct TJob { const float* src; bf16_t* dst; int K, N, ldsrc, ldd, rb, rs, roff, batch; long sbs, dbs; };

struct Params {
    const float *x, *w_in, *conv, *a_log, *dt_bias, *gnorm, *lam_re, *lam_im, *log_dt, *b_re, *b_im, *c_re, *c_im, *s5d, *wglu, *wout,
        *wqkv, *woutc, *lnmg, *lnmb, *rgw, *rgb, *rew, *reb, *mg, *mu, *md, *lnfg, *lnfb;
    float* out;
    bf16_t *WinT, *WoutT, *WgluT, *WqkvT, *WoutcT;
    float* WrT;
    float *s5a, *s5a64, *s5bbr, *s5bbi;
    bf16_t* s5cm;
    bf16_t* s5bbm;
    bf16_t* hb;
    bf16_t *WguT, *WdT;
    int* cnt;
    int *tok_e, *tok_pos; float* tok_gate;
    int* list; float* list_gate;
    bf16_t* proj;
    float *gbeta, *gg;
    bf16_t *gq, *gk, *gv;
    bf16_t *cU, *cW, *cQd, *cKdT;
    bf16_t* cQK;
    float* cgl;
    bf16_t* go;
    float *s5loc, *s5in;
    bf16_t* ygelu;
    bf16_t* ycat;
    bf16_t* mix;
    bf16_t* H;
    bf16_t* Y;
    bf16_t* qkv;
    bf16_t* attno;
    bf16_t* obr[3];
    float* ost;
    bf16_t* mix1;
    bf16_t* Xg;
    float* slot_gate;
    unsigned* bar;
    TJob jobs[8]; int njobs; int pad0;
    TJob moejobs[2][3];
};

struct TTile { const float* src; bf16_t* dst; int ldsrc, ldd, rb, rs, roff, k0, n0; };
template <int NJ>
__device__ __forceinline__ TTile tt_decode(const TJob* jobs, int g) {
    TJob J = jobs[0]; int rem = g; bool found = false;
#pragma unroll
    for (int j = 0; j < NJ; ++j) { const int nt = jobs[j].batch * (jobs[j].K / 64) * (jobs[j].N / 64); if (!found) { if (rem < nt) { J = jobs[j]; found = true; } else rem -= nt; } }
    const int tk = J.K / 64, tn = J.N / 64;
    const int b = rem / (tk * tn), r2 = rem % (tk * tn);
    TTile T; T.k0 = (r2 / tn) * 64; T.n0 = (r2 % tn) * 64; T.src = J.src + (long)b * J.sbs; T.dst = J.dst + (long)b * J.dbs;
    T.ldsrc = J.ldsrc; T.ldd = J.ldd; T.rb = J.rb; T.rs = J.rs; T.roff = J.roff; return T;
}
__device__ __forceinline__ void tt_load(const TTile& T, int t, f32x4 (&r)[4]) {
#pragma unroll
    for (int i = 0; i < 4; ++i) r[i] = __builtin_nontemporal_load((const f32x4*)(T.src + (long)(T.k0 + (t >> 4) + 16 * i) * T.ldsrc + T.n0 + (t & 15) * 4));
}
__device__ __forceinline__ void tt_emit(const TTile& T, int t, float* ts, const f32x4 (&r)[4], bool active) {
    LDS_BARRIER();
    if (active) {
#pragma unroll
        for (int i = 0; i < 4; ++i) { const int k = (t >> 4) + 16 * i, n4 = (t & 15) * 4; ts[k * 65 + n4 + 0] = r[i][0]; ts[k * 65 + n4 + 1] = r[i][1]; ts[k * 65 + n4 + 2] = r[i][2]; ts[k * 65 + n4 + 3] = r[i][3]; }
    }
    LDS_BARRIER();
    if (active) {
        const int n = t >> 2, kq = (t & 3) * 16;
        unsigned w[8];
#pragma unroll
        for (int i = 0; i < 8; ++i) w[i] = pack2(ts[(kq + 2 * i) * 65 + n], ts[(kq + 2 * i + 1) * 65 + n]);
        const int nn = T.n0 + n, row = (nn / T.rb) * T.rs + T.roff + nn % T.rb;
        u32x4* o = (u32x4*)(T.dst + (long)row * T.ldd + T.k0 + kq);
        o[0] = (u32x4){w[0], w[1], w[2], w[3]}; o[1] = (u32x4){w[4], w[5], w[6], w[7]};
    }
}
template <int NJ>
__device__ __forceinline__ void transpose_tiles(const TJob* jobs) {
    const int t = TID() & 255, half = TID() >> 8;
    float* ts = (float*)LDS_BASE() + half * (64 * 65 + 16);
    int total = 0;
#pragma unroll
    for (int j = 0; j < NJ; ++j) total += jobs[j].batch * (jobs[j].K / 64) * (jobs[j].N / 64);
    const int G = (int)gridDim.x;
    f32x4 ra[4], rb[4];
    int gp = (int)blockIdx.x;
    if (gp * 2 + half < total) { const TTile T0 = tt_decode<NJ>(jobs, gp * 2 + half); tt_load(T0, t, ra); }
#pragma unroll 1
    for (; gp * 2 < total; gp += 2 * G) {
        {
            const int g = gp * 2 + half, gn = (gp + G) * 2 + half; const bool active = g < total;
            if (gn < total) { const TTile Tn = tt_decode<NJ>(jobs, gn); tt_load(Tn, t, rb); }
            const TTile T = tt_decode<NJ>(jobs, active ? g : 0);
            tt_emit(T, t, ts, ra, active);
        }
        if ((gp + G) * 2 < total) {
            const int g = (gp + G) * 2 + half, gn = (gp + 2 * G) * 2 + half; const bool active = g < total;
            if (gn < total) { const TTile Tn = tt_decode<NJ>(jobs, gn); tt_load(Tn, t, ra); }
            const TTile T = tt_decode<NJ>(jobs, active ? g : 0);
            tt_emit(T, t, ts, rb, active);
        }
    }
}

__device__ __forceinline__ void phase_prologue(const Params& p) {
    transpose_tiles<6>(p.jobs);
    const long gtid = (long)blockIdx.x * NTHREADS + TID(), gsz = (long)gridDim.x * NTHREADS;
    for (long i = gtid; i < 2L * 36 * 1024; i += gsz) {
        const int l = (int)(i / (36 * 1024)), n = (int)((i / 1024) % 36), k = (int)(i % 1024);
        p.WrT[i] = n < 4 ? p.rgw[((long)l * 1024 + k) * 4 + n] : p.rew[((long)l * 1024 + k) * 32 + (n - 4)];
    }
    for (long idx = gtid; idx < 32 * 64 * 16; idx += gsz) {
        const long i = idx >> 4; const int h = (int)(idx & 15);
        const int g = (int)(i / 64);
        const float dt = expf(p.log_dt[g]);
        const float lr = p.lam_re[i], li = p.lam_im[i];
        const float mag = expf(lr * dt), ar = mag * cosf(li * dt), ai = mag * sinf(li * dt);
        if (h == 0) {
            const float mag64 = expf(64.0f * lr * dt), ph64 = 64.0f * li * dt;
            p.s5a[i * 2] = ar; p.s5a[i * 2 + 1] = ai;
            p.s5a64[i * 2] = mag64 * cosf(ph64); p.s5a64[i * 2 + 1] = mag64 * sinf(ph64);
        }
        const float den = lr * lr + li * li, nr = ar - 1.0f, ni = ai;
        const float cr = (nr * lr + ni * li) / den, ci = (ni * lr - nr * li) / den;
        const float br = p.b_re[i * 16 + h], bi = p.b_im[i * 16 + h];
        p.s5bbr[i * 16 + h] = cr * br - ci * bi; p.s5bbi[i * 16 + h] = cr * bi + ci * br;
        const int pp = (int)(i % 64);
        p.s5bbm[((long)g * 128 + pp) * 16 + h] = f2bf(cr * br - ci * bi); p.s5bbm[((long)g * 128 + 64 + pp) * 16 + h] = f2bf(cr * bi + ci * br);
    }
    for (long i = gtid; i < 32 * 16 * 128; i += gsz) {
        const int p2 = (int)(i % 128); const long gk = i / 128;
        p.s5cm[i] = f2bf(p2 < 64 ? p.c_re[gk * 64 + p2] : -p.c_im[gk * 64 + (p2 - 64)]);
    }
    for (long i = gtid; i < 64; i += gsz) p.cnt[i] = 0;
}

#ifndef MOE_XCD
#define MOE_XCD 1
#endif
namespace pg8 {
#ifdef EMU
#define PG8_LAS
#define PG8_WAIT_V(n) do { } while (0)
#define PG8_WAIT_L(n) do { } while (0)
#else
#define PG8_LAS __attribute__((address_space(3)))
#define PG8_WAIT_V(n) asm volatile("s_waitcnt vmcnt(" #n ")" ::: "memory")
#define PG8_WAIT_L(n) asm volatile("s_waitcnt lgkmcnt(" #n ")" ::: "memory")
#endif
constexpr int BM = 256, BK = 64, HALF = 128, HTB = HALF * BK * 2  , STAGE_BYTES = 8 * HTB, NXCD = 8, WGM = 8;
__host__ __device__ __forceinline__ int lds_byte(int r, int c) { const int st = (r >> 4) * 2 + (c >> 5), rr = r & 15, cc = c & 31, ob = rr * 64 + cc * 2; return st * 1024 + (ob ^ (((ob >> 9) & 1) << 5)); }
__host__ __device__ __forceinline__ void stage_rc(int b, int& R, int& C) { const int st = b / 1024, sb = b % 1024, swz = sb ^ (((sb >> 9) & 1) << 5); R = (st >> 1) * 16 + swz / 64; C = (st & 1) * 32 + (swz % 64) / 2; }
__host__ __device__ __forceinline__ int perm32(int rho) { const int n = rho >> 4, i = rho & 15; return 8 * (i >> 2) + 4 * n + (i & 3); }

struct Unit { int arow, brow, pn, nvalid, lrow; };

struct DenseOrder {
    int nM, nN, nwg, G, c;
    __device__ __forceinline__ void init(int M, int N, int G_, int c_) { nM = M / BM; nN = N / BM; nwg = nM * nN; G = G_; c = c_; }
    __device__ __forceinline__ bool next(int i, Unit& u) const {
        const long L = (long)i * G + c; if (L >= nwg) return false;
        int wgid = (int)L; { const int q = nwg / NXCD, r = nwg % NXCD, xcd = wgid % NXCD, off = wgid / NXCD; wgid = (xcd < r ? xcd * (q + 1) : r * (q + 1) + (xcd - r) * q) + off; }
        const int nig = WGM * nN, gid = wgid / nig, fm = gid * WGM, gsz = (nM - fm) < WGM ? (nM - fm) : WGM;
        const int pm = fm + ((wgid % nig) % gsz), pn = (wgid % nig) / gsz;
        u.arow = pm * BM; u.brow = pn * BM; u.pn = pn; u.nvalid = BM; u.lrow = 0; return true;
    }
};
struct MoeOrder {
    const int* ustart; const int* rbase; const int* cntp; int G, c, npn, brows;
    __device__ __forceinline__ bool next(int i, Unit& u) const {
        const int L0 = i * G + c, nwg = ustart[32]; if (L0 >= nwg) return false;
        int L = L0; if (MOE_XCD) { const int q = nwg / NXCD, r = nwg % NXCD, xcd = L0 % NXCD, off = L0 / NXCD; L = (xcd < r ? xcd * (q + 1) : r * (q + 1) + (xcd - r) * q) + off; }
        int e = 0; while (ustart[e + 1] <= L) ++e;
        const int cn = cntp[e], ntile = (cn + BM - 1) / BM, local = L - ustart[e], ti = local % ntile, pn = local / ntile;
        u.arow = rbase[e] + ti * BM; u.brow = e * brows + pn * BM; u.pn = pn; u.nvalid = cn - ti * BM < BM ? cn - ti * BM : BM; u.lrow = e * LIST_CAP + ti * BM; return true;
    }
};

template <class Epi, class Sched, bool GATHER = false>
__device__ __forceinline__ void gemm_phase(PG8_LAS unsigned char* lds, const bf16_t* gA, const bf16_t* gBt, const int K, const Sched& S, const Epi& E, const int* list = nullptr) {
    const int tid = TID(), wid = __builtin_amdgcn_readfirstlane(tid >> 6), lane = tid & 63, wr = wid >> 2, wc = wid & 3, fr = lane & 15, fq = lane >> 4;
    const int nt = K / BK;
    unsigned voffA[2], voffB[2]; int Rl[2], Cl[2];
#pragma unroll
    for (int i = 0; i < 2; ++i) { int R, C; stage_rc(tid * 16 + i * 8192, R, C); const int Rb = Epi::PERM ? ((R & ~31) + perm32(R & 31)) : R;
        voffA[i] = (unsigned)(R * K + C) * 2u; voffB[i] = (unsigned)(Rb * K + C) * 2u; Rl[i] = R; Cl[i] = C; }
    unsigned aoC[2][2], aoN[2][2];
#define PG8_GATHER_OFFS(ao, u_) do { _Pragma("unroll") for (int h_ = 0; h_ < 2; ++h_) _Pragma("unroll") for (int i_ = 0; i_ < 2; ++i_) { \
        int pos_ = h_ * HALF + Rl[i_]; pos_ = pos_ < (u_).nvalid ? pos_ : (u_).nvalid - 1; \
        ao[h_][i_] = (unsigned)list[(u_).lrow + pos_] * (unsigned)(K * 2) + (unsigned)(Cl[i_] * 2); } } while (0)
#define PG8_STAGE_A(bufoff, aptr, h, kb, nx) do { if constexpr (GATHER) { unsigned ao_[2] = {(nx) ? aoN[h][0] : aoC[h][0], (nx) ? aoN[h][1] : aoC[h][1]}; \
        PG8_STAGE(bufoff, (const char*)gA + (kb), ao_); } else { PG8_STAGE(bufoff, (aptr) + (h) * hstep, voffA); } } while (0)
    const size_t kstep = (size_t)(BK * 2);
    const size_t hstep = (size_t)HALF * K * 2;
    const unsigned ldsw = (unsigned)wid * 1024u;
    const int aoff = lds_byte(wr * 64 + fr, fq * 8), boff = lds_byte(wc * 32 + fr, fq * 8);
#define PG8_SA(b, h) (((b) * 2 + (h)) * HTB)
#define PG8_SB(b, h) ((4 + (b) * 2 + (h)) * HTB)
#define PG8_STAGE(bufoff, gbase, voff) do { _Pragma("unroll") for (int _i = 0; _i < 2; ++_i) \
        __builtin_amdgcn_global_load_lds((const unsigned*)((const char*)(gbase) + (voff)[_i]), (PG8_LAS unsigned*)(lds + (bufoff) + ldsw + _i * 8192), 16, 0, 0); } while (0)
#define PG8_LDA(dst, b, h) do { _Pragma("unroll") for (int m = 0; m < 4; ++m) _Pragma("unroll") for (int k = 0; k < 2; ++k) dst[m][k] = *(const PG8_LAS bf16x8*)(lds + PG8_SA(b, h) + aoff + m * 2048 + k * 1024); } while (0)
#define PG8_LDB(dst, b, h) do { _Pragma("unroll") for (int n = 0; n < 2; ++n) _Pragma("unroll") for (int k = 0; k < 2; ++k) dst[n][k] = *(const PG8_LAS bf16x8*)(lds + PG8_SB(b, h) + boff + n * 2048 + k * 1024); } while (0)
#define PG8_MMA(ai, bj, At, Bt) do { __builtin_amdgcn_s_setprio(1); _Pragma("unroll") for (int m = 0; m < 4; ++m) _Pragma("unroll") for (int n = 0; n < 2; ++n) _Pragma("unroll") for (int k = 0; k < 2; ++k) \
        acc[ai][bj][m][n] = __builtin_amdgcn_mfma_f32_16x16x32_bf16(Bt[n][k], At[m][k], acc[ai][bj][m][n], 0, 0, 0); __builtin_amdgcn_s_setprio(0); } while (0)
#define PG8_BAR __builtin_amdgcn_s_barrier()
#define PG8_SCHED __builtin_amdgcn_sched_barrier(0)
    Unit cur, nxt; int ui = 0;
    if (!S.next(0, cur)) return;
    f32x4 acc[2][2][4][2];
#pragma unroll
    for (int a = 0; a < 2; ++a)
#pragma unroll
        for (int b = 0; b < 2; ++b)
#pragma unroll
            for (int m = 0; m < 4; ++m)
#pragma unroll
                for (int n = 0; n < 2; ++n) acc[a][b][m][n] = (f32x4){0.f, 0.f, 0.f, 0.f};
    bf16x8 At[4][2], B0[2][2], B1[2][2];
    const char* cA = (const char*)gA + (size_t)cur.arow * K * 2; const char* cB = (const char*)gBt + (size_t)cur.brow * K * 2;
    if constexpr (GATHER) { PG8_GATHER_OFFS(aoC, cur); }
    PG8_STAGE(PG8_SB(0, 0), cB, voffB); PG8_STAGE(PG8_SB(0, 1), cB + hstep, voffB); PG8_STAGE_A(PG8_SA(0, 0), cA, 0, 0, false); PG8_STAGE_A(PG8_SA(0, 1), cA, 1, 0, false);
    if (wr == 1) PG8_BAR;
    PG8_WAIT_V(2); PG8_BAR;
    PG8_STAGE(PG8_SB(1, 0), cB + kstep, voffB); PG8_STAGE_A(PG8_SA(1, 0), cA + kstep, 0, kstep, false); PG8_STAGE(PG8_SB(1, 1), cB + hstep + kstep, voffB);
    PG8_WAIT_V(6); PG8_BAR;
    for (;;) {
        const bool has_next = S.next(ui + 1, nxt);
        const char* nA = has_next ? (const char*)gA + (size_t)nxt.arow * K * 2 : cA; const char* nB = has_next ? (const char*)gBt + (size_t)nxt.brow * K * 2 : cB;
        if constexpr (GATHER) { if (has_next) { PG8_GATHER_OFFS(aoN, nxt); } }
        for (int t = 0; t < nt; t += 2) {
            const bool last = (t == nt - 2);
            const bool nx = last && has_next;
            const char* a1 = cA + (size_t)(t + 1) * kstep;
            const char* a2 = last ? nA : cA + (size_t)(t + 2) * kstep; const char* b2 = last ? nB : cB + (size_t)(t + 2) * kstep;
            const char* a3 = a2 + kstep; const char* b3 = b2 + kstep;
            const size_t k1 = (size_t)(t + 1) * kstep, k2 = last ? 0 : (size_t)(t + 2) * kstep, k3 = k2 + kstep;
            PG8_LDB(B0, 0, 0); PG8_LDB(B1, 0, 1); PG8_SCHED; PG8_LDA(At, 0, 0); PG8_STAGE_A(PG8_SA(1, 1), a1, 1, k1, false);
            PG8_WAIT_V(8); PG8_WAIT_L(0); PG8_BAR; PG8_MMA(0, 0, At, B0); PG8_MMA(0, 1, At, B1); PG8_BAR; PG8_SCHED;
            PG8_LDA(At, 0, 1); PG8_STAGE(PG8_SB(0, 0), b2, voffB); PG8_STAGE(PG8_SB(0, 1), b2 + hstep, voffB); PG8_STAGE_A(PG8_SA(0, 0), a2, 0, k2, nx);
            PG8_WAIT_V(8); PG8_WAIT_L(0); PG8_BAR; PG8_MMA(1, 0, At, B0); PG8_MMA(1, 1, At, B1); PG8_BAR; PG8_SCHED;
            PG8_LDB(B0, 1, 0); PG8_LDB(B1, 1, 1); PG8_SCHED; PG8_LDA(At, 1, 0); PG8_STAGE_A(PG8_SA(0, 1), a2, 1, k2, nx);
            PG8_WAIT_V(8); PG8_WAIT_L(0); PG8_BAR; PG8_MMA(0, 0, At, B0); PG8_MMA(0, 1, At, B1); PG8_BAR; PG8_SCHED;
            PG8_LDA(At, 1, 1); PG8_STAGE(PG8_SB(1, 0), b3, voffB); PG8_STAGE(PG8_SB(1, 1), b3 + hstep, voffB); PG8_STAGE_A(PG8_SA(1, 0), a3, 0, k3, nx);
            PG8_WAIT_V(8); PG8_WAIT_L(0); PG8_BAR; PG8_MMA(1, 0, At, B0); PG8_MMA(1, 1, At, B1); PG8_BAR; PG8_SCHED;
        }
        if (wr == 0) PG8_BAR;
        E(acc, cur, wr, wc, fr, fq);
        if (!has_next) break;
#pragma unroll
        for (int a = 0; a < 2; ++a)
#pragma unroll
            for (int b = 0; b < 2; ++b)
#pragma unroll
                for (int m = 0; m < 4; ++m)
#pragma unroll
                    for (int n = 0; n < 2; ++n) acc[a][b][m][n] = (f32x4){0.f, 0.f, 0.f, 0.f};
        cur = nxt; cA = nA; cB = nB; ++ui;
        if constexpr (GATHER) { _Pragma("unroll") for (int h_ = 0; h_ < 2; ++h_) _Pragma("unroll") for (int i_ = 0; i_ < 2; ++i_) aoC[h_][i_] = aoN[h_][i_]; }
        if (wr == 1) PG8_BAR;
    }
    PG8_WAIT_V(0);
    PG8_BAR;
#undef PG8_SA
#undef PG8_SB
#undef PG8_STAGE
#undef PG8_STAGE_A
#undef PG8_GATHER_OFFS
#undef PG8_LDA
#undef PG8_LDB
#undef PG8_MMA
#undef PG8_BAR
#undef PG8_SCHED
}

struct EpiStore {
    static constexpr bool PERM = true;
    bf16_t* C; int ldc;
    __device__ __forceinline__ void operator()(const f32x4 (&acc)[2][2][4][2], const Unit& u, int wr, int wc, int fr, int fq) const {
#pragma unroll
        for (int ai = 0; ai < 2; ++ai)
#pragma unroll
            for (int m = 0; m < 4; ++m) {
                bf16_t* rowp = C + (long)(u.arow + ai * HALF + wr * 64 + m * 16 + fr) * ldc + u.pn * BM + wc * 32 + 8 * fq;
#pragma unroll
                for (int bj = 0; bj < 2; ++bj) { const f32x4 v0 = acc[ai][bj][m][0], v1 = acc[ai][bj][m][1];
                    *(u32x4*)(rowp + bj * HALF) = (u32x4){pack2(v0[0], v0[1]), pack2(v0[2], v0[3]), pack2(v1[0], v1[1]), pack2(v1[2], v1[3])}; }
            }
    }
};
struct EpiGlu {
    static constexpr bool PERM = true;
    const bf16_t* y; bf16_t* ycat;
    __device__ __forceinline__ void operator()(const f32x4 (&acc)[2][2][4][2], const Unit& u, int wr, int wc, int fr, int fq) const {
#pragma unroll
        for (int ai = 0; ai < 2; ++ai)
#pragma unroll
            for (int m = 0; m < 4; ++m) {
                const long row = u.arow + ai * HALF + wr * 64 + m * 16 + fr;
#pragma unroll
                for (int bj = 0; bj < 2; ++bj) {
                    const int col = u.pn * BM + bj * HALF + wc * 32 + 8 * fq;
                    const u32x4 yy = *(const u32x4*)(y + row * 512 + col);
                    const f32x4 v0 = acc[ai][bj][m][0], v1 = acc[ai][bj][m][1];
                    float o[8];
#pragma unroll
                    for (int e = 0; e < 4; ++e) { o[e] = sigmoidf_(v0[e]); o[4 + e] = sigmoidf_(v1[e]); }
#pragma unroll
                    for (int e = 0; e < 4; ++e) { o[2 * e] *= bf2f((bf16_t)(yy[e] & 0xffff)); o[2 * e + 1] *= bf2f((bf16_t)(yy[e] >> 16)); }
                    *(u32x4*)(ycat + row * 1024 + 512 + col) = (u32x4){pack2(o[0], o[1]), pack2(o[2], o[3]), pack2(o[4], o[5]), pack2(o[6], o[7])};
                }
            }
    }
};
struct EpiMoe1 {
    static constexpr bool PERM = true;
    bf16_t* H;
    __device__ __forceinline__ void operator()(const f32x4 (&acc)[2][2][4][2], const Unit& u, int wr, int wc, int fr, int fq) const {
#pragma unroll
        for (int ai = 0; ai < 2; ++ai)
#pragma unroll
            for (int m = 0; m < 4; ++m) {
                const int rl = ai * HALF + wr * 64 + m * 16 + fr;
                if (rl < u.nvalid) {
                    float o[8];
#pragma unroll
                    for (int n = 0; n < 2; ++n)
#pragma unroll
                        for (int e = 0; e < 4; ++e) o[4 * n + e] = siluf_(acc[ai][0][m][n][e]) * acc[ai][1][m][n][e];
                    *(u32x4*)(H + (long)(u.arow + rl) * EFF + u.pn * HALF + wc * 32 + 8 * fq) = (u32x4){pack2(o[0], o[1]), pack2(o[2], o[3]), pack2(o[4], o[5]), pack2(o[6], o[7])};
                }
            }
    }
};
struct EpiMoe2 {
    static constexpr bool PERM = true;
    bf16_t* Y; const float* gate;
    __device__ __forceinline__ void operator()(const f32x4 (&acc)[2][2][4][2], const Unit& u, int wr, int wc, int fr, int fq) const {
#pragma unroll
        for (int ai = 0; ai < 2; ++ai)
#pragma unroll
            for (int m = 0; m < 4; ++m) {
                const int rl = ai * HALF + wr * 64 + m * 16 + fr;
                if (rl < u.nvalid) {
                    const float g = gate[u.lrow + rl];
                    bf16_t* rowp = Y + (long)(u.arow + rl) * DM + u.pn * BM + wc * 32 + 8 * fq;
#pragma unroll
                    for (int bj = 0; bj < 2; ++bj) { const f32x4 v0 = acc[ai][bj][m][0] * g, v1 = acc[ai][bj][m][1] * g;
                        *(u32x4*)(rowp + bj * HALF) = (u32x4){pack2(v0[0], v0[1]), pack2(v0[2], v0[3]), pack2(v1[0], v1[1]), pack2(v1[2], v1[3])}; }
                }
            }
    }
};
}

template <class Epi>
__device__ __forceinline__ void gemm_dense(const bf16_t* A, const bf16_t* Bt, int M, int N, int K, const Epi& E) {
    pg8::DenseOrder S; S.init(M, N, (int)gridDim.x, (int)blockIdx.x);
    pg8::gemm_phase<Epi, pg8::DenseOrder>((PG8_LAS unsigned char*)LDS_BASE(), A, Bt, K, S, E);
}

__device__ __forceinline__ void phase_ba(const Params& p) {
    float* wl = (float*)LDS_BASE();
    {
        float v_[16];
#pragma unroll
        for (int j = 0; j < 16; ++j) { const int i = TID() + NTHREADS * j; v_[j] = p.w_in[(long)(i >> 3) * 2568 + 2048 + (i & 7)]; }
#pragma unroll
        for (int j = 0; j < 16; ++j) { const int i = TID() + NTHREADS * j; wl[(i & 7) * 1024 + (i >> 3)] = v_[j]; }
    }
    __syncthreads();
    const int lane = TID() & 63, gw = blockIdx.x * NW + (TID() >> 6), nw = gridDim.x * NW;
    constexpr int TPI = 4;
    for (int grp = gw; grp < NT / TPI; grp += nw) {
        const long tok0 = (long)grp * TPI;
        f32x4 xv[TPI][4];
#pragma unroll
        for (int tt = 0; tt < TPI; ++tt)
#pragma unroll
            for (int i = 0; i < 4; ++i) xv[tt][i] = *(const f32x4*)(p.x + (tok0 + tt) * DM + 4 * lane + 256 * i);
#pragma unroll
        for (int tt = 0; tt < TPI; ++tt)
#pragma unroll
            for (int i = 0; i < 4; ++i) *(u32x2*)(p.hb + (tok0 + tt) * DM + 4 * lane + 256 * i) = (u32x2){pack2(xv[tt][i][0], xv[tt][i][1]), pack2(xv[tt][i][2], xv[tt][i][3])};
        float acc[TPI][8];
#pragma unroll
        for (int tt = 0; tt < TPI; ++tt)
#pragma unroll
            for (int n = 0; n < 8; ++n) acc[tt][n] = 0.f;
#pragma unroll
        for (int i = 0; i < 4; ++i)
#pragma unroll
            for (int n = 0; n < 8; ++n) {
                const f32x4 wv = *(const f32x4*)(wl + n * 1024 + 4 * lane + 256 * i);
#pragma unroll
                for (int tt = 0; tt < TPI; ++tt) acc[tt][n] += (xv[tt][i][0] * wv[0] + xv[tt][i][1] * wv[1]) + (xv[tt][i][2] * wv[2] + xv[tt][i][3] * wv[3]);
            }
#pragma unroll
        for (int o = 32; o > 0; o >>= 1)
#pragma unroll
            for (int tt = 0; tt < TPI; ++tt)
#pragma unroll
                for (int n = 0; n < 8; ++n) acc[tt][n] += __shfl_xor(acc[tt][n], o);
        if (lane < 4) {
#pragma unroll
            for (int tt = 0; tt < TPI; ++tt) {
                const float bl = lane == 0 ? acc[tt][0] : lane == 1 ? acc[tt][1] : lane == 2 ? acc[tt][2] : acc[tt][3];
                const float al = lane == 0 ? acc[tt][4] : lane == 1 ? acc[tt][5] : lane == 2 ? acc[tt][6] : acc[tt][7];
                const float xx = al + p.dt_bias[lane];
                const float sp = xx > 20.f ? xx : log1pf(expf(xx));
                p.gbeta[(tok0 + tt) * 4 + lane] = 1.0f / (1.0f + expf(-bl));
                p.gg[(tok0 + tt) * 4 + lane] = -expf(p.a_log[lane]) * sp;
            }
        }
    }
}

__device__ __forceinline__ void phase_gdn_prep(const Params& p) {
    const int t = TID(), lane = t & 63, w = t >> 6;
    constexpr int RUN = 16;
    const int nitems = (NT / RUN) * 3;
    for (int item = (int)blockIdx.x * NW + w; item < nitems; item += (int)gridDim.x * NW) {
        const int i = item % 3, run = item / 3;
        const long tok0 = (long)run * RUN; const int s0 = (int)(tok0 % NS_);
        const int cb = i * 512 + lane * 8;
        u32x4 x[RUN + 3];
#pragma unroll
        for (int j = 0; j < 3; ++j) x[j] = s0 > 0 ? *(const u32x4*)(p.proj + (tok0 - 3 + j) * PROJ_LD + cb) : (u32x4){0u, 0u, 0u, 0u};
#pragma unroll
        for (int k = 0; k < RUN; ++k) x[3 + k] = *(const u32x4*)(p.proj + (tok0 + k) * PROJ_LD + cb);
        f32x4 wv[4][2];
#pragma unroll
        for (int j = 0; j < 4; ++j) { wv[j][0] = *(const f32x4*)(p.conv + j * 1536 + cb); wv[j][1] = *(const f32x4*)(p.conv + j * 1536 + cb + 4); }
        bf16_t* dst = (i == 0 ? p.gq : i == 1 ? p.gk : p.gv) + tok0 * 512 + lane * 8;
#pragma unroll
        for (int k = 0; k < RUN; ++k) {
            float a[8];
#pragma unroll
            for (int e = 0; e < 8; ++e) a[e] = 0.f;
#pragma unroll
            for (int j = 0; j < 4; ++j) {
                const u32x4 xv = x[k + j];
                a[0] += wv[j][0][0] * bf2f((bf16_t)(xv[0] & 0xffff)); a[1] += wv[j][0][1] * bf2f((bf16_t)(xv[0] >> 16));
                a[2] += wv[j][0][2] * bf2f((bf16_t)(xv[1] & 0xffff)); a[3] += wv[j][0][3] * bf2f((bf16_t)(xv[1] >> 16));
                a[4] += wv[j][1][0] * bf2f((bf16_t)(xv[2] & 0xffff)); a[5] += wv[j][1][1] * bf2f((bf16_t)(xv[2] >> 16));
                a[6] += wv[j][1][2] * bf2f((bf16_t)(xv[3] & 0xffff)); a[7] += wv[j][1][3] * bf2f((bf16_t)(xv[3] >> 16));
            }
            float ss = 0.f;
#pragma unroll
            for (int e = 0; e < 8; ++e) { a[e] = siluf_(a[e]); ss += a[e] * a[e]; }
            if (i < 2) {
                ss += __shfl_xor(ss, 1); ss += __shfl_xor(ss, 2); ss += __shfl_xor(ss, 4); ss += __shfl_xor(ss, 8);
                const float sc = rsqrtf(ss + 1e-6f);
#pragma unroll
                for (int e = 0; e < 8; ++e) a[e] *= sc;
            }
            *(u32x4*)(dst + (long)k * 512) = (u32x4){pack2(a[0], a[1]), pack2(a[2], a[3]), pack2(a[4], a[5]), pack2(a[6], a[7])};
        }
    }
}

#ifndef FUSE_PREP
#define FUSE_PREP 1
#endif
constexpr int CLD = 136;
__device__ __forceinline__ void phase_gdn_chunk(const Params& p) {
    const int half = TID() >> 8;
    char* lds = LDS_BASE() + half * 70656;
    float* gc = (float*)lds; float* be = gc + 64; float* eg = be + 64; float* ek = eg + 64; float* bek = ek + 64;
    float* Ls = (float*)(lds + 1280);
    bf16_t* vs = (bf16_t*)(lds + 1280 + 16384); bf16_t* ks = vs + 64 * CLD; bf16_t* qs = ks + 64 * CLD;
    const int t = TID() & 255, lane = t & 63, w = t >> 6, fr = lane & 15, fq = lane >> 4;
    const int nunits = NB_ * 4 * NCH;
    for (int up = blockIdx.x; up * 2 < nunits; up += gridDim.x) {
        const int u = up * 2 + half;
        const int n = u % NCH, hh = (u / NCH) & 3, b = u / (NCH * 4);
        const long tok0 = (long)b * NS_ + n * 64;
        LDS_BARRIER();
#if FUSE_PREP
        {
            const int rg = t >> 4, ch = (t & 15) * 8;
            const int s0 = n * 64 + 4 * rg;
#pragma unroll
            for (int X = 0; X < 3; ++X) {
                const int col = X * 512 + hh * 128 + ch;
                u32x4 x[7];
#pragma unroll
                for (int j = 0; j < 7; ++j) x[j] = (s0 - 3 + j) >= 0 ? *(const u32x4*)(p.proj + (tok0 + 4 * rg - 3 + j) * PROJ_LD + col) : (u32x4){0u, 0u, 0u, 0u};
                f32x4 wv[4][2];
#pragma unroll
                for (int j = 0; j < 4; ++j) { wv[j][0] = *(const f32x4*)(p.conv + j * 1536 + col); wv[j][1] = *(const f32x4*)(p.conv + j * 1536 + col + 4); }
                bf16_t* dl = X == 0 ? qs : X == 1 ? ks : vs;
#pragma unroll
                for (int i = 0; i < 4; ++i) {
                    float a[8];
#pragma unroll
                    for (int e = 0; e < 8; ++e) a[e] = 0.f;
#pragma unroll
                    for (int j = 0; j < 4; ++j) {
                        const u32x4 xv = x[i + j];
                        a[0] += wv[j][0][0] * bf2f((bf16_t)(xv[0] & 0xffff)); a[1] += wv[j][0][1] * bf2f((bf16_t)(xv[0] >> 16));
                        a[2] += wv[j][0][2] * bf2f((bf16_t)(xv[1] & 0xffff)); a[3] += wv[j][0][3] * bf2f((bf16_t)(xv[1] >> 16));
                        a[4] += wv[j][1][0] * bf2f((bf16_t)(xv[2] & 0xffff)); a[5] += wv[j][1][1] * bf2f((bf16_t)(xv[2] >> 16));
                        a[6] += wv[j][1][2] * bf2f((bf16_t)(xv[3] & 0xffff)); a[7] += wv[j][1][3] * bf2f((bf16_t)(xv[3] >> 16));
                    }
                    float ss = 0.f;
#pragma unroll
                    for (int e = 0; e < 8; ++e) { a[e] = siluf_(a[e]); ss += a[e] * a[e]; }
                    if (X < 2) {
                        ss += __shfl_xor(ss, 1); ss += __shfl_xor(ss, 2); ss += __shfl_xor(ss, 4); ss += __shfl_xor(ss, 8);
                        const float sc = rsqrtf(ss + 1e-6f);
#pragma unroll
                        for (int e = 0; e < 8; ++e) a[e] *= sc;
                    }
                    *(u32x4*)(dl + (4 * rg + i) * CLD + ch) = (u32x4){pack2(a[0], a[1]), pack2(a[2], a[3]), pack2(a[4], a[5]), pack2(a[6], a[7])};
                }
            }
        }
#else
#pragma unroll
        for (int i = 0; i < 4; ++i) {
            const int c = t + 256 * i, row = c >> 4, ch = (c & 15) * 8;
            const long go_ = (tok0 + row) * 512 + hh * 128 + ch;
            *(u32x4*)(qs + row * CLD + ch) = *(const u32x4*)(p.gq + go_);
            *(u32x4*)(ks + row * CLD + ch) = *(const u32x4*)(p.gk + go_);
            *(u32x4*)(vs + row * CLD + ch) = *(const u32x4*)(p.gv + go_);
        }
#endif
        if (w == 0) {
            float v = p.gg[(tok0 + lane) * 4 + hh];
#pragma unroll
            for (int o = 1; o < 64; o <<= 1) { const float nb = __shfl_up(v, o); if (lane >= o) v += nb; }
            const float gl = __shfl(v, 63);
            const float bt = p.gbeta[(tok0 + lane) * 4 + hh];
            gc[lane] = v; be[lane] = bt; eg[lane] = expf(v); ek[lane] = expf(gl - v); bek[lane] = bt * expf(v);
            if (lane == 0) WT_STORE_F(p.cgl + u, expf(gl));
        }
        LDS_BARRIER();
        {
            f32x4 akk[4], aqk[4];
#pragma unroll
            for (int nn = 0; nn < 4; ++nn) { akk[nn] = (f32x4){0.f, 0.f, 0.f, 0.f}; aqk[nn] = (f32x4){0.f, 0.f, 0.f, 0.f}; }
#pragma unroll
            for (int k4 = 0; k4 < 4; ++k4) {
                const bf16x8 afk = *(const bf16x8*)(ks + (16 * w + fr) * CLD + k4 * 32 + fq * 8);
                const bf16x8 afq = *(const bf16x8*)(qs + (16 * w + fr) * CLD + k4 * 32 + fq * 8);
#pragma unroll
                for (int nn = 0; nn < 4; ++nn) {
                    const bf16x8 bfr = *(const bf16x8*)(ks + (16 * nn + fr) * CLD + k4 * 32 + fq * 8);
                    akk[nn] = __builtin_amdgcn_mfma_f32_16x16x32_bf16(bfr, afk, akk[nn], 0, 0, 0);
                    aqk[nn] = __builtin_amdgcn_mfma_f32_16x16x32_bf16(bfr, afq, aqk[nn], 0, 0, 0);
                }
            }
            const int i = 16 * w + fr; const float gci = gc[i], bei = be[i];
#pragma unroll
            for (int nn = 0; nn < 4; ++nn) {
                const int j0 = 16 * nn + 4 * fq;
                f32x4 lv; float qv[4];
#pragma unroll
                for (int r = 0; r < 4; ++r) {
                    const int j = j0 + r;
                    const float dec = i >= j ? expf(gci - gc[j]) : 0.f;
                    lv[r] = i > j ? bei * akk[nn][r] * dec : 0.f;
                    qv[r] = 0.08838834764831845f * aqk[nn][r] * dec;
                }
                *(f32x4*)(Ls + i * 64 + j0) = lv;
                *(u32x2*)(p.cQK + (long)u * 8192 + i * 64 + j0) = (u32x2){pack2(qv[0], qv[1]), pack2(qv[2], qv[3])};
            }
        }
        LDS_BARRIER();
        {
            const int c = t & 127; const bf16_t* src = t < 128 ? vs : ks; const float* mulp = t < 128 ? be : bek;
            float x[64];
#pragma unroll
            for (int i = 0; i < 64; ++i) {
                float a = mulp[i] * bf2f(src[i * CLD + c]);
#pragma unroll
                for (int j4 = 0; j4 < (i + 3) / 4; ++j4) {
                    const f32x4 l4 = *(const f32x4*)(Ls + i * 64 + 4 * j4);
                    if (4 * j4 + 0 < i) a = fmaf(-l4[0], x[4 * j4 + 0], a);
                    if (4 * j4 + 1 < i) a = fmaf(-l4[1], x[4 * j4 + 1], a);
                    if (4 * j4 + 2 < i) a = fmaf(-l4[2], x[4 * j4 + 2], a);
                    if (4 * j4 + 3 < i) a = fmaf(-l4[3], x[4 * j4 + 3], a);
                }
                x[i] = a;
                asm volatile("" ::: "memory");
            }
            LDS_BARRIER();
            bf16_t* Wt = (bf16_t*)Ls;
            if (t < 128) {
#pragma unroll
                for (int i = 0; i < 64; ++i) vs[i * CLD + c] = f2bf(x[i]);
            } else {
#pragma unroll
                for (int i = 0; i < 64; ++i) Wt[i * 128 + c] = f2bf(x[i]);
            }
        }
        LDS_BARRIER();
#pragma unroll
        for (int e = 0; e < 4; ++e) {
            const int id = t + 256 * e, row = id >> 4, ch = (id & 15) * 8;
            *(u32x4*)(p.cU + (long)u * 8192 + row * 128 + ch) = *(const u32x4*)(vs + row * CLD + ch);
            *(u32x4*)(p.cW + (long)u * 8192 + row * 128 + ch) = *(const u32x4*)((const bf16_t*)Ls + row * 128 + ch);
            {
                const u32x4 qv = *(const u32x4*)(qs + row * CLD + ch); const float sc = 0.08838834764831845f * eg[row];
                unsigned o4[4];
#pragma unroll
                for (int k = 0; k < 4; ++k) o4[k] = pack2(bf2f((bf16_t)(qv[k] & 0xffff)) * sc, bf2f((bf16_t)(qv[k] >> 16)) * sc);
                *(u32x4*)(p.cQd + (long)u * 8192 + row * 128 + ch) = (u32x4){o4[0], o4[1], o4[2], o4[3]};
            }
            {
                const int d = id >> 3, i0 = (id & 7) * 8;
                float kv[8];
#pragma unroll
                for (int k = 0; k < 8; ++k) kv[k] = bf2f(ks[(i0 + k) * CLD + d]) * ek[i0 + k];
                *(u32x4*)(p.cKdT + (long)u * 8192 + d * 64 + i0) = (u32x4){pack2(kv[0], kv[1]), pack2(kv[2], kv[3]), pack2(kv[4], kv[5]), pack2(kv[6], kv[7])};
            }
        }
    }
}

#define GO_STORE(ptr, lo, hi) (*(u32x2*)(ptr) = (u32x2){(lo), (hi)})
#ifndef SCAN_XCD_REMAP
#define SCAN_XCD_REMAP 1
#endif
struct ScanOwn { bf16x8 f[7]; u32x2 uvr; };
__device__ __forceinline__ const bf16_t* scan_slot_ptr(const Params& p, int s, int w, int fr, int fq) {
    if (s < 4) return p.cW + (16 * w + fr) * 128 + s * 32 + fq * 8;
    if (s < 8) return p.cQd + (16 * w + fr) * 128 + (s - 4) * 32 + fq * 8;
    if (s < 12) return p.cKdT + (32 * w + 16 * ((s - 8) >> 1) + fr) * 64 + ((s - 8) & 1) * 32 + fq * 8;
    return p.cQK + (16 * w + fr) * 64 + (s - 12) * 32 + fq * 8;
}
#define SCAN_LOAD(P, cu_) do { const long co_ = (long)(cu_) * 8192; \
        _Pragma("unroll") for (int j = 0; j < 7; ++j) P.f[j] = *(const bf16x8*)(sp[j] + co_); \
        P.uvr = *(const u32x2*)(up + co_); } while (0)
#define SCAN_STEP(Pw, n_) do { \
        const long cu_ = cu0 + (n_); const long tokr = (long)b * NS_ + (n_) * 64 + 16 * w + fr; \
        bf16x8 sb[4]; \
        _Pragma("unroll") for (int k4 = 0; k4 < 4; ++k4) sb[k4] = *(const bf16x8*)(SbT + fr * CLD + k4 * 32 + fq * 8); \
        f32x4 vw = (f32x4){0.f, 0.f, 0.f, 0.f}, o = (f32x4){0.f, 0.f, 0.f, 0.f}; \
        _Pragma("unroll") for (int k4 = 0; k4 < 4; ++k4) { vw = __builtin_amdgcn_mfma_f32_16x16x32_bf16(sb[k4], F[k4], vw, 0, 0, 0); o = __builtin_amdgcn_mfma_f32_16x16x32_bf16(sb[k4], F[4 + k4], o, 0, 0, 0); } \
          \
        { const u32x2 uvc = *(const u32x2*)ub; const unsigned u0_ = uvc[0], u1_ = uvc[1]; \
          VnT[(4 * fq + 0) * 72 + 16 * w + fr] = f2bf(bf2f((bf16_t)(u0_ & 0xffff)) - vw[0]); VnT[(4 * fq + 1) * 72 + 16 * w + fr] = f2bf(bf2f((bf16_t)(u0_ >> 16)) - vw[1]); \
          VnT[(4 * fq + 2) * 72 + 16 * w + fr] = f2bf(bf2f((bf16_t)(u1_ & 0xffff)) - vw[2]); VnT[(4 * fq + 3) * 72 + 16 * w + fr] = f2bf(bf2f((bf16_t)(u1_ >> 16)) - vw[3]); } \
        LDS_BARRIER(); \
        _Pragma("unroll") for (int j = 0; j < 7; ++j) *(bf16x8*)(xw + j * 512) = Pw.f[j];                   \
        *(u32x2*)ub = Pw.uvr;                                                                                \
        const float glc = glbuf[(n_)]; \
        bf16x8 vb[2]; \
        _Pragma("unroll") for (int k2 = 0; k2 < 2; ++k2) vb[k2] = *(const bf16x8*)(VnT + fr * 72 + k2 * 32 + fq * 8); \
        _Pragma("unroll") for (int k2 = 0; k2 < 2; ++k2) o = __builtin_amdgcn_mfma_f32_16x16x32_bf16(vb[k2], F[12 + k2], o, 0, 0, 0); \
        GO_STORE((p.go + tokr * 512 + hh * 128 + vsl * 16 + 4 * fq), pack2(o[0], o[1]), pack2(o[2], o[3])); \
        _Pragma("unroll") for (int m = 0; m < 2; ++m) { \
            sacc[m] = sacc[m] * glc; \
            _Pragma("unroll") for (int k2 = 0; k2 < 2; ++k2) sacc[m] = __builtin_amdgcn_mfma_f32_16x16x32_bf16(F[8 + 2 * m + k2], vb[k2], sacc[m], 0, 0, 0); \
            *(u32x2*)(SbT + fr * CLD + 32 * w + 16 * m + 4 * fq) = (u32x2){pack2(sacc[m][0], sacc[m][1]), pack2(sacc[m][2], sacc[m][3])}; \
        } \
        LDS_BARRIER(); \
        _Pragma("unroll") for (int k = 0; k < 14; ++k) F[k] = *(const bf16x8*)(xr + k * 512);                \
        { const long c3_ = cu_ + 3 < culast ? cu_ + 3 : culast; SCAN_LOAD(Pw, c3_); } \
    } while (0)
#ifdef EMU
#define PIN2(a, b) do { } while (0)
#else
#define PIN2(a, b) asm volatile("" : "+v"(a), "+v"(b))
#endif
__device__ __forceinline__ void phase_gdn_scan(const Params& p, int nblk) {
    const int half = TID() >> 8;
    bf16_t* SbT = (bf16_t*)(LDS_BASE() + half * 8192);
    bf16_t* VnT = SbT + 16 * CLD;
    const int t = TID() & 255, lane = t & 63, w = t >> 6, fr = lane & 15, fq = lane >> 4;
    bf16_t* xbuf = (bf16_t*)(LDS_BASE() + 16384) + w * (14 * 512);
    bf16_t* xw = xbuf + half * (7 * 512) + lane * 8; const bf16_t* xr = xbuf + lane * 8;
    unsigned* ub = (unsigned*)(LDS_BASE() + 16384 + 4 * 14336) + ((half * 4 + w) * 64 + lane) * 2;
    float* glbuf = (float*)(LDS_BASE() + 16384 + 4 * 14336 + 4096);
    const int nunits = NB_ * 4 * 8;
    for (int x = blockIdx.x; x * 2 < nunits; x += nblk) {
        int up_ = x;
        if (SCAN_XCD_REMAP && (nblk & 31) == 0 && (nunits & 63) == 0) { const int xcd = x & 7, slot = x >> 3; up_ = 4 * ((slot >> 2) * 8 + xcd) + (slot & 3); }
        const int u = up_ * 2 + half;
        const int vsl = u & 7, hh = (u >> 3) & 3, b = u >> 5;
        const long cu0 = (long)(b * 4 + hh) * NCH, culast = cu0 + NCH - 1;
        const bf16_t* sp[7];
#pragma unroll
        for (int j = 0; j < 7; ++j) { const bf16_t* p0 = scan_slot_ptr(p, j, w, fr, fq); const bf16_t* p1 = scan_slot_ptr(p, 7 + j, w, fr, fq); sp[j] = half ? p1 : p0; }
        const bf16_t* up = p.cU + (16 * w + fr) * 128 + vsl * 16 + 4 * fq;
        LDS_BARRIER();
        for (int i = t; i < 16 * CLD; i += 256) SbT[i] = 0;
        f32x4 sacc[2] = {(f32x4){0.f, 0.f, 0.f, 0.f}, (f32x4){0.f, 0.f, 0.f, 0.f}};
        ScanOwn PA, PB; bf16x8 F[14];
        for (int i = TID(); i < NCH; i += NTHREADS) glbuf[i] = p.cgl[cu0 + i];
        SCAN_LOAD(PA, cu0); { const long c1_ = cu0 + 1 < culast ? cu0 + 1 : culast; SCAN_LOAD(PB, c1_); }
#pragma unroll
        for (int j = 0; j < 7; ++j) *(bf16x8*)(xw + j * 512) = PA.f[j];
        *(u32x2*)ub = PA.uvr;
        LDS_BARRIER();
#pragma unroll
        for (int k = 0; k < 14; ++k) F[k] = *(const bf16x8*)(xr + k * 512);
        { const long c2_ = cu0 + 2 < culast ? cu0 + 2 : culast; SCAN_LOAD(PA, c2_); }
        int n = 0;
#pragma unroll 1
        for (; n + 2 <= NCH; n += 2) {
            SCAN_STEP(PB, n);
            SCAN_STEP(PA, n + 1);
        }
    }
}
#undef SCAN_STEP
#undef SCAN_LOAD

__device__ __forceinline__ void phase_gdn_post(const Params& p) {
    const int lane = TID() & 63; const int gw = blockIdx.x * NW + (TID() >> 6), nw = gridDim.x * NW;
    const f32x4 nw0 = *(const f32x4*)(p.gnorm + (lane & 15) * 8), nw1 = *(const f32x4*)(p.gnorm + (lane & 15) * 8 + 4);
    for (int g8 = gw; g8 < NT / 8; g8 += nw) {
        const long tok0 = (long)g8 * 8;
        u32x4 ov[8], zv[8];
#pragma unroll
        for (int k = 0; k < 8; ++k) { ov[k] = *(const u32x4*)(p.go + (tok0 + k) * 512 + lane * 8); zv[k] = *(const u32x4*)(p.proj + (tok0 + k) * PROJ_LD + 1536 + lane * 8); }
#pragma unroll
        for (int k = 0; k < 8; ++k) {
            float o[8], z[8];
#pragma unroll
            for (int e = 0; e < 4; ++e) { o[2 * e] = bf2f((bf16_t)(ov[k][e] & 0xffff)); o[2 * e + 1] = bf2f((bf16_t)(ov[k][e] >> 16)); z[2 * e] = bf2f((bf16_t)(zv[k][e] & 0xffff)); z[2 * e + 1] = bf2f((bf16_t)(zv[k][e] >> 16)); }
            float ss = 0.f;
#pragma unroll
            for (int e = 0; e < 8; ++e) ss += o[e] * o[e];
            ss += __shfl_xor(ss, 1); ss += __shfl_xor(ss, 2); ss += __shfl_xor(ss, 4); ss += __shfl_xor(ss, 8);
            const float rs = rsqrtf(ss * (1.0f / 128.0f) + 1e-6f);
            float r[8];
#pragma unroll
            for (int e = 0; e < 4; ++e) { r[e] = o[e] * rs * nw0[e] * siluf_(z[e]); r[4 + e] = o[4 + e] * rs * nw1[e] * siluf_(z[4 + e]); }
            *(u32x4*)(p.ycat + (tok0 + k) * 1024 + lane * 8) = (u32x4){pack2(r[0], r[1]), pack2(r[2], r[3]), pack2(r[4], r[5]), pack2(r[6], r[7])};
        }
    }
}

__device__ __forceinline__ float gelu_tanh(float x) { return 0.5f * x * (1.0f + tanhf(0.7978845608028654f * (x + 0.044715f * x * x * x))); }
#ifndef S5_CARRY
#define S5_CARRY 1
#endif
#ifdef EMU
#define CARRY_PIN(a, b) do { } while (0)
#else
#define CARRY_PIN(a, b) asm volatile("" : "+v"(a), "+v"(b))
#endif
#define WAVE_SYNC() LDS_BARRIER()
constexpr int S5_NSEG1 = NCH >= 16 ? 8 : NCH / 2, S5_NSEG2 = NCH >= 8 ? 4 : NCH / 2;
struct S5Task { bf16x8 bfm[8]; bf16x8 cf[4]; float ar, ai; f32x4 dsk; };
struct S5In { bf16x8 uf[4]; u32x2 uu[4]; };
template <int PASS>
__device__ __forceinline__ void s5_task_init(const Params& p, S5Task& T, int g, int lane, int fr, int fq) {
    bf16x8 zf;
#pragma unroll
    for (int e = 0; e < 8; ++e) zf[e] = 0;
#pragma unroll
    for (int nt = 0; nt < 8; ++nt) T.bfm[nt] = fq < 2 ? *(const bf16x8*)(p.s5bbm + ((long)g * 128 + 16 * nt + fr) * 16 + 8 * fq) : zf;
    if (PASS == 2) {
#pragma unroll
        for (int k4 = 0; k4 < 4; ++k4) T.cf[k4] = *(const bf16x8*)(p.s5cm + (g * 16 + fr) * 128 + k4 * 32 + fq * 8);
        T.dsk = *(const f32x4*)(p.s5d + g * 16 + 4 * fq);
    }
    T.ar = p.s5a[(g * 64 + lane) * 2]; T.ai = p.s5a[(g * 64 + lane) * 2 + 1];
}
template <int PASS>
__device__ __forceinline__ void s5_load(const Params& p, S5In& I, int g, long tok0, int fr, int fq) {
    bf16x8 zf;
#pragma unroll
    for (int e = 0; e < 8; ++e) zf[e] = 0;
#pragma unroll
    for (int mt = 0; mt < 4; ++mt) I.uf[mt] = fq < 2 ? *(const bf16x8*)(p.proj + (tok0 + 16 * mt + fr) * PROJ_LD + 2048 + g * 16 + 8 * fq) : zf;
    if (PASS == 2) {
#pragma unroll
        for (int mt = 0; mt < 4; ++mt) I.uu[mt] = *(const u32x2*)(p.proj + (tok0 + 16 * mt + fr) * PROJ_LD + 2048 + g * 16 + 4 * fq);
    }
}
template <int PASS>
__device__ __forceinline__ void s5_unit(const Params& p, bf16_t* hs, const S5Task& T, const S5In& I, int g, long tok0, float& hr, float& hi, int lane, int fr, int fq) {
#pragma unroll
    for (int nt = 0; nt < 8; ++nt)
#pragma unroll
        for (int mt = 0; mt < 4; ++mt) {
            f32x4 d = (f32x4){0.f, 0.f, 0.f, 0.f};
            d = __builtin_amdgcn_mfma_f32_16x16x32_bf16(T.bfm[nt], I.uf[mt], d, 0, 0, 0);
            *(u32x2*)(hs + (16 * mt + fr) * CLD + 16 * nt + 4 * fq) = (u32x2){pack2(d[0], d[1]), pack2(d[2], d[3])};
        }
    WAVE_SYNC();
    const float ar = T.ar, ai = T.ai;
#pragma unroll 8
    for (int j = 0; j < 64; ++j) {
        const float br = bf2f(hs[j * CLD + lane]), bi = bf2f(hs[j * CLD + 64 + lane]);
        const float nr = ar * hr - ai * hi + br, ni = ar * hi + ai * hr + bi;
        hr = nr; hi = ni;
        if (PASS == 2) { hs[j * CLD + lane] = f2bf(hr); hs[j * CLD + 64 + lane] = f2bf(hi); }
    }
    if (PASS == 2) {
        WAVE_SYNC();
        f32x4 acc[4];
#pragma unroll
        for (int mt = 0; mt < 4; ++mt) acc[mt] = (f32x4){0.f, 0.f, 0.f, 0.f};
#pragma unroll
        for (int k4 = 0; k4 < 4; ++k4)
#pragma unroll
            for (int mt = 0; mt < 4; ++mt) {
                const bf16x8 hf = *(const bf16x8*)(hs + (16 * mt + fr) * CLD + k4 * 32 + fq * 8);
                acc[mt] = __builtin_amdgcn_mfma_f32_16x16x32_bf16(T.cf[k4], hf, acc[mt], 0, 0, 0);
            }
#pragma unroll
        for (int mt = 0; mt < 4; ++mt) {
            const int j = 16 * mt + fr;
            const u32x2 uu = I.uu[mt];
            const float y0 = acc[mt][0] + T.dsk[0] * bf2f((bf16_t)(uu[0] & 0xffff)), y1 = acc[mt][1] + T.dsk[1] * bf2f((bf16_t)(uu[0] >> 16));
            const float y2 = acc[mt][2] + T.dsk[2] * bf2f((bf16_t)(uu[1] & 0xffff)), y3 = acc[mt][3] + T.dsk[3] * bf2f((bf16_t)(uu[1] >> 16));
            *(u32x2*)(p.ygelu + (tok0 + j) * 512 + g * 16 + 4 * fq) = (u32x2){pack2(gelu_tanh(y0), gelu_tanh(y1)), pack2(gelu_tanh(y2), gelu_tanh(y3))};
        }
    }
    WAVE_SYNC();
}
template <int PASS>
__device__ __forceinline__ void phase_s5_pass(const Params& p, int blk0) {
    const int t = TID(), lane = t & 63, w = t >> 6, fr = lane & 15, fq = lane >> 4;
    bf16_t* hs = (bf16_t*)(LDS_BASE() + w * (64 * CLD * 2));
    constexpr int S5_NSEG = PASS == 1 ? S5_NSEG1 : S5_NSEG2, S5_CPS = NCH / S5_NSEG;
    const int ntasks = NB_ * 32 * S5_NSEG;
    if ((int)blockIdx.x < blk0) return;
    for (int bt = (int)blockIdx.x - blk0; bt < ntasks / NW; bt += (int)gridDim.x - blk0) {
        const int task = bt * NW + w;
        const int g = task & 31, seg = (task >> 5) % S5_NSEG, b = task / (32 * S5_NSEG);
        S5Task T; s5_task_init<PASS>(p, T, g, lane, fr, fq);
        const int c0 = seg * S5_CPS;
        S5In IA, IB;
        s5_load<PASS>(p, IA, g, ((long)b * NCH + c0) * 64, fr, fq);
        float hr = 0.f, hi = 0.f;
        if (PASS == 2 && S5_CARRY) {
            const float a64r = p.s5a64[(g * 64 + lane) * 2], a64i = p.s5a64[(g * 64 + lane) * 2 + 1];
            const long base = ((long)b * NCH * 32 + g) * 64 + lane;
            constexpr int CG = S5_CPS >= 8 ? 8 : S5_CPS;
#pragma unroll 1
            for (int c8 = 0; c8 < c0; c8 += CG) {
                float lr[CG], li[CG];
#pragma unroll
                for (int k = 0; k < CG; ++k) { lr[k] = p.s5loc[(base + (long)(c8 + k) * 2048) * 2]; li[k] = p.s5loc[(base + (long)(c8 + k) * 2048) * 2 + 1]; }
#pragma unroll
                for (int k = 0; k < CG; ++k) {
                    float nr = fmaf(a64r, hr, lr[k]), ni = fmaf(a64r, hi, li[k]);
                    CARRY_PIN(nr, ni);
                    nr = fmaf(-a64i, hi, nr); ni = fmaf(a64i, hr, ni);
                    CARRY_PIN(nr, ni);
                    hr = nr; hi = ni;
                }
            }
        }
#pragma unroll 1
        for (int c = c0; c < c0 + S5_CPS; c += 2) {
            const long tokA = ((long)b * NCH + c) * 64, tokB = tokA + 64;
            s5_load<PASS>(p, IB, g, tokB, fr, fq);
            if (PASS == 1) { hr = 0.f; hi = 0.f; }
            s5_unit<PASS>(p, hs, T, IA, g, tokA, hr, hi, lane, fr, fq);
            if (PASS == 1) { const long unit = ((long)b * NCH + c) * 32 + g; p.s5loc[(unit * 64 + lane) * 2] = hr; p.s5loc[(unit * 64 + lane) * 2 + 1] = hi; hr = 0.f; hi = 0.f; }
            if (c + 2 < c0 + S5_CPS) s5_load<PASS>(p, IA, g, tokB + 64, fr, fq);
            s5_unit<PASS>(p, hs, T, IB, g, tokB, hr, hi, lane, fr, fq);
            if (PASS == 1) { const long unit = ((long)b * NCH + c + 1) * 32 + g; p.s5loc[(unit * 64 + lane) * 2] = hr; p.s5loc[(unit * 64 + lane) * 2 + 1] = hi; }
        }
    }
}

struct LnrRow { f32x4 xf[4]; u32x2 xh[4]; u32x2 mm[4]; };
template <bool F32IN>
__device__ __forceinline__ void lnr_load(const Params& p, LnrRow& R, const float* hin, const bf16_t* mixp, long tok, int lane) {
#pragma unroll
    for (int i = 0; i < 4; ++i) {
        const int k = 4 * lane + 256 * i;
        if (F32IN) R.xf[i] = *(const f32x4*)(hin + tok * DM + k); else R.xh[i] = *(const u32x2*)(p.hb + tok * DM + k);
        R.mm[i] = *(const u32x2*)(mixp + tok * DM + k);
    }
}
template <bool F32IN>
__device__ __forceinline__ void lnr_process(const Params& p, int layer, const LnrRow& R, const f32x4 (&gv)[4], const f32x4 (&bv)[4], const float* Wr,
                                            int* lcount, int* le, int* lrank, float* lgate, int lt, long tok, int lane, bool dry = false) {
    float h[16];
    float s = 0.f;
#pragma unroll
    for (int i = 0; i < 4; ++i) {
        f32x4 xv;
        if (F32IN) xv = R.xf[i];
        else { const u32x2 xx = R.xh[i]; xv = (f32x4){bf2f((bf16_t)(xx[0] & 0xffff)), bf2f((bf16_t)(xx[0] >> 16)), bf2f((bf16_t)(xx[1] & 0xffff)), bf2f((bf16_t)(xx[1] >> 16))}; }
        const u32x2 mm = R.mm[i];
        h[4 * i + 0] = ALPHA * xv[0] + bf2f((bf16_t)(mm[0] & 0xffff)); h[4 * i + 1] = ALPHA * xv[1] + bf2f((bf16_t)(mm[0] >> 16));
        h[4 * i + 2] = ALPHA * xv[2] + bf2f((bf16_t)(mm[1] & 0xffff)); h[4 * i + 3] = ALPHA * xv[3] + bf2f((bf16_t)(mm[1] >> 16));
        s += (h[4 * i] + h[4 * i + 1]) + (h[4 * i + 2] + h[4 * i + 3]);
    }
    const float mean = wave_sum(s) * (1.0f / DM);
    float q = 0.f;
#pragma unroll
    for (int e = 0; e < 16; ++e) { const float d = h[e] - mean; q += d * d; }
    const float rstd = rsqrtf(wave_sum(q) * (1.0f / DM) + LN_EPS);
#pragma unroll
    for (int i = 0; i < 4; ++i) {
        const int k = 4 * lane + 256 * i;
#pragma unroll
        for (int e = 0; e < 4; ++e) h[4 * i + e] = (h[4 * i + e] - mean) * rstd * gv[i][e] + bv[i][e];
        if (!dry) NT_STORE((u32x2*)(p.hb + tok * DM + k), ((u32x2){pack2(h[4 * i], h[4 * i + 1]), pack2(h[4 * i + 2], h[4 * i + 3])}));
        else NT_STORE((u32x2*)(p.H + tok * DM + k), ((u32x2){pack2(h[4 * i], h[4 * i + 1]), pack2(h[4 * i + 2], h[4 * i + 3])}));
    }
    float gl[4];
#pragma unroll
    for (int n = 0; n < 4; ++n) {
        float a = 0.f;
#pragma unroll
        for (int i = 0; i < 4; ++i) { const f32x4 wv = *(const f32x4*)(Wr + n * 1024 + 4 * lane + 256 * i); a += h[4 * i] * wv[0] + h[4 * i + 1] * wv[1] + h[4 * i + 2] * wv[2] + h[4 * i + 3] * wv[3]; }
        gl[n] = a;
    }
#pragma unroll
    for (int o = 32; o > 0; o >>= 1)
#pragma unroll
        for (int n = 0; n < 4; ++n) gl[n] += __shfl_xor(gl[n], o);
#pragma unroll
    for (int n = 0; n < 4; ++n) gl[n] += p.rgb[layer * 4 + n];
    int grp = 0; float gm = gl[0];
#pragma unroll
    for (int n = 1; n < 4; ++n) if (gl[n] > gm) { gm = gl[n]; grp = n; }
    float den = 0.f;
#pragma unroll
    for (int n = 0; n < 4; ++n) den += expf(gl[n] - gm);
    const float pg = 1.0f / den;
    float m1 = -3.0e38f, m2 = -3.0e38f; int i1 = 0, i2 = 0;
    float el8[8];
#pragma unroll
    for (int j = 0; j < 8; ++j) {
        const float* wrow = Wr + (long)(4 + grp * 8 + j) * 1024;
        float a = 0.f;
#pragma unroll
        for (int i = 0; i < 4; ++i) { const f32x4 wv = *(const f32x4*)(wrow + 4 * lane + 256 * i); a += h[4 * i] * wv[0] + h[4 * i + 1] * wv[1] + h[4 * i + 2] * wv[2] + h[4 * i + 3] * wv[3]; }
        el8[j] = a;
    }
#pragma unroll
    for (int o = 32; o > 0; o >>= 1)
#pragma unroll
        for (int j = 0; j < 8; ++j) el8[j] += __shfl_xor(el8[j], o);
#pragma unroll
    for (int j = 0; j < 8; ++j) {
        const float el = el8[j] + p.reb[layer * 32 + grp * 8 + j];
        if (el > m1) { m2 = m1; i2 = i1; m1 = el; i1 = j; } else if (el > m2) { m2 = el; i2 = j; }
    }
    if (lane == 0) {
        const float g1 = 1.0f / (1.0f + expf(m2 - m1));
        const int e0 = grp * 8 + i1, e1 = grp * 8 + i2;
        le[lt * 2] = e0; le[lt * 2 + 1] = e1; lgate[lt * 2] = pg * g1; lgate[lt * 2 + 1] = pg * (1.0f - g1);
        lrank[lt * 2] = atomicAdd(&lcount[e0], 1); lrank[lt * 2 + 1] = atomicAdd(&lcount[e1], 1);
    }
}
__device__ __forceinline__ void phase_ln_router(const Params& p, int layer, const float* hin, const bf16_t* mixp, bool dry = false) {
    float* Wr = (float*)LDS_BASE();
    int* li = (int*)(LDS_BASE() + 36 * 1024 * 4);
    int* lcount = li; int* lbase = li + 32; int* le = li + 64; int* lrank = li + 64 + 128; float* lgate = (float*)(li + 64 + 256);
    const int t = TID(), lane = t & 63, w = t >> 6;
    f32x4 gv[4], bv[4];
#pragma unroll
    for (int i = 0; i < 4; ++i) { gv[i] = *(const f32x4*)(p.lnmg + layer * DM + 4 * lane + 256 * i); bv[i] = *(const f32x4*)(p.lnmb + layer * DM + 4 * lane + 256 * i); }
    { const f32x4* src = (const f32x4*)(p.WrT + (long)layer * 36 * 1024); f32x4* dst = (f32x4*)Wr;
#pragma unroll
      for (int r = 0; r < 2; ++r) {
          f32x4 v[9];
#pragma unroll
          for (int j = 0; j < 9; ++j) v[j] = src[t + NTHREADS * (9 * r + j)];
#pragma unroll
          for (int j = 0; j < 9; ++j) dst[t + NTHREADS * (9 * r + j)] = v[j];
      } }
    for (int bb = blockIdx.x; bb < NT / 64; bb += gridDim.x) {
        __syncthreads();
        if (t < 32) lcount[t] = 0;
        __syncthreads();
        {
            const long tokb = (long)bb * 64 + w * (64 / NW);
            LnrRow RA, RB;
            if (hin) lnr_load<true>(p, RA, hin, mixp, tokb, lane); else lnr_load<false>(p, RA, hin, mixp, tokb, lane);
#pragma unroll 1
            for (int it = 0; it < 64 / NW; it += 2) {
                const long tn = tokb + (it + 2 < 64 / NW ? it + 2 : it + 1);
                if (hin) {
                    lnr_load<true>(p, RB, hin, mixp, tokb + it + 1, lane);
                    lnr_process<true>(p, layer, RA, gv, bv, Wr, lcount, le, lrank, lgate, w * (64 / NW) + it, tokb + it, lane, dry);
                    lnr_load<true>(p, RA, hin, mixp, tn, lane);
                    lnr_process<true>(p, layer, RB, gv, bv, Wr, lcount, le, lrank, lgate, w * (64 / NW) + it + 1, tokb + it + 1, lane, dry);
                } else {
                    lnr_load<false>(p, RB, hin, mixp, tokb + it + 1, lane);
                    lnr_process<false>(p, layer, RA, gv, bv, Wr, lcount, le, lrank, lgate, w * (64 / NW) + it, tokb + it, lane, dry);
                    lnr_load<false>(p, RA, hin, mixp, tn, lane);
                    lnr_process<false>(p, layer, RB, gv, bv, Wr, lcount, le, lrank, lgate, w * (64 / NW) + it + 1, tokb + it + 1, lane, dry);
                }
            }
        }
        __syncthreads();
        if (t < 32) lbase[t] = (lcount[t] > 0 && !dry) ? atomicAdd(p.cnt + layer * 32 + t, lcount[t]) : 0;
        __syncthreads();
        if (t < 128 && !dry) {
            const int e = le[t], pos = lbase[e] + lrank[t]; const long tok = (long)bb * 64 + (t >> 1);
            p.tok_e[tok * 2 + (t & 1)] = e; p.tok_pos[tok * 2 + (t & 1)] = pos; p.tok_gate[tok * 2 + (t & 1)] = lgate[t];
            WT_STORE_I(p.list + (long)e * LIST_CAP + pos, (int)tok); WT_STORE_F(p.list_gate + (long)e * LIST_CAP + pos, lgate[t]);
        }
    }
}

__device__ __forceinline__ void moe_map(const Params& p, int layer, int* ustart, int* rbase, int* cntl, int npn) {
    __syncthreads();
    if (TID() < 64) {
        const int l_ = TID(), e = l_ & 31;
        const int c = l_ < 32 ? p.cnt[layer * 32 + e] : 0;
        const int tiles = ((c + 255) >> 8) * npn;
        int us = tiles, rb = c;
#pragma unroll
        for (int o = 1; o < 32; o <<= 1) { const int a = __shfl_up(us, o), b = __shfl_up(rb, o); if ((l_ & 31) >= o) { us += a; rb += b; } }
        if (l_ < 32) { ustart[e] = us - tiles; rbase[e] = rb - c; cntl[e] = c; if (e == 31) { ustart[32] = us; rbase[32] = rb; } }
    }
    __syncthreads();
}
constexpr int MAP_OFF = 131072;

__device__ __forceinline__ void phase_moe_gather(const Params& p, int layer) {
    int* ustart = (int*)(LDS_BASE() + MAP_OFF); int* rbase = ustart + 33; int* cntl = rbase + 33;
    moe_map(p, layer, ustart, rbase, cntl, 4);
    const int lane = TID() & 63, gw = blockIdx.x * NW + (TID() >> 6), nw = gridDim.x * NW, total = rbase[32];
    for (int s = gw; s < total; s += nw) {
        int e = 0; while (rbase[e + 1] <= s) ++e;
        const int pos = s - rbase[e]; const long tok = p.list[(long)e * LIST_CAP + pos];
        const u32x4 v0 = *(const u32x4*)(p.hb + tok * DM + lane * 8), v1 = *(const u32x4*)(p.hb + tok * DM + 512 + lane * 8);
        *(u32x4*)(p.Xg + (long)s * DM + lane * 8) = v0; *(u32x4*)(p.Xg + (long)s * DM + 512 + lane * 8) = v1;
        if (lane == 0) p.slot_gate[s] = p.list_gate[(long)e * LIST_CAP + pos];
    }
}

__device__ __forceinline__ void phase_moe1(const Params& p, int layer) {
    int* ustart = (int*)(LDS_BASE() + MAP_OFF); int* rbase = ustart + 33; int* cntl = rbase + 33;
    moe_map(p, layer, ustart, rbase, cntl, 4);
    pg8::MoeOrder S{ustart, rbase, cntl, (int)gridDim.x, (int)blockIdx.x, 4, 1024};
    pg8::gemm_phase<pg8::EpiMoe1, pg8::MoeOrder, true>((PG8_LAS unsigned char*)LDS_BASE(), p.hb, p.WguT, 1024, S, pg8::EpiMoe1{p.H}, p.list);
}
__device__ __forceinline__ void phase_moe2(const Params& p, int layer) {
    int* ustart = (int*)(LDS_BASE() + MAP_OFF); int* rbase = ustart + 33; int* cntl = rbase + 33;
    moe_map(p, layer, ustart, rbase, cntl, 4);
    pg8::MoeOrder S{ustart, rbase, cntl, (int)gridDim.x, (int)blockIdx.x, 4, 1024};
    pg8::gemm_phase<pg8::EpiMoe2, pg8::MoeOrder>((PG8_LAS unsigned char*)LDS_BASE(), p.H, p.WdT, EFF, S, pg8::EpiMoe2{p.Y, p.list_gate});
}

__device__ __forceinline__ void phase_ln_ffn(const Params& p, int layer, bool write_hb, bool dry = false) {
    int* ustart = (int*)(LDS_BASE() + MAP_OFF); int* rbase = ustart + 33; int* cntl = rbase + 33;
    moe_map(p, layer, ustart, rbase, cntl, 4);
    const int lane = TID() & 63, gw = blockIdx.x * NW + (TID() >> 6), nw = gridDim.x * NW;
    const float* gam = p.lnfg + layer * DM; const float* bet = p.lnfb + layer * DM;
    for (int tok = gw; tok < NT; tok += nw) {
        const long s0 = rbase[p.tok_e[(long)tok * 2]] + p.tok_pos[(long)tok * 2], s1 = rbase[p.tok_e[(long)tok * 2 + 1]] + p.tok_pos[(long)tok * 2 + 1];
        float h[16]; float s = 0.f;
#pragma unroll
        for (int i = 0; i < 4; ++i) {
            const int k = 4 * lane + 256 * i;
            const u32x2 xx = *(const u32x2*)(p.hb + (long)tok * DM + k);
            const f32x4 xv = (f32x4){bf2f((bf16_t)(xx[0] & 0xffff)), bf2f((bf16_t)(xx[0] >> 16)), bf2f((bf16_t)(xx[1] & 0xffff)), bf2f((bf16_t)(xx[1] >> 16))};
            const u32x2 ya = *(const u32x2*)(p.Y + s0 * DM + k), yb = *(const u32x2*)(p.Y + s1 * DM + k);
            h[4 * i + 0] = ALPHA * xv[0] + (bf2f((bf16_t)(ya[0] & 0xffff)) + bf2f((bf16_t)(yb[0] & 0xffff)));
            h[4 * i + 1] = ALPHA * xv[1] + (bf2f((bf16_t)(ya[0] >> 16)) + bf2f((bf16_t)(yb[0] >> 16)));
            h[4 * i + 2] = ALPHA * xv[2] + (bf2f((bf16_t)(ya[1] & 0xffff)) + bf2f((bf16_t)(yb[1] & 0xffff)));
            h[4 * i + 3] = ALPHA * xv[3] + (bf2f((bf16_t)(ya[1] >> 16)) + bf2f((bf16_t)(yb[1] >> 16)));
            s += (h[4 * i] + h[4 * i + 1]) + (h[4 * i + 2] + h[4 * i + 3]);
        }
        const float mean = wave_sum(s) * (1.0f / DM);
        float q = 0.f;
#pragma unroll
        for (int e = 0; e < 16; ++e) { const float d = h[e] - mean; q += d * d; }
        const float rstd = rsqrtf(wave_sum(q) * (1.0f / DM) + LN_EPS);
#pragma unroll
        for (int i = 0; i < 4; ++i) {
            const int k = 4 * lane + 256 * i;
            const f32x4 gv = *(const f32x4*)(gam + k), bv = *(const f32x4*)(bet + k);
#pragma unroll
            for (int e = 0; e < 4; ++e) h[4 * i + e] = (h[4 * i + e] - mean) * rstd * gv[e] + bv[e];
            if (dry) *(u32x2*)(p.H + (long)tok * DM + k) = (u32x2){pack2(h[4 * i], h[4 * i + 1]), pack2(h[4 * i + 2], h[4 * i + 3])};
            else if (write_hb) NT_STORE((u32x2*)(p.hb + (long)tok * DM + k), ((u32x2){pack2(h[4 * i], h[4 * i + 1]), pack2(h[4 * i + 2], h[4 * i + 3])}));
            else NT_STORE((f32x4*)(p.out + (long)tok * DM + k), ((f32x4){h[4 * i], h[4 * i + 1], h[4 * i + 2], h[4 * i + 3]}));
        }
    }
}


typedef float f32x16 __attribute__((ext_vector_type(16)));
typedef short s16x4 __attribute__((ext_vector_type(4)));
__device__ __forceinline__ s16x4 lds_tr_read(const bf16_t* p) {
#ifdef EMU
    return emu_ds_read_tr16_b64(p);
#else
    typedef short v4i16_t __attribute__((ext_vector_type(4)));
    return __builtin_bit_cast(s16x4, __builtin_amdgcn_ds_read_tr16_b64_v4i16((__attribute__((address_space(3))) v4i16_t*)p));
#endif
}
constexpr int KLD = 72;
struct AttnUnit { int c, d, r, grp, tpr, Ld, h, b; };
__device__ __forceinline__ AttnUnit attn_decode(int u, int g0, int g1, int g2) {
    constexpr int TPB = NS_ / 32;
    const int gper = g0 + g1 + g2; int gi = u % gper; const int bh = u / gper;
    AttnUnit a; a.h = bh & 15; a.b = bh >> 4;
    if (gi < g0) { a.c = 0; a.d = 1; } else if (gi < g0 + g1) { a.c = 1; a.d = 4; gi -= g0; } else { a.c = 2; a.d = 16; gi -= g0 + g1; }
    a.tpr = TPB / a.d; const int gpr = (a.tpr + 7) / 8; a.r = gi / gpr; a.grp = gi % gpr; a.Ld = NS_ / a.d;
    return a;
}
__device__ __forceinline__ void attn_loads(const Params& p, const AttnUnit& a, int t, int w, int q, int hh, u32x4 (&kr)[6], u32x4 (&vr)[6], bf16x8 (&qf)[4]) {
    const long tb = (long)a.b * NS_; const int M0 = 256 * a.grp;
#pragma unroll
    for (int i = 0; i < 6; ++i) {
        const int id = t + 512 * i, row = id >> 3, ch = (id & 7) * 8;
        int mk = M0 - 128 + row; mk = mk < 0 ? 0 : (mk >= a.Ld ? a.Ld - 1 : mk);
        const bf16_t* src = p.qkv + (tb + (long)mk * a.d + a.r) * 3072 + 1024 + a.h * 64 + ch;
        kr[i] = *(const u32x4*)src; vr[i] = *(const u32x4*)(src + 1024);
    }
    const int mt = 8 * a.grp + w, mtc = mt < a.tpr ? mt : a.tpr - 1;
    const long tokq = tb + (long)(32 * mtc + q) * a.d + a.r;
#pragma unroll
    for (int s = 0; s < 4; ++s) qf[s] = *(const bf16x8*)(p.qkv + tokq * 3072 + a.h * 64 + 16 * s + 8 * hh);
}
__device__ __forceinline__ void phase_attn(const Params& p) {
    constexpr int TPB = NS_ / 32;
    const int t = TID(), lane = t & 63, w = t >> 6, q = lane & 31, hh = lane >> 5;
    bf16_t* Ks = (bf16_t*)LDS_BASE(); bf16_t* Vs = Ks + 384 * KLD;
    const int g0 = (TPB + 7) / 8, g1 = 4 * ((TPB / 4 + 7) / 8), g2 = 16 * ((TPB / 16 + 7) / 8), gper = g0 + g1 + g2;
    const int nunits = NB_ * 16 * gper;
    const float C = 0.125f * 1.4426950408889634f;
    u32x4 kr[6], vr[6]; bf16x8 qn[4];
    const int G = (int)gridDim.x, nbh = NB_ * 16;
#ifndef ATTN_XCD
#define ATTN_XCD 1
#endif
    const bool xcdmap = ATTN_XCD && (G % 8 == 0) && (nbh % 8 == 0);
    const int xcd = (int)blockIdx.x & 7, lb = (int)blockIdx.x >> 3, nlb = G >> 3, nloc = (nbh / 8) * gper;
    const int nit = xcdmap ? (nloc + nlb - 1) / nlb : (nunits + G - 1) / G;
#define ATTN_UNIT_OF(it_) (xcdmap ? (((it_) * nlb + lb) < nloc ? ((((it_) * nlb + lb) / gper) * 8 + xcd) * gper + (((it_) * nlb + lb) % gper) : -1) \
                                  : (((it_) * G + (int)blockIdx.x) < nunits ? ((it_) * G + (int)blockIdx.x) : -1))
    { const int u0 = ATTN_UNIT_OF(0); if (u0 >= 0) { const AttnUnit a0 = attn_decode(u0, g0, g1, g2); attn_loads(p, a0, t, w, q, hh, kr, vr, qn); } }
    for (int it = 0; it < nit; ++it) {
        const int u = ATTN_UNIT_OF(it); if (u < 0) break;
        const AttnUnit a = attn_decode(u, g0, g1, g2);
        const int c = a.c, d = a.d, r = a.r, h = a.h, tpr = a.tpr;
        const int mt = 8 * a.grp + w;
        const long tb = (long)a.b * NS_;
        LDS_BARRIER();
#pragma unroll
        for (int i = 0; i < 6; ++i) {
            const int id = t + 512 * i, row = id >> 3, ch = (id & 7) * 8;
            *(u32x4*)(Ks + row * KLD + ch) = kr[i]; *(u32x4*)(Vs + row * KLD + ch) = vr[i];
        }
        bf16x8 qf[4];
#pragma unroll
        for (int s = 0; s < 4; ++s) qf[s] = qn[s];
        const bool active = mt < tpr;
        const int mtc = active ? mt : tpr - 1;
        const long tokq = tb + (long)(32 * mtc + q) * d + r;
        LDS_BARRIER();
        { const int un = (it + 1 < nit) ? ATTN_UNIT_OF(it + 1) : -1; if (un >= 0) { const AttnUnit an = attn_decode(un, g0, g1, g2); attn_loads(p, an, t, w, q, hh, kr, vr, qn); } }
        if (active) {
            f32x16 sc[5];
#pragma unroll
            for (int j = 0; j < 5; ++j) {
                const int mk0 = 32 * mt - 128 + 32 * j;
                if (mk0 >= 0) {
                    const bf16_t* kp = Ks + (32 * (w + j) + q) * KLD + 8 * hh;
                    f32x16 acc;
#pragma unroll
                    for (int i = 0; i < 16; ++i) acc[i] = 0.f;
#pragma unroll
                    for (int s = 0; s < 4; ++s) acc = __builtin_amdgcn_mfma_f32_32x32x16_bf16(*(const bf16x8*)(kp + 16 * s), qf[s], acc, 0, 0, 0);
                    sc[j] = acc;
                } else {
#pragma unroll
                    for (int i = 0; i < 16; ++i) sc[j][i] = -1.0e30f;
                }
            }
            float mx = -1.0e30f;
#pragma unroll
            for (int j = 0; j < 5; ++j)
#pragma unroll
                for (int i = 0; i < 16; ++i) {
                    const int kk = (i & 3) + 8 * (i >> 2) + 4 * hh;
                    if (j == 0) { if (kk < q) sc[j][i] = -1.0e30f; }
                    if (j == 4) { if (kk > q) sc[j][i] = -1.0e30f; }
                    mx = fmaxf(mx, sc[j][i]);
                }
            mx = fmaxf(mx, __shfl_xor(mx, 32));
            const float nmx = -mx * C;
            mx = mx * C;
            float l = 0.f;
#pragma unroll
            for (int j = 0; j < 5; ++j)
#pragma unroll
                for (int i = 0; i < 16; ++i) { const float e = __builtin_amdgcn_exp2f(fmaf(sc[j][i], C, nmx)); sc[j][i] = e; l += e; }
            l += __shfl_xor(l, 32);
            f32x16 o[2];
#pragma unroll
            for (int i = 0; i < 16; ++i) { o[0][i] = 0.f; o[1][i] = 0.f; }
#pragma unroll
            for (int j = 0; j < 5; ++j) {
                const int mk0 = 32 * mt - 128 + 32 * j;
                if (mk0 >= 0) {
#pragma unroll
                    for (int s = 0; s < 2; ++s) {
                        const unsigned w0 = pack2(sc[j][8 * s + 0], sc[j][8 * s + 1]), w1 = pack2(sc[j][8 * s + 2], sc[j][8 * s + 3]);
                        const unsigned w2 = pack2(sc[j][8 * s + 4], sc[j][8 * s + 5]), w3 = pack2(sc[j][8 * s + 6], sc[j][8 * s + 7]);
                        const bf16x8 pa = __builtin_bit_cast(bf16x8, (u32x4){w0, w1, w2, w3});
#pragma unroll
                        for (int db = 0; db < 2; ++db) {
                            const bf16_t* vp = Vs + (32 * (w + j) + 16 * s + 4 * hh + ((lane & 15) >> 2)) * KLD + 32 * db + 16 * ((lane >> 4) & 1) + 4 * (lane & 3);
                            const s16x4 lo = lds_tr_read(vp), hi = lds_tr_read(vp + 8 * KLD);
                            const bf16x8 vb = (bf16x8){lo[0], lo[1], lo[2], lo[3], hi[0], hi[1], hi[2], hi[3]};
                            o[db] = __builtin_amdgcn_mfma_f32_32x32x16_bf16(vb, pa, o[db], 0, 0, 0);
                        }
                    }
                }
            }
            bf16_t* ob = p.obr[c] + tokq * 1024 + h * 64 + 4 * hh;
#pragma unroll
            for (int db = 0; db < 2; ++db)
#pragma unroll
                for (int cq = 0; cq < 4; ++cq)
                    *(u32x2*)(ob + 32 * db + 8 * cq) = (u32x2){pack2(o[db][4 * cq], o[db][4 * cq + 1]), pack2(o[db][4 * cq + 2], o[db][4 * cq + 3])};
            if (hh == 0) { float* st = p.ost + ((long)c * NT + tokq) * 32 + h * 2; WT_STORE_F2(st, mx, l); }
        }
    }
}

__device__ __forceinline__ void phase_attn_merge(const Params& p) {
    const long gtid = (long)blockIdx.x * NTHREADS + TID(), gsz = (long)gridDim.x * NTHREADS;
    for (long idx = gtid; idx < (long)NT * 16 * 8; idx += gsz) {
        const long th = idx >> 3; const int ch = (int)(idx & 7);
        const long tok = th >> 4; const int h = (int)(th & 15);
        float m[3], l[3];
#pragma unroll
        for (int c = 0; c < 3; ++c) { const float* st = p.ost + ((long)c * NT + tok) * 32 + h * 2; m[c] = st[0]; l[c] = st[1]; }
        const float M = fmaxf(m[0], fmaxf(m[1], m[2]));
        float wgt[3], den = 0.f;
#pragma unroll
        for (int c = 0; c < 3; ++c) { wgt[c] = __builtin_amdgcn_exp2f(m[c] - M); den += wgt[c] * l[c]; }
        const float inv = 1.0f / den;
        float acc[8];
#pragma unroll
        for (int e = 0; e < 8; ++e) acc[e] = 0.f;
#pragma unroll
        for (int c = 0; c < 3; ++c) {
            const u32x4 v = *(const u32x4*)(p.obr[c] + tok * 1024 + h * 64 + ch * 8);
#pragma unroll
            for (int e = 0; e < 4; ++e) { acc[2 * e] += wgt[c] * bf2f((bf16_t)(v[e] & 0xffff)); acc[2 * e + 1] += wgt[c] * bf2f((bf16_t)(v[e] >> 16)); }
        }
        *(u32x4*)(p.attno + tok * 1024 + h * 64 + ch * 8) = (u32x4){pack2(acc[0] * inv, acc[1] * inv), pack2(acc[2] * inv, acc[3] * inv), pack2(acc[4] * inv, acc[5] * inv), pack2(acc[6] * inv, acc[7] * inv)};
    }
}

constexpr int NPHASES = 19;
__device__ __forceinline__ void run_phase(const Params& p, int ph, const XcdBarrier& xb) {
    switch (ph) {
    case 0:
#if defined(P0_VARIANT)
        _Pragma("unroll 1") for (int rep = 0; rep < 2; ++rep) { phase_prologue(p); __syncthreads(); }
#else
        phase_prologue(p);
#endif
        __syncthreads(); phase_ba(p);
        break;
    case 1: gemm_dense(p.hb, p.WinT, NT, 2560, 1024, pg8::EpiStore{p.proj, 2560}); break;
    case 2:
#if !FUSE_PREP
        phase_gdn_prep(p);
#endif
        break;
    case 3:
#if defined(P3_VARIANT) && P3_VARIANT == 1
        _Pragma("unroll 1") for (int rep = 0; rep < 2; ++rep) { phase_gdn_chunk(p); __syncthreads(); }
        phase_s5_pass<1>(p, 0);
#elif defined(P3_VARIANT) && P3_VARIANT == 2
        phase_gdn_chunk(p); __syncthreads();
        _Pragma("unroll 1") for (int rep = 0; rep < 2; ++rep) { phase_s5_pass<1>(p, 0); __syncthreads(); }
#else
        phase_gdn_chunk(p); __syncthreads(); phase_s5_pass<1>(p, 0);
#endif
        break;
    case 4: {
        int nscan = NB_ * 16; if (nscan > (int)gridDim.x / 2) nscan = (int)gridDim.x / 2;
#if defined(P4_VARIANT) && P4_VARIANT == 1
        if ((int)blockIdx.x < nscan) { phase_gdn_scan(p, nscan); LDS_BARRIER(); phase_gdn_scan(p, nscan); } else phase_s5_pass<2>(p, nscan);
#elif defined(P4_VARIANT) && P4_VARIANT == 2
        if ((int)blockIdx.x < nscan) phase_gdn_scan(p, nscan); else { phase_s5_pass<2>(p, nscan); LDS_BARRIER(); phase_s5_pass<2>(p, nscan); }
#else
        if ((int)blockIdx.x < nscan) phase_gdn_scan(p, nscan); else phase_s5_pass<2>(p, nscan);
#endif
        break; }
    case 5: phase_gdn_post(p); __syncthreads(); gemm_dense(p.ygelu, p.WgluT, NT, 512, 512, pg8::EpiGlu{p.ygelu, p.ycat}); break;
    case 6: gemm_dense(p.ycat, p.WoutT, NT, 1024, 1024, pg8::EpiStore{p.mix, 1024}); __syncthreads(); transpose_tiles<3>(p.moejobs[0]);
#if defined(P6_VARIANT)
        __syncthreads(); transpose_tiles<3>(p.moejobs[0]);
#endif
        break;
    case 7:
#if defined(P7_VARIANT)
        phase_ln_router(p, 0, p.x, p.mix, true); __syncthreads();
#endif
        phase_ln_router(p, 0, p.x, p.mix); break;
    case 8: phase_moe1(p, 0); break;
    case 9: phase_moe2(p, 0); break;
    case 10:
#if defined(P11_VARIANT)
        phase_ln_ffn(p, 0, true, true); __syncthreads();
#endif
        phase_ln_ffn(p, 0, true); break;
    case 11: gemm_dense(p.hb, p.WqkvT, NT, 3072, 1024, pg8::EpiStore{p.qkv, 3072}); break;
    case 12: phase_attn(p); break;
    case 13: phase_attn_merge(p); break;
    case 14: gemm_dense(p.attno, p.WoutcT, NT, 1024, 1024, pg8::EpiStore{p.mix1, 1024}); __syncthreads(); transpose_tiles<3>(p.moejobs[1]); break;
    case 15: phase_ln_router(p, 1, nullptr, p.mix1); break;
    case 16: phase_moe1(p, 1); break;
    case 17: phase_moe2(p, 1); break;
    case 18: phase_ln_ffn(p, 1, false); break;
    default: break;
    }
}

#if N_LAUNCH_MODE == 0
template <int PH> __global__ void __launch_bounds__(NTHREADS, 2) k_ph(Params p) { XcdBarrier xb{}; run_phase(p, PH, xb); }
template <int PH> static void launch_from(const Params& p, int grid, hipStream_t stream, int maxph) {
    if constexpr (PH < NPHASES) {
        if (PH <= maxph) {
#ifdef EMU
            emu::launch(dim3(32), dim3(NTHREADS), LDS_BYTES, [=] { k_ph<PH>(p); }, false); fprintf(stderr, "phase %d done\n", PH);
#else
            hipFuncSetAttribute((const void*)k_ph<PH>, hipFuncAttributeMaxDynamicSharedMemorySize, LDS_BYTES);
            hipLaunchKernelGGL(k_ph<PH>, dim3(grid), dim3(NTHREADS), LDS_BYTES, stream, p);
#endif
        }
        launch_from<PH + 1>(p, grid, stream, maxph);
    }
}
#else
template <int PH> __device__ __forceinline__ void mega_from(const Params& p, const XcdBarrier& xb) {
    if constexpr (PH < NPHASES && FUSE_PREP && PH == 2) { mega_from<PH + 1>(p, xb); }
    else if constexpr (PH < NPHASES) {
        run_phase(p, PH, xb);
#ifdef PROBE_MASK
        if constexpr (((PROBE_MASK) >> PH) & 1) { GRID_SYNC(); run_phase(p, PH, xb); }
#endif
        if constexpr (PH == 0) { GRID_SYNC_CG(); }
        else if constexpr (PH + 1 < NPHASES) { GRID_SYNC(); }
        mega_from<PH + 1>(p, xb);
    }
}
__global__ void __launch_bounds__(NTHREADS, 2) k_mega(Params p) {
#ifdef EMU
    XcdBarrier xb{0};
#else
    volatile XB_LAS unsigned* st = (volatile XB_LAS unsigned*)(lds_raw + XB_ST_OFF);
    if (threadIdx.x == 0) { st[0] = 0u; st[1] = 0u; }
    __syncthreads();
    const XcdBarrier xb = xcd_barrier_post(p.bar, st);
#endif
    mega_from<0>(p, xb);
}
#endif

#ifdef EMU
Params g_emu_params;
#endif

static inline size_t al256(size_t x) { return (x + 255) & ~(size_t)255; }

extern "C" void kernel_launch(void* const* d_in, const int* in_sizes, int n_in, void* d_out, int out_size, void* d_ws, size_t ws_size, hipStream_t stream) {
    Params p; memset(&p, 0, sizeof(p));
    const float* const* in = (const float* const*)d_in;
    p.x = in[0]; p.w_in = in[1]; p.conv = in[2]; p.a_log = in[3]; p.dt_bias = in[4]; p.gnorm = in[5]; p.lam_re = in[6]; p.lam_im = in[7]; p.log_dt = in[8];
    p.b_re = in[9]; p.b_im = in[10]; p.c_re = in[11]; p.c_im = in[12]; p.s5d = in[13]; p.wglu = in[14]; p.wout = in[15]; p.wqkv = in[16]; p.woutc = in[17];
    p.lnmg = in[18]; p.lnmb = in[19]; p.rgw = in[20]; p.rgb = in[21]; p.rew = in[22]; p.reb = in[23]; p.mg = in[24]; p.mu = in[25]; p.md = in[26]; p.lnfg = in[27]; p.lnfb = in[28];
    p.out = (float*)d_out;
    char* ws = (char*)d_ws; size_t off = 0;
    auto take = [&](size_t bytes) { char* r = ws + off; off += al256(bytes); return r; };
    p.WinT = (bf16_t*)take((size_t)2560 * 1024 * 2); p.WoutT = (bf16_t*)take((size_t)1024 * 1024 * 2); p.WgluT = (bf16_t*)take((size_t)512 * 512 * 2);
    p.WqkvT = (bf16_t*)take((size_t)3072 * 1024 * 2); p.WoutcT = (bf16_t*)take((size_t)1024 * 1024 * 2);
    p.WrT = (float*)take((size_t)2 * 36 * 1024 * 4);
    p.s5a = (float*)take(2048 * 2 * 4); p.s5a64 = (float*)take(2048 * 2 * 4); p.s5bbr = (float*)take(2048 * 16 * 4); p.s5bbi = (float*)take(2048 * 16 * 4); p.s5cm = (bf16_t*)take(32 * 16 * 128 * 2); p.s5bbm = (bf16_t*)take(32 * 128 * 16 * 2);
    p.cnt = (int*)take(64 * 4);
    p.bar = (unsigned*)take(4096 * 4);
    p.tok_e = (int*)take((size_t)NT * 2 * 4); p.tok_pos = (int*)take((size_t)NT * 2 * 4); p.tok_gate = (float*)take((size_t)NT * 2 * 4);
    p.list = (int*)take((size_t)32 * LIST_CAP * 4); p.list_gate = (float*)take((size_t)32 * LIST_CAP * 4);
    char* hbreg = take((size_t)NT * 1024 * 2);
    p.hb = (bf16_t*)hbreg;
    p.go = (bf16_t*)hbreg;
    p.s5loc = (float*)(hbreg + (size_t)NT * 512 * 2); p.s5in = p.s5loc + (size_t)NB_ * NCH * 2048 * 2;
    char* moew = take((size_t)32 * 1024 * 1024 * 2 + (size_t)32 * 1024 * 512 * 2);
    p.WguT = (bf16_t*)moew; p.WdT = (bf16_t*)(moew + (size_t)32 * 1024 * 1024 * 2);
    p.gq = (bf16_t*)moew; p.gk = p.gq + (size_t)NT * 512; p.gv = p.gk + (size_t)NT * 512;
    p.ygelu = (bf16_t*)moew;
    char* ar = ws + off;
    size_t a = 0;
    auto atake = [&](size_t bytes) { char* r = ar + a; a += al256(bytes); return r; };
    p.proj = (bf16_t*)atake((size_t)NT * PROJ_LD * 2);
    char* chunk0 = ar + a;
    p.cU = (bf16_t*)atake((size_t)NT * 512 * 2); p.cW = (bf16_t*)atake((size_t)NT * 512 * 2); p.cQd = (bf16_t*)atake((size_t)NT * 512 * 2); p.cKdT = (bf16_t*)atake((size_t)NT * 512 * 2);
    p.cQK = (bf16_t*)atake((size_t)NT * 512 * 2); p.cgl = (float*)atake((size_t)NB_ * 4 * NCH * 4);
    p.gbeta = (float*)atake((size_t)NT * 4 * 4); p.gg = (float*)atake((size_t)NT * 4 * 4);
    size_t amax = a;
    p.ycat = (bf16_t*)chunk0;
    p.mix = (bf16_t*)ar;
    p.Xg = (bf16_t*)ar; p.Y = (bf16_t*)ar; p.H = (bf16_t*)(ar + al256((size_t)(2 * NT + 256) * DM * 2)); p.slot_gate = (float*)((char*)p.H + al256((size_t)(2 * NT + 256) * EFF * 2));
    { size_t e = al256((size_t)(2 * NT + 256) * DM * 2) + al256((size_t)(2 * NT + 256) * EFF * 2) + (size_t)2 * NT * 4; if (e > amax) amax = e; }
    p.qkv = (bf16_t*)ar; p.attno = (bf16_t*)ar; p.mix1 = (bf16_t*)(ar + (size_t)NT * 1024 * 2);
    p.obr[0] = (bf16_t*)(ar + al256((size_t)NT * 3072 * 2) + (size_t)NT * 1024 * 2); p.obr[1] = (bf16_t*)moew; p.ost = (float*)(moew + (size_t)NT * 1024 * 2); p.obr[2] = (bf16_t*)(ar + al256((size_t)NT * 3072 * 2));
    { size_t e = al256((size_t)NT * 3072 * 2) + (size_t)2 * NT * 1024 * 2; if (e > amax) amax = e; }
    if (off + amax > ws_size) { fprintf(stderr, "workspace too small: need %zu have %zu\n", off + amax, ws_size); return; }
    auto job = [](const float* src, bf16_t* dst, int K, int N, int ldsrc, int ldd, int rb, int rs, int roff, int batch, long sbs, long dbs) {
        TJob j; memset(&j, 0, sizeof(j)); j.src = src; j.dst = dst; j.K = K; j.N = N; j.ldsrc = ldsrc; j.ldd = ldd; j.rb = rb; j.rs = rs; j.roff = roff; j.batch = batch; j.sbs = sbs; j.dbs = dbs; return j; };
    p.jobs[0] = job(p.w_in, p.WinT, 1024, 2048, 2568, 1024, 2048, 0, 0, 1, 0, 0);
    p.jobs[1] = job(p.w_in + 2056, p.WinT + (size_t)2048 * 1024, 1024, 512, 2568, 1024, 512, 0, 0, 1, 0, 0);
    p.jobs[2] = job(p.wout, p.WoutT, 1024, 1024, 1024, 1024, 1024, 0, 0, 1, 0, 0);
    p.jobs[3] = job(p.wglu, p.WgluT, 512, 512, 512, 512, 512, 0, 0, 1, 0, 0);
    p.jobs[4] = job(p.wqkv, p.WqkvT, 1024, 3072, 3072, 1024, 3072, 0, 0, 1, 0, 0);
    p.jobs[5] = job(p.woutc, p.WoutcT, 1024, 1024, 1024, 1024, 1024, 0, 0, 1, 0, 0);
    p.njobs = 6;
    for (int l = 0; l < 2; ++l) {
        p.moejobs[l][0] = job(p.mg + (size_t)l * 32 * 1024 * 512, p.WguT, 1024, 512, 512, 1024, 128, 256, 0, 32, 1024L * 512, 1024L * 1024);
        p.moejobs[l][1] = job(p.mu + (size_t)l * 32 * 1024 * 512, p.WguT, 1024, 512, 512, 1024, 128, 256, 128, 32, 1024L * 512, 1024L * 1024);
        p.moejobs[l][2] = job(p.md + (size_t)l * 32 * 512 * 1024, p.WdT, 512, 1024, 1024, 512, 1024, 0, 0, 32, 512L * 1024, 1024L * 512);
    }
#ifdef EMU
    g_emu_params = p;
#if N_LAUNCH_MODE == 1
    emu::launch(dim3(16), dim3(NTHREADS), LDS_BYTES, [=] { k_mega(p); }, true);
#else
    { const char* e = getenv("EMU_MAXPHASE"); launch_from<0>(p, 64, stream, e ? atoi(e) : NPHASES - 1); }
#endif
#else
#if N_LAUNCH_MODE == 1
    static int grid_blocks = 0;
    if (!grid_blocks) {
        int dev = 0, cus = 0, per_cu = 0;
        (void)hipGetDevice(&dev); (void)hipDeviceGetAttribute(&cus, hipDeviceAttributeMultiprocessorCount, dev);
        (void)hipFuncSetAttribute((const void*)k_mega, hipFuncAttributeMaxDynamicSharedMemorySize, LDS_BYTES);
        (void)hipOccupancyMaxActiveBlocksPerMultiprocessor(&per_cu, k_mega, NTHREADS, LDS_BYTES);
        per_cu = 1;
        grid_blocks = cus * per_cu;
    }
    (void)hipMemsetAsync(p.bar, 0, 4096 * 4, stream);
    void* args[] = {(void*)&p};
    hipError_t e = hipLaunchCooperativeKernel((void*)k_mega, dim3(grid_blocks), dim3(NTHREADS), args, LDS_BYTES, stream);
    if (e != hipSuccess) fprintf(stderr, "cooperative launch failed: %s (grid %d)\n", hipGetErrorString(e), grid_blocks);
#else
    launch_from<0>(p, 256, stream, NPHASES - 1);
#endif
#endif
}
```

```cpp
#ifndef EMU
#include <hip/hip_runtime.h>
#include <hip/hip_cooperative_groups.h>
#endif
#include <cstdint>
#include <cstdio>
#include <cmath>
#include <cstring>
#include <cstdlib>

#ifndef CFG_BATCH
#define CFG_BATCH 8
#endif
#ifndef CFG_SEQ
#define CFG_SEQ 4096
#endif
#ifndef N_LAUNCH_MODE
#define N_LAUNCH_MODE 1
#endif

typedef unsigned short bf16_t;
typedef short bf16x8 __attribute__((ext_vector_type(8)));
typedef float f32x4 __attribute__((ext_vector_type(4)));
typedef unsigned u32x4 __attribute__((ext_vector_type(4)));
typedef unsigned u32x2 __attribute__((ext_vector_type(2)));

constexpr int NB_ = CFG_BATCH, NS_ = CFG_SEQ, NT = NB_ * NS_, DM = 1024;
constexpr int NCH = NS_ / 64;
constexpr int PROJ_LD = 2560;
constexpr int NEXP = 32, EFF = 512;
constexpr int LIST_CAP = NT * 2;
constexpr float ALPHA = 1.41421356237f;
constexpr float LN_EPS = 1e-5f;
constexpr int NTHREADS = 512, NW = 8;
constexpr int LDS_BYTES = 160 * 1024;

#ifdef EMU
#define LDS_BASE() (emu::cur->blk->smem)
#define GRID_SYNC_CG() emu::grid_sync()
#define GRID_SYNC() emu::grid_sync()
struct XcdBarrier { int dummy; };
#else
extern __shared__ __attribute__((aligned(16))) char lds_raw[];
#define LDS_BASE() (lds_raw)
#define GRID_SYNC_CG() cooperative_groups::this_grid().sync()
#define GRID_SYNC() xcd_barrier(xb)
#define XB_TMO      128
#define XB_XCNT(j)  (256  + 64 * (j))
#define XB_XSUB(j)  (1280 + 64 * (j))
#define XB_XGEN(j)  (2304 + 64 * (j))
#define XB_TOP      3328
#define XB_TOPGEN   3392
#define XCD_BAR_WORDS 3456
#define XB_SPIN_CAP (1u << 18)
#define XB_LAS __attribute__((address_space(3)))
#define XB_ACQUIRE() __builtin_amdgcn_fence(__ATOMIC_ACQUIRE, "agent")
__device__ __forceinline__ unsigned xb_ld(unsigned* p)              { return __hip_atomic_load(p, __ATOMIC_RELAXED, __HIP_MEMORY_SCOPE_AGENT); }
__device__ __forceinline__ unsigned xb_add(unsigned* p, unsigned v) { return __hip_atomic_fetch_add(p, v, __ATOMIC_RELAXED, __HIP_MEMORY_SCOPE_AGENT); }
__device__ __forceinline__ unsigned xb_xcc_id() { return (unsigned)__builtin_amdgcn_s_getreg((3 << 11) | 20) & 0xFu; }
#define XB_SPIN(cond, bar) do { unsigned _sp = 0; while (cond) { __builtin_amdgcn_s_sleep(1); \
    if ((++_sp & 255u) == 0u) { if (xb_ld(&(bar)[XB_TMO])) break; if (_sp > XB_SPIN_CAP) { atomicAdd(&(bar)[XB_TMO], 1u); break; } } } } while (0)
struct XcdBarrier { unsigned* bar; unsigned x; volatile XB_LAS unsigned* st; };
__device__ __forceinline__ XcdBarrier xcd_barrier_post(unsigned* bar, volatile XB_LAS unsigned* st) {
    XcdBarrier b; b.bar = bar; b.x = xb_xcc_id(); b.st = st;
    if (threadIdx.x == 0) (void)xb_add(&bar[XB_XCNT(b.x)], 1u);
    return b;
}
__device__ __forceinline__ void xcd_barrier_complete(unsigned* bar, unsigned x, unsigned& nloc, unsigned& nx) {
    const unsigned G = gridDim.x * gridDim.y * gridDim.z;
    unsigned sum, cnt, mine, sp = 0u;
    for (;;) {
        sum = 0u; cnt = 0u; mine = 0u;
#pragma unroll
        for (unsigned j = 0; j < 16; ++j) { const unsigned c = xb_ld(&bar[XB_XCNT(j)]); sum += c; cnt += (c > 0u) ? 1u : 0u; mine = (j == x) ? c : mine; }
        if (sum == G) break;
        __builtin_amdgcn_s_sleep(1);
        if ((++sp & 255u) == 0u) { if (xb_ld(&bar[XB_TMO])) break; if (sp > XB_SPIN_CAP) { atomicAdd(&bar[XB_TMO], 1u); break; } }
    }
    nloc = mine > 0u ? mine : 1u; nx = cnt > 0u ? cnt : 1u;
}
__device__ __forceinline__ void xcd_barrier(const XcdBarrier& b) {
    asm volatile("s_waitcnt vmcnt(0)" ::: "memory");
    __syncthreads();
    if (threadIdx.x == 0) {
        unsigned* bar = b.bar;
        __builtin_amdgcn_s_waitcnt(0);
        unsigned nloc = b.st[0], nx = b.st[1];
        if (nloc == 0u) { xcd_barrier_complete(bar, b.x, nloc, nx); b.st[0] = nloc; b.st[1] = nx; }
        const unsigned old = xb_add(&bar[XB_XSUB(b.x)], 1u);
        const unsigned gen = old / nloc;
        if (old + 1u == (gen + 1u) * nloc) {
            __builtin_amdgcn_fence(__ATOMIC_RELEASE, "agent");
            asm volatile("s_waitcnt vmcnt(0)" ::: "memory");
            const unsigned og = xb_add(&bar[XB_TOP], 1u);
            const unsigned tg = og / nx;
            if (og + 1u == (tg + 1u) * nx) xb_add(&bar[XB_TOPGEN], 1u);
            else XB_SPIN(xb_ld(&bar[XB_TOPGEN]) == tg, bar);
            XB_ACQUIRE();
            xb_add(&bar[XB_XGEN(b.x)], 1u);
            asm volatile("s_waitcnt vmcnt(0)" ::: "memory");
        } else {
            XB_SPIN(xb_ld(&bar[XB_XGEN(b.x)]) == gen, bar);
            XB_ACQUIRE();
            asm volatile("s_waitcnt vmcnt(0)" ::: "memory");
        }
    }
    __syncthreads();
}
#endif
#ifdef EMU
#define NT_STORE(ptr, val) (*(ptr) = (val))
#define NT_LOAD(ptr) (*(ptr))
#else
#define NT_STORE(ptr, val) __builtin_nontemporal_store((val), (ptr))
#define NT_LOAD(ptr) __builtin_nontemporal_load(ptr)
#endif
#ifndef WT_PLAIN
#define WT_PLAIN 0
#endif
#ifdef EMU
#define WT_STORE_I(ptr, val) (*(ptr) = (val))
#define WT_STORE_F(ptr, val) (*(ptr) = (val))
#define WT_STORE_F2(ptr, a, b) ((ptr)[0] = (a), (ptr)[1] = (b))
#else
#if WT_PLAIN
#define WT_STORE_F2(ptr, a, b) ((ptr)[0] = (a), (ptr)[1] = (b))
#define WT_STORE_I(ptr, val) (*(ptr) = (val))
#define WT_STORE_F(ptr, val) (*(ptr) = (val))
#else
#define WT_STORE_F2(ptr, a, b) __hip_atomic_store((unsigned long long*)(ptr), ((unsigned long long)__float_as_uint(b) << 32) | (unsigned long long)__float_as_uint(a), __ATOMIC_RELAXED, __HIP_MEMORY_SCOPE_AGENT)
#define WT_STORE_I(ptr, val) __hip_atomic_store((ptr), (val), __ATOMIC_RELAXED, __HIP_MEMORY_SCOPE_AGENT)
#define WT_STORE_F(ptr, val) __hip_atomic_store((ptr), (val), __ATOMIC_RELAXED, __HIP_MEMORY_SCOPE_AGENT)
#endif
#endif
#ifdef EMU
#define LDS_BARRIER() emu::syncthreads()
#else
#define LDS_BARRIER() asm volatile("s_waitcnt lgkmcnt(0)\n\ts_barrier" ::: "memory")
#endif
constexpr int XB_ST_OFF = 160 * 1024 - 16;

__device__ __forceinline__ int TID() {
#ifdef EMU
    return (int)emu::cur->tid.x;
#else
    int t = (int)threadIdx.x; asm volatile("" : "+v"(t)); return t;
#endif
}
__device__ __forceinline__ float bf2f(bf16_t v) { return __builtin_bit_cast(float, (unsigned)v << 16); }
__device__ __forceinline__ bf16_t f2bf(float f) { unsigned u = __builtin_bit_cast(unsigned, f); u += 0x7fffu + ((u >> 16) & 1u); return (bf16_t)(u >> 16); }
#ifdef EMU
__device__ __forceinline__ unsigned pack2(float a, float b) { return (unsigned)f2bf(a) | ((unsigned)f2bf(b) << 16); }
#else
typedef float f32x2_t_ __attribute__((ext_vector_type(2))); typedef __bf16 bf16x2_t_ __attribute__((ext_vector_type(2)));
__device__ __forceinline__ unsigned pack2(float a, float b) { f32x2_t_ v = {a, b}; bf16x2_t_ r = __builtin_convertvector(v, bf16x2_t_); return __builtin_bit_cast(unsigned, r); }
#endif
__device__ __forceinline__ float sigmoidf_(float x) { return 1.0f / (1.0f + __expf(-x)); }
__device__ __forceinline__ float siluf_(float x) { return x / (1.0f + __expf(-x)); }
__device__ __forceinline__ float wave_sum(float v) {
#pragma unroll
    for (int o = 32; o > 0; o >>= 1) v += __shfl_xor(v, o);
    return v;
}

struct TJob { const float* src; bf16_t* dst; int K, N, ldsrc, ldd, rb, rs, roff, batch; long sbs, dbs; };

struct Params {
    const float *x, *w_in, *conv, *a_log, *dt_bias, *gnorm, *lam_re, *lam_im, *log_dt, *b_re, *b_im, *c_re, *c_im, *s5d, *wglu, *wout,
        *wqkv, *woutc, *lnmg, *lnmb, *rgw, *rgb, *rew, *reb, *mg, *mu, *md, *lnfg, *lnfb;
    float* out;
    bf16_t *WinT, *WoutT, *WgluT, *WqkvT, *WoutcT;
    float* WrT;
    float *s5a, *s5a64, *s5bbr, *s5bbi;
    bf16_t* s5cm;
    bf16_t* s5bbm;
    bf16_t* hb;
    bf16_t *WguT, *WdT;
    int* cnt;
    int *tok_e, *tok_pos; float* tok_gate;
    int* list; float* list_gate;
    bf16_t* proj;
    float *gbeta, *gg;
    bf16_t *gq, *gk, *gv;
    bf16_t *cU, *cW, *cQd, *cKdT;
    bf16_t* cQK;
    float* cgl;
    bf16_t* go;
    float *s5loc, *s5in;
    bf16_t* ygelu;
    bf16_t* ycat;
    bf16_t* mix;
    bf16_t* H;
    bf16_t* Y;
    bf16_t* qkv;
    bf16_t* attno;
    bf16_t* obr[3];
    float* ost;
    bf16_t* mix1;
    bf16_t* Xg;
    float* slot_gate;
    unsigned* bar;
    TJob jobs[8]; int njobs; int pad0;
    TJob moejobs[2][3];
};

struct TTile { const float* src; bf16_t* dst; int ldsrc, ldd, rb, rs, roff, k0, n0; };
template <int NJ>
__device__ __forceinline__ TTile tt_decode(const TJob* jobs, int g) {
    TJob J = jobs[0]; int rem = g; bool found = false;
#pragma unroll
    for (int j = 0; j < NJ; ++j) { const int nt = jobs[j].batch * (jobs[j].K / 64) * (jobs[j].N / 64); if (!found) { if (rem < nt) { J = jobs[j]; found = true; } else rem -= nt; } }
    const int tk = J.K / 64, tn = J.N / 64;
    const int b = rem / (tk * tn), r2 = rem % (tk * tn);
    TTile T; T.k0 = (r2 / tn) * 64; T.n0 = (r2 % tn) * 64; T.src = J.src + (long)b * J.sbs; T.dst = J.dst + (long)b * J.dbs;
    T.ldsrc = J.ldsrc; T.ldd = J.ldd; T.rb = J.rb; T.rs = J.rs; T.roff = J.roff; return T;
}
__device__ __forceinline__ void tt_load(const TTile& T, int t, f32x4 (&r)[4]) {
#pragma unroll
    for (int i = 0; i < 4; ++i) r[i] = __builtin_nontemporal_load((const f32x4*)(T.src + (long)(T.k0 + (t >> 4) + 16 * i) * T.ldsrc + T.n0 + (t & 15) * 4));
}
__device__ __forceinline__ void tt_emit(const TTile& T, int t, float* ts, const f32x4 (&r)[4], bool active) {
    LDS_BARRIER();
    if (active) {
#pragma unroll
        for (int i = 0; i < 4; ++i) { const int k = (t >> 4) + 16 * i, n4 = (t & 15) * 4; ts[k * 65 + n4 + 0] = r[i][0]; ts[k * 65 + n4 + 1] = r[i][1]; ts[k * 65 + n4 + 2] = r[i][2]; ts[k * 65 + n4 + 3] = r[i][3]; }
    }
    LDS_BARRIER();
    if (active) {
        const int n = t >> 2, kq = (t & 3) * 16;
        unsigned w[8];
#pragma unroll
        for (int i = 0; i < 8; ++i) w[i] = pack2(ts[(kq + 2 * i) * 65 + n], ts[(kq + 2 * i + 1) * 65 + n]);
        const int nn = T.n0 + n, row = (nn / T.rb) * T.rs + T.roff + nn % T.rb;
        u32x4* o = (u32x4*)(T.dst + (long)row * T.ldd + T.k0 + kq);
        o[0] = (u32x4){w[0], w[1], w[2], w[3]}; o[1] = (u32x4){w[4], w[5], w[6], w[7]};
    }
}
template <int NJ>
__device__ __forceinline__ void transpose_tiles(const TJob* jobs) {
    const int t = TID() & 255, half = TID() >> 8;
    float* ts = (float*)LDS_BASE() + half * (64 * 65 + 16);
    int total = 0;
#pragma unroll
    for (int j = 0; j < NJ; ++j) total += jobs[j].batch * (jobs[j].K / 64) * (jobs[j].N / 64);
    const int G = (int)gridDim.x;
    f32x4 ra[4], rb[4];
    int gp = (int)blockIdx.x;
    if (gp * 2 + half < total) { const TTile T0 = tt_decode<NJ>(jobs, gp * 2 + half); tt_load(T0, t, ra); }
#pragma unroll 1
    for (; gp * 2 < total; gp += 2 * G) {
        {
            const int g = gp * 2 + half, gn = (gp + G) * 2 + half; const bool active = g < total;
            if (gn < total) { const TTile Tn = tt_decode<NJ>(jobs, gn); tt_load(Tn, t, rb); }
            const TTile T = tt_decode<NJ>(jobs, active ? g : 0);
            tt_emit(T, t, ts, ra, active);
        }
        if ((gp + G) * 2 < total) {
            const int g = (gp + G) * 2 + half, gn = (gp + 2 * G) * 2 + half; const bool active = g < total;
            if (gn < total) { const TTile Tn = tt_decode<NJ>(jobs, gn); tt_load(Tn, t, ra); }
            const TTile T = tt_decode<NJ>(jobs, active ? g : 0);
            tt_emit(T, t, ts, rb, active);
        }
    }
}

__device__ __forceinline__ void phase_prologue(const Params& p) {
    transpose_tiles<6>(p.jobs);
    const long gtid = (long)blockIdx.x * NTHREADS + TID(), gsz = (long)gridDim.x * NTHREADS;
    for (long i = gtid; i < 2L * 36 * 1024; i += gsz) {
        const int l = (int)(i / (36 * 1024)), n = (int)((i / 1024) % 36), k = (int)(i % 1024);
        p.WrT[i] = n < 4 ? p.rgw[((long)l * 1024 + k) * 4 + n] : p.rew[((long)l * 1024 + k) * 32 + (n - 4)];
    }
    for (long idx = gtid; idx < 32 * 64 * 16; idx += gsz) {
        const long i = idx >> 4; const int h = (int)(idx & 15);
        const int g = (int)(i / 64);
        const float dt = expf(p.log_dt[g]);
        const float lr = p.lam_re[i], li = p.lam_im[i];
        const float mag = expf(lr * dt), ar = mag * cosf(li * dt), ai = mag * sinf(li * dt);
        if (h == 0) {
            const float mag64 = expf(64.0f * lr * dt), ph64 = 64.0f * li * dt;
            p.s5a[i * 2] = ar; p.s5a[i * 2 + 1] = ai;
            p.s5a64[i * 2] = mag64 * cosf(ph64); p.s5a64[i * 2 + 1] = mag64 * sinf(ph64);
        }
        const float den = lr * lr + li * li, nr = ar - 1.0f, ni = ai;
        const float cr = (nr * lr + ni * li) / den, ci = (ni * lr - nr * li) / den;
        const float br = p.b_re[i * 16 + h], bi = p.b_im[i * 16 + h];
        p.s5bbr[i * 16 + h] = cr * br - ci * bi; p.s5bbi[i * 16 + h] = cr * bi + ci * br;
        const int pp = (int)(i % 64);
        p.s5bbm[((long)g * 128 + pp) * 16 + h] = f2bf(cr * br - ci * bi); p.s5bbm[((long)g * 128 + 64 + pp) * 16 + h] = f2bf(cr * bi + ci * br);
    }
    for (long i = gtid; i < 32 * 16 * 128; i += gsz) {
        const int p2 = (int)(i % 128); const long gk = i / 128;
        p.s5cm[i] = f2bf(p2 < 64 ? p.c_re[gk * 64 + p2] : -p.c_im[gk * 64 + (p2 - 64)]);
    }
    for (long i = gtid; i < 64; i += gsz) p.cnt[i] = 0;
}

#ifndef MOE_XCD
#define MOE_XCD 1
#endif
namespace pg8 {
#ifdef EMU
#define PG8_LAS
#define PG8_WAIT_V(n) do { } while (0)
#define PG8_WAIT_L(n) do { } while (0)
#else
#define PG8_LAS __attribute__((address_space(3)))
#define PG8_WAIT_V(n) asm volatile("s_waitcnt vmcnt(" #n ")" ::: "memory")
#define PG8_WAIT_L(n) asm volatile("s_waitcnt lgkmcnt(" #n ")" ::: "memory")
#endif
constexpr int BM = 256, BK = 64, HALF = 128, HTB = HALF * BK * 2  , STAGE_BYTES = 8 * HTB, NXCD = 8, WGM = 8;
__host__ __device__ __forceinline__ int lds_byte(int r, int c) { const int st = (r >> 4) * 2 + (c >> 5), rr = r & 15, cc = c & 31, ob = rr * 64 + cc * 2; return st * 1024 + (ob ^ (((ob >> 9) & 1) << 5)); }
__host__ __device__ __forceinline__ void stage_rc(int b, int& R, int& C) { const int st = b / 1024, sb = b % 1024, swz = sb ^ (((sb >> 9) & 1) << 5); R = (st >> 1) * 16 + swz / 64; C = (st & 1) * 32 + (swz % 64) / 2; }
__host__ __device__ __forceinline__ int perm32(int rho) { const int n = rho >> 4, i = rho & 15; return 8 * (i >> 2) + 4 * n + (i & 3); }

struct Unit { int arow, brow, pn, nvalid, lrow; };

struct DenseOrder {
    int nM, nN, nwg, G, c;
    __device__ __forceinline__ void init(int M, int N, int G_, int c_) { nM = M / BM; nN = N / BM; nwg = nM * nN; G = G_; c = c_; }
    __device__ __forceinline__ bool next(int i, Unit& u) const {
        const long L = (long)i * G + c; if (L >= nwg) return false;
        int wgid = (int)L; { const int q = nwg / NXCD, r = nwg % NXCD, xcd = wgid % NXCD, off = wgid / NXCD; wgid = (xcd < r ? xcd * (q + 1) : r * (q + 1) + (xcd - r) * q) + off; }
        const int nig = WGM * nN, gid = wgid / nig, fm = gid * WGM, gsz = (nM - fm) < WGM ? (nM - fm) : WGM;
        const int pm = fm + ((wgid % nig) % gsz), pn = (wgid % nig) / gsz;
        u.arow = pm * BM; u.brow = pn * BM; u.pn = pn; u.nvalid = BM; u.lrow = 0; return true;
    }
};
struct MoeOrder {
    const int* ustart; const int* rbase; const int* cntp; int G, c, npn, brows;
    __device__ __forceinline__ bool next(int i, Unit& u) const {
        const int L0 = i * G + c, nwg = ustart[32]; if (L0 >= nwg) return false;
        int L = L0; if (MOE_XCD) { const int q = nwg / NXCD, r = nwg % NXCD, xcd = L0 % NXCD, off = L0 / NXCD; L = (xcd < r ? xcd * (q + 1) : r * (q + 1) + (xcd - r) * q) + off; }
        int e = 0; while (ustart[e + 1] <= L) ++e;
        const int cn = cntp[e], ntile = (cn + BM - 1) / BM, local = L - ustart[e], ti = local % ntile, pn = local / ntile;
        u.arow = rbase[e] + ti * BM; u.brow = e * brows + pn * BM; u.pn = pn; u.nvalid = cn - ti * BM < BM ? cn - ti * BM : BM; u.lrow = e * LIST_CAP + ti * BM; return true;
    }
};

template <class Epi, class Sched, bool GATHER = false>
__device__ __forceinline__ void gemm_phase(PG8_LAS unsigned char* lds, const bf16_t* gA, const bf16_t* gBt, const int K, const Sched& S, const Epi& E, const int* list = nullptr) {
    const int tid = TID(), wid = __builtin_amdgcn_readfirstlane(tid >> 6), lane = tid & 63, wr = wid >> 2, wc = wid & 3, fr = lane & 15, fq = lane >> 4;
    const int nt = K / BK;
    unsigned voffA[2], voffB[2]; int Rl[2], Cl[2];
#pragma unroll
    for (int i = 0; i < 2; ++i) { int R, C; stage_rc(tid * 16 + i * 8192, R, C); const int Rb = Epi::PERM ? ((R & ~31) + perm32(R & 31)) : R;
        voffA[i] = (unsigned)(R * K + C) * 2u; voffB[i] = (unsigned)(Rb * K + C) * 2u; Rl[i] = R; Cl[i] = C; }
    unsigned aoC[2][2], aoN[2][2];
#define PG8_GATHER_OFFS(ao, u_) do { _Pragma("unroll") for (int h_ = 0; h_ < 2; ++h_) _Pragma("unroll") for (int i_ = 0; i_ < 2; ++i_) { \
        int pos_ = h_ * HALF + Rl[i_]; pos_ = pos_ < (u_).nvalid ? pos_ : (u_).nvalid - 1; \
        ao[h_][i_] = (unsigned)list[(u_).lrow + pos_] * (unsigned)(K * 2) + (unsigned)(Cl[i_] * 2); } } while (0)
#define PG8_STAGE_A(bufoff, aptr, h, kb, nx) do { if constexpr (GATHER) { unsigned ao_[2] = {(nx) ? aoN[h][0] : aoC[h][0], (nx) ? aoN[h][1] : aoC[h][1]}; \
        PG8_STAGE(bufoff, (const char*)gA + (kb), ao_); } else { PG8_STAGE(bufoff, (aptr) + (h) * hstep, voffA); } } while (0)
    const size_t kstep = (size_t)(BK * 2);
    const size_t hstep = (size_t)HALF * K * 2;
    const unsigned ldsw = (unsigned)wid * 1024u;
    const int aoff = lds_byte(wr * 64 + fr, fq * 8), boff = lds_byte(wc * 32 + fr, fq * 8);
#define PG8_SA(b, h) (((b) * 2 + (h)) * HTB)
#define PG8_SB(b, h) ((4 + (b) * 2 + (h)) * HTB)
#define PG8_STAGE(bufoff, gbase, voff) do { _Pragma("unroll") for (int _i = 0; _i < 2; ++_i) \
        __builtin_amdgcn_global_load_lds((const unsigned*)((const char*)(gbase) + (voff)[_i]), (PG8_LAS unsigned*)(lds + (bufoff) + ldsw + _i * 8192), 16, 0, 0); } while (0)
#define PG8_LDA(dst, b, h) do { _Pragma("unroll") for (int m = 0; m < 4; ++m) _Pragma("unroll") for (int k = 0; k < 2; ++k) dst[m][k] = *(const PG8_LAS bf16x8*)(lds + PG8_SA(b, h) + aoff + m * 2048 + k * 1024); } while (0)
#define PG8_LDB(dst, b, h) do { _Pragma("unroll") for (int n = 0; n < 2; ++n) _Pragma("unroll") for (int k = 0; k < 2; ++k) dst[n][k] = *(const PG8_LAS bf16x8*)(lds + PG8_SB(b, h) + boff + n * 2048 + k * 1024); } while (0)
#define PG8_MMA(ai, bj, At, Bt) do { __builtin_amdgcn_s_setprio(1); _Pragma("unroll") for (int m = 0; m < 4; ++m) _Pragma("unroll") for (int n = 0; n < 2; ++n) _Pragma("unroll") for (int k = 0; k < 2; ++k) \
        acc[ai][bj][m][n] = __builtin_amdgcn_mfma_f32_16x16x32_bf16(Bt[n][k], At[m][k], acc[ai][bj][m][n], 0, 0, 0); __builtin_amdgcn_s_setprio(0); } while (0)
#define PG8_BAR __builtin_amdgcn_s_barrier()
#define PG8_SCHED __builtin_amdgcn_sched_barrier(0)
    Unit cur, nxt; int ui = 0;
    if (!S.next(0, cur)) return;
    f32x4 acc[2][2][4][2];
#pragma unroll
    for (int a = 0; a < 2; ++a)
#pragma unroll
        for (int b = 0; b < 2; ++b)
#pragma unroll
            for (int m = 0; m < 4; ++m)
#pragma unroll
                for (int n = 0; n < 2; ++n) acc[a][b][m][n] = (f32x4){0.f, 0.f, 0.f, 0.f};
    bf16x8 At[4][2], B0[2][2], B1[2][2];
    const char* cA = (const char*)gA + (size_t)cur.arow * K * 2; const char* cB = (const char*)gBt + (size_t)cur.brow * K * 2;
    if constexpr (GATHER) { PG8_GATHER_OFFS(aoC, cur); }
    PG8_STAGE(PG8_SB(0, 0), cB, voffB); PG8_STAGE(PG8_SB(0, 1), cB + hstep, voffB); PG8_STAGE_A(PG8_SA(0, 0), cA, 0, 0, false); PG8_STAGE_A(PG8_SA(0, 1), cA, 1, 0, false);
    if (wr == 1) PG8_BAR;
    PG8_WAIT_V(2); PG8_BAR;
    PG8_STAGE(PG8_SB(1, 0), cB + kstep, voffB); PG8_STAGE_A(PG8_SA(1, 0), cA + kstep, 0, kstep, false); PG8_STAGE(PG8_SB(1, 1), cB + hstep + kstep, voffB);
    PG8_WAIT_V(6); PG8_BAR;
    for (;;) {
        const bool has_next = S.next(ui + 1, nxt);
        const char* nA = has_next ? (const char*)gA + (size_t)nxt.arow * K * 2 : cA; const char* nB = has_next ? (const char*)gBt + (size_t)nxt.brow * K * 2 : cB;
        if constexpr (GATHER) { if (has_next) { PG8_GATHER_OFFS(aoN, nxt); } }
        for (int t = 0; t < nt; t += 2) {
            const bool last = (t == nt - 2);
            const bool nx = last && has_next;
            const char* a1 = cA + (size_t)(t + 1) * kstep;
            const char* a2 = last ? nA : cA + (size_t)(t + 2) * kstep; const char* b2 = last ? nB : cB + (size_t)(t + 2) * kstep;
            const char* a3 = a2 + kstep; const char* b3 = b2 + kstep;
            const size_t k1 = (size_t)(t + 1) * kstep, k2 = last ? 0 : (size_t)(t + 2) * kstep, k3 = k2 + kstep;
            PG8_LDB(B0, 0, 0); PG8_LDB(B1, 0, 1); PG8_SCHED; PG8_LDA(At, 0, 0); PG8_STAGE_A(PG8_SA(1, 1), a1, 1, k1, false);
            PG8_WAIT_V(8); PG8_WAIT_L(0); PG8_BAR; PG8_MMA(0, 0, At, B0); PG8_MMA(0, 1, At, B1); PG8_BAR; PG8_SCHED;
            PG8_LDA(At, 0, 1); PG8_STAGE(PG8_SB(0, 0), b2, voffB); PG8_STAGE(PG8_SB(0, 1), b2 + hstep, voffB); PG8_STAGE_A(PG8_SA(0, 0), a2, 0, k2, nx);
            PG8_WAIT_V(8); PG8_WAIT_L(0); PG8_BAR; PG8_MMA(1, 0, At, B0); PG8_MMA(1, 1, At, B1); PG8_BAR; PG8_SCHED;
            PG8_LDB(B0, 1, 0); PG8_LDB(B1, 1, 1); PG8_SCHED; PG8_LDA(At, 1, 0); PG8_STAGE_A(PG8_SA(0, 1), a2, 1, k2, nx);
            PG8_WAIT_V(8); PG8_WAIT_L(0); PG8_BAR; PG8_MMA(0, 0, At, B0); PG8_MMA(0, 1, At, B1); PG8_BAR; PG8_SCHED;
            PG8_LDA(At, 1, 1); PG8_STAGE(PG8_SB(1, 0), b3, voffB); PG8_STAGE(PG8_SB(1, 1), b3 + hstep, voffB); PG8_STAGE_A(PG8_SA(1, 0), a3, 0, k3, nx);
            PG8_WAIT_V(8); PG8_WAIT_L(0); PG8_BAR; PG8_MMA(1, 0, At, B0); PG8_MMA(1, 1, At, B1); PG8_BAR; PG8_SCHED;
        }
        if (wr == 0) PG8_BAR;
        E(acc, cur, wr, wc, fr, fq);
        if (!has_next) break;
#pragma unroll
        for (int a = 0; a < 2; ++a)
#pragma unroll
            for (int b = 0; b < 2; ++b)
#pragma unroll
                for (int m = 0; m < 4; ++m)
#pragma unroll
                    for (int n = 0; n < 2; ++n) acc[a][b][m][n] = (f32x4){0.f, 0.f, 0.f, 0.f};
        cur = nxt; cA = nA; cB = nB; ++ui;
        if constexpr (GATHER) { _Pragma("unroll") for (int h_ = 0; h_ < 2; ++h_) _Pragma("unroll") for (int i_ = 0; i_ < 2; ++i_) aoC[h_][i_] = aoN[h_][i_]; }
        if (wr == 1) PG8_BAR;
    }
    PG8_WAIT_V(0);
    PG8_BAR;
#undef PG8_SA
#undef PG8_SB
#undef PG8_STAGE
#undef PG8_STAGE_A
#undef PG8_GATHER_OFFS
#undef PG8_LDA
#undef PG8_LDB
#undef PG8_MMA
#undef PG8_BAR
#undef PG8_SCHED
}

struct EpiStore {
    static constexpr bool PERM = true;
    bf16_t* C; int ldc;
    __device__ __forceinline__ void operator()(const f32x4 (&acc)[2][2][4][2], const Unit& u, int wr, int wc, int fr, int fq) const {
#pragma unroll
        for (int ai = 0; ai < 2; ++ai)
#pragma unroll
            for (int m = 0; m < 4; ++m) {
                bf16_t* rowp = C + (long)(u.arow + ai * HALF + wr * 64 + m * 16 + fr) * ldc + u.pn * BM + wc * 32 + 8 * fq;
#pragma unroll
                for (int bj = 0; bj < 2; ++bj) { const f32x4 v0 = acc[ai][bj][m][0], v1 = acc[ai][bj][m][1];
                    *(u32x4*)(rowp + bj * HALF) = (u32x4){pack2(v0[0], v0[1]), pack2(v0[2], v0[3]), pack2(v1[0], v1[1]), pack2(v1[2], v1[3])}; }
            }
    }
};
struct EpiGlu {
    static constexpr bool PERM = true;
    const bf16_t* y; bf16_t* ycat;
    __device__ __forceinline__ void operator()(const f32x4 (&acc)[2][2][4][2], const Unit& u, int wr, int wc, int fr, int fq) const {
#pragma unroll
        for (int ai = 0; ai < 2; ++ai)
#pragma unroll
            for (int m = 0; m < 4; ++m) {
                const long row = u.arow + ai * HALF + wr * 64 + m * 16 + fr;
#pragma unroll
                for (int bj = 0; bj < 2; ++bj) {
                    const int col = u.pn * BM + bj * HALF + wc * 32 + 8 * fq;
                    const u32x4 yy = *(const u32x4*)(y + row * 512 + col);
                    const f32x4 v0 = acc[ai][bj][m][0], v1 = acc[ai][bj][m][1];
                    float o[8];
#pragma unroll
                    for (int e = 0; e < 4; ++e) { o[e] = sigmoidf_(v0[e]); o[4 + e] = sigmoidf_(v1[e]); }
#pragma unroll
                    for (int e = 0; e < 4; ++e) { o[2 * e] *= bf2f((bf16_t)(yy[e] & 0xffff)); o[2 * e + 1] *= bf2f((bf16_t)(yy[e] >> 16)); }
                    *(u32x4*)(ycat + row * 1024 + 512 + col) = (u32x4){pack2(o[0], o[1]), pack2(o[2], o[3]), pack2(o[4], o[5]), pack2(o[6], o[7])};
                }
            }
    }
};
struct EpiMoe1 {
    static constexpr bool PERM = true;
    bf16_t* H;
    __device__ __forceinline__ void operator()(const f32x4 (&acc)[2][2][4][2], const Unit& u, int wr, int wc, int fr, int fq) const {
#pragma unroll
        for (int ai = 0; ai < 2; ++ai)
#pragma unroll
            for (int m = 0; m < 4; ++m) {
                const int rl = ai * HALF + wr * 64 + m * 16 + fr;
                if (rl < u.nvalid) {
                    float o[8];
#pragma unroll
                    for (int n = 0; n < 2; ++n)
#pragma unroll
                        for (int e = 0; e < 4; ++e) o[4 * n + e] = siluf_(acc[ai][0][m][n][e]) * acc[ai][1][m][n][e];
                    *(u32x4*)(H + (long)(u.arow + rl) * EFF + u.pn * HALF + wc * 32 + 8 * fq) = (u32x4){pack2(o[0], o[1]), pack2(o[2], o[3]), pack2(o[4], o[5]), pack2(o[6], o[7])};
                }
            }
    }
};
struct EpiMoe2 {
    static constexpr bool PERM = true;
    bf16_t* Y; const float* gate;
    __device__ __forceinline__ void operator()(const f32x4 (&acc)[2][2][4][2], const Unit& u, int wr, int wc, int fr, int fq) const {
#pragma unroll
        for (int ai = 0; ai < 2; ++ai)
#pragma unroll
            for (int m = 0; m < 4; ++m) {
                const int rl = ai * HALF + wr * 64 + m * 16 + fr;
                if (rl < u.nvalid) {
                    const float g = gate[u.lrow + rl];
                    bf16_t* rowp = Y + (long)(u.arow + rl) * DM + u.pn * BM + wc * 32 + 8 * fq;
#pragma unroll
                    for (int bj = 0; bj < 2; ++bj) { const f32x4 v0 = acc[ai][bj][m][0] * g, v1 = acc[ai][bj][m][1] * g;
                        *(u32x4*)(rowp + bj * HALF) = (u32x4){pack2(v0[0], v0[1]), pack2(v0[2], v0[3]), pack2(v1[0], v1[1]), pack2(v1[2], v1[3])}; }
                }
            }
    }
};
}

template <class Epi>
__device__ __forceinline__ void gemm_dense(const bf16_t* A, const bf16_t* Bt, int M, int N, int K, const Epi& E) {
    pg8::DenseOrder S; S.init(M, N, (int)gridDim.x, (int)blockIdx.x);
    pg8::gemm_phase<Epi, pg8::DenseOrder>((PG8_LAS unsigned char*)LDS_BASE(), A, Bt, K, S, E);
}

__device__ __forceinline__ void phase_ba(const Params& p) {
    float* wl = (float*)LDS_BASE();
    {
        float v_[16];
#pragma unroll
        for (int j = 0; j < 16; ++j) { const int i = TID() + NTHREADS * j; v_[j] = p.w_in[(long)(i >> 3) * 2568 + 2048 + (i & 7)]; }
#pragma unroll
        for (int j = 0; j < 16; ++j) { const int i = TID() + NTHREADS * j; wl[(i & 7) * 1024 + (i >> 3)] = v_[j]; }
    }
    __syncthreads();
    const int lane = TID() & 63, gw = blockIdx.x * NW + (TID() >> 6), nw = gridDim.x * NW;
    constexpr int TPI = 4;
    for (int grp = gw; grp < NT / TPI; grp += nw) {
        const long tok0 = (long)grp * TPI;
        f32x4 xv[TPI][4];
#pragma unroll
        for (int tt = 0; tt < TPI; ++tt)
#pragma unroll
            for (int i = 0; i < 4; ++i) xv[tt][i] = NT_LOAD((const f32x4*)(p.x + (tok0 + tt) * DM + 4 * lane + 256 * i));
#pragma unroll
        for (int tt = 0; tt < TPI; ++tt)
#pragma unroll
            for (int i = 0; i < 4; ++i) *(u32x2*)(p.hb + (tok0 + tt) * DM + 4 * lane + 256 * i) = (u32x2){pack2(xv[tt][i][0], xv[tt][i][1]), pack2(xv[tt][i][2], xv[tt][i][3])};
        float acc[TPI][8];
#pragma unroll
        for (int tt = 0; tt < TPI; ++tt)
#pragma unroll
            for (int n = 0; n < 8; ++n) acc[tt][n] = 0.f;
#pragma unroll
        for (int i = 0; i < 4; ++i)
#pragma unroll
            for (int n = 0; n < 8; ++n) {
                const f32x4 wv = *(const f32x4*)(wl + n * 1024 + 4 * lane + 256 * i);
#pragma unroll
                for (int tt = 0; tt < TPI; ++tt) acc[tt][n] += (xv[tt][i][0] * wv[0] + xv[tt][i][1] * wv[1]) + (xv[tt][i][2] * wv[2] + xv[tt][i][3] * wv[3]);
            }
#pragma unroll
        for (int o = 32; o > 0; o >>= 1)
#pragma unroll
            for (int tt = 0; tt < TPI; ++tt)
#pragma unroll
                for (int n = 0; n < 8; ++n) acc[tt][n] += __shfl_xor(acc[tt][n], o);
        if (lane < 4) {
#pragma unroll
            for (int tt = 0; tt < TPI; ++tt) {
                const float bl = lane == 0 ? acc[tt][0] : lane == 1 ? acc[tt][1] : lane == 2 ? acc[tt][2] : acc[tt][3];
                const float al = lane == 0 ? acc[tt][4] : lane == 1 ? acc[tt][5] : lane == 2 ? acc[tt][6] : acc[tt][7];
                const float xx = al + p.dt_bias[lane];
                const float sp = xx > 20.f ? xx : log1pf(expf(xx));
                p.gbeta[(tok0 + tt) * 4 + lane] = 1.0f / (1.0f + expf(-bl));
                p.gg[(tok0 + tt) * 4 + lane] = -expf(p.a_log[lane]) * sp;
            }
        }
    }
}

__device__ __forceinline__ void phase_gdn_prep(const Params& p) {
    const int t = TID(), lane = t & 63, w = t >> 6;
    constexpr int RUN = 16;
    const int nitems = (NT / RUN) * 3;
    for (int item = (int)blockIdx.x * NW + w; item < nitems; item += (int)gridDim.x * NW) {
        const int i = item % 3, run = item / 3;
        const long tok0 = (long)run * RUN; const int s0 = (int)(tok0 % NS_);
        const int cb = i * 512 + lane * 8;
        u32x4 x[RUN + 3];
#pragma unroll
        for (int j = 0; j < 3; ++j) x[j] = s0 > 0 ? *(const u32x4*)(p.proj + (tok0 - 3 + j) * PROJ_LD + cb) : (u32x4){0u, 0u, 0u, 0u};
#pragma unroll
        for (int k = 0; k < RUN; ++k) x[3 + k] = *(const u32x4*)(p.proj + (tok0 + k) * PROJ_LD + cb);
        f32x4 wv[4][2];
#pragma unroll
        for (int j = 0; j < 4; ++j) { wv[j][0] = *(const f32x4*)(p.conv + j * 1536 + cb); wv[j][1] = *(const f32x4*)(p.conv + j * 1536 + cb + 4); }
        bf16_t* dst = (i == 0 ? p.gq : i == 1 ? p.gk : p.gv) + tok0 * 512 + lane * 8;
#pragma unroll
        for (int k = 0; k < RUN; ++k) {
            float a[8];
#pragma unroll
            for (int e = 0; e < 8; ++e) a[e] = 0.f;
#pragma unroll
            for (int j = 0; j < 4; ++j) {
                const u32x4 xv = x[k + j];
                a[0] += wv[j][0][0] * bf2f((bf16_t)(xv[0] & 0xffff)); a[1] += wv[j][0][1] * bf2f((bf16_t)(xv[0] >> 16));
                a[2] += wv[j][0][2] * bf2f((bf16_t)(xv[1] & 0xffff)); a[3] += wv[j][0][3] * bf2f((bf16_t)(xv[1] >> 16));
                a[4] += wv[j][1][0] * bf2f((bf16_t)(xv[2] & 0xffff)); a[5] += wv[j][1][1] * bf2f((bf16_t)(xv[2] >> 16));
                a[6] += wv[j][1][2] * bf2f((bf16_t)(xv[3] & 0xffff)); a[7] += wv[j][1][3] * bf2f((bf16_t)(xv[3] >> 16));
            }
            float ss = 0.f;
#pragma unroll
            for (int e = 0; e < 8; ++e) { a[e] = siluf_(a[e]); ss += a[e] * a[e]; }
            if (i < 2) {
                ss += __shfl_xor(ss, 1); ss += __shfl_xor(ss, 2); ss += __shfl_xor(ss, 4); ss += __shfl_xor(ss, 8);
                const float sc = rsqrtf(ss + 1e-6f);
#pragma unroll
                for (int e = 0; e < 8; ++e) a[e] *= sc;
            }
            *(u32x4*)(dst + (long)k * 512) = (u32x4){pack2(a[0], a[1]), pack2(a[2], a[3]), pack2(a[4], a[5]), pack2(a[6], a[7])};
        }
    }
}

#ifndef FUSE_PREP
#define FUSE_PREP 1
#endif
constexpr int CLD = 136;
__device__ __forceinline__ void phase_gdn_chunk(const Params& p) {
    const int half = TID() >> 8;
    char* lds = LDS_BASE() + half * 70656;
    float* gc = (float*)lds; float* be = gc + 64; float* eg = be + 64; float* ek = eg + 64; float* bek = ek + 64;
    float* Ls = (float*)(lds + 1280);
    bf16_t* vs = (bf16_t*)(lds + 1280 + 16384); bf16_t* ks = vs + 64 * CLD; bf16_t* qs = ks + 64 * CLD;
    const int t = TID() & 255, lane = t & 63, w = t >> 6, fr = lane & 15, fq = lane >> 4;
    const int nunits = NB_ * 4 * NCH;
    for (int up = blockIdx.x; up * 2 < nunits; up += gridDim.x) {
        const int u = up * 2 + half;
        const int n = u % NCH, hh = (u / NCH) & 3, b = u / (NCH * 4);
        const long tok0 = (long)b * NS_ + n * 64;
        LDS_BARRIER();
#if FUSE_PREP
        {
            const int rg = t >> 4, ch = (t & 15) * 8;
            const int s0 = n * 64 + 4 * rg;
#pragma unroll
            for (int X = 0; X < 3; ++X) {
                const int col = X * 512 + hh * 128 + ch;
                u32x4 x[7];
#pragma unroll
                for (int j = 0; j < 7; ++j) x[j] = (s0 - 3 + j) >= 0 ? *(const u32x4*)(p.proj + (tok0 + 4 * rg - 3 + j) * PROJ_LD + col) : (u32x4){0u, 0u, 0u, 0u};
                f32x4 wv[4][2];
#pragma unroll
                for (int j = 0; j < 4; ++j) { wv[j][0] = *(const f32x4*)(p.conv + j * 1536 + col); wv[j][1] = *(const f32x4*)(p.conv + j * 1536 + col + 4); }
                bf16_t* dl = X == 0 ? qs : X == 1 ? ks : vs;
#pragma unroll
                for (int i = 0; i < 4; ++i) {
                    float a[8];
#pragma unroll
                    for (int e = 0; e < 8; ++e) a[e] = 0.f;
#pragma unroll
                    for (int j = 0; j < 4; ++j) {
                        const u32x4 xv = x[i + j];
                        a[0] += wv[j][0][0] * bf2f((bf16_t)(xv[0] & 0xffff)); a[1] += wv[j][0][1] * bf2f((bf16_t)(xv[0] >> 16));
                        a[2] += wv[j][0][2] * bf2f((bf16_t)(xv[1] & 0xffff)); a[3] += wv[j][0][3] * bf2f((bf16_t)(xv[1] >> 16));
                        a[4] += wv[j][1][0] * bf2f((bf16_t)(xv[2] & 0xffff)); a[5] += wv[j][1][1] * bf2f((bf16_t)(xv[2] >> 16));
                        a[6] += wv[j][1][2] * bf2f((bf16_t)(xv[3] & 0xffff)); a[7] += wv[j][1][3] * bf2f((bf16_t)(xv[3] >> 16));
                    }
                    float ss = 0.f;
#pragma unroll
                    for (int e = 0; e < 8; ++e) { a[e] = siluf_(a[e]); ss += a[e] * a[e]; }
                    if (X < 2) {
                        ss += __shfl_xor(ss, 1); ss += __shfl_xor(ss, 2); ss += __shfl_xor(ss, 4); ss += __shfl_xor(ss, 8);
                        const float sc = rsqrtf(ss + 1e-6f);
#pragma unroll
                        for (int e = 0; e < 8; ++e) a[e] *= sc;
                    }
                    *(u32x4*)(dl + (4 * rg + i) * CLD + ch) = (u32x4){pack2(a[0], a[1]), pack2(a[2], a[3]), pack2(a[4], a[5]), pack2(a[6], a[7])};
                }
            }
        }
#else
#pragma unroll
        for (int i = 0; i < 4; ++i) {
            const int c = t + 256 * i, row = c >> 4, ch = (c & 15) * 8;
            const long go_ = (tok0 + row) * 512 + hh * 128 + ch;
            *(u32x4*)(qs + row * CLD + ch) = *(const u32x4*)(p.gq + go_);
            *(u32x4*)(ks + row * CLD + ch) = *(const u32x4*)(p.gk + go_);
            *(u32x4*)(vs + row * CLD + ch) = *(const u32x4*)(p.gv + go_);
        }
#endif
        if (w == 0) {
            float v = p.gg[(tok0 + lane) * 4 + hh];
#pragma unroll
            for (int o = 1; o < 64; o <<= 1) { const float nb = __shfl_up(v, o); if (lane >= o) v += nb; }
            const float gl = __shfl(v, 63);
            const float bt = p.gbeta[(tok0 + lane) * 4 + hh];
            gc[lane] = v; be[lane] = bt; eg[lane] = expf(v); ek[lane] = expf(gl - v); bek[lane] = bt * expf(v);
            if (lane == 0) WT_STORE_F(p.cgl + u, expf(gl));
        }
        LDS_BARRIER();
        {
            f32x4 akk[4], aqk[4];
#pragma unroll
            for (int nn = 0; nn < 4; ++nn) { akk[nn] = (f32x4){0.f, 0.f, 0.f, 0.f}; aqk[nn] = (f32x4){0.f, 0.f, 0.f, 0.f}; }
#pragma unroll
            for (int k4 = 0; k4 < 4; ++k4) {
                const bf16x8 afk = *(const bf16x8*)(ks + (16 * w + fr) * CLD + k4 * 32 + fq * 8);
                const bf16x8 afq = *(const bf16x8*)(qs + (16 * w + fr) * CLD + k4 * 32 + fq * 8);
#pragma unroll
                for (int nn = 0; nn < 4; ++nn) {
                    const bf16x8 bfr = *(const bf16x8*)(ks + (16 * nn + fr) * CLD + k4 * 32 + fq * 8);
                    akk[nn] = __builtin_amdgcn_mfma_f32_16x16x32_bf16(bfr, afk, akk[nn], 0, 0, 0);
                    aqk[nn] = __builtin_amdgcn_mfma_f32_16x16x32_bf16(bfr, afq, aqk[nn], 0, 0, 0);
                }
            }
            const int i = 16 * w + fr; const float gci = gc[i], bei = be[i];
#pragma unroll
            for (int nn = 0; nn < 4; ++nn) {
                const int j0 = 16 * nn + 4 * fq;
                f32x4 lv; float qv[4];
#pragma unroll
                for (int r = 0; r < 4; ++r) {
                    const int j = j0 + r;
                    const float dec = i >= j ? expf(gci - gc[j]) : 0.f;
                    lv[r] = i > j ? bei * akk[nn][r] * dec : 0.f;
                    qv[r] = 0.08838834764831845f * aqk[nn][r] * dec;
                }
                *(f32x4*)(Ls + i * 64 + j0) = lv;
                *(u32x2*)(p.cQK + (long)u * 8192 + i * 64 + j0) = (u32x2){pack2(qv[0], qv[1]), pack2(qv[2], qv[3])};
            }
        }
        LDS_BARRIER();
        {
            const int c = t & 127; const bf16_t* src = t < 128 ? vs : ks; const float* mulp = t < 128 ? be : bek;
            float x[64];
#pragma unroll
            for (int i = 0; i < 64; ++i) {
                float a = mulp[i] * bf2f(src[i * CLD + c]);
#pragma unroll
                for (int j4 = 0; j4 < (i + 3) / 4; ++j4) {
                    const f32x4 l4 = *(const f32x4*)(Ls + i * 64 + 4 * j4);
                    if (4 * j4 + 0 < i) a = fmaf(-l4[0], x[4 * j4 + 0], a);
                    if (4 * j4 + 1 < i) a = fmaf(-l4[1], x[4 * j4 + 1], a);
                    if (4 * j4 + 2 < i) a = fmaf(-l4[2], x[4 * j4 + 2], a);
                    if (4 * j4 + 3 < i) a = fmaf(-l4[3], x[4 * j4 + 3], a);
                }
                x[i] = a;
                asm volatile("" ::: "memory");
            }
            LDS_BARRIER();
            bf16_t* Wt = (bf16_t*)Ls;
            if (t < 128) {
#pragma unroll
                for (int i = 0; i < 64; ++i) vs[i * CLD + c] = f2bf(x[i]);
            } else {
#pragma unroll
                for (int i = 0; i < 64; ++i) Wt[i * 128 + c] = f2bf(x[i]);
            }
        }
        LDS_BARRIER();
#pragma unroll
        for (int e = 0; e < 4; ++e) {
            const int id = t + 256 * e, row = id >> 4, ch = (id & 15) * 8;
            *(u32x4*)(p.cU + (long)u * 8192 + row * 128 + ch) = *(const u32x4*)(vs + row * CLD + ch);
            *(u32x4*)(p.cW + (long)u * 8192 + row * 128 + ch) = *(const u32x4*)((const bf16_t*)Ls + row * 128 + ch);
            {
                const u32x4 qv = *(const u32x4*)(qs + row * CLD + ch); const float sc = 0.08838834764831845f * eg[row];
                unsigned o4[4];
#pragma unroll
                for (int k = 0; k < 4; ++k) o4[k] = pack2(bf2f((bf16_t)(qv[k] & 0xffff)) * sc, bf2f((bf16_t)(qv[k] >> 16)) * sc);
                *(u32x4*)(p.cQd + (long)u * 8192 + row * 128 + ch) = (u32x4){o4[0], o4[1], o4[2], o4[3]};
            }
            {
                const int d = id >> 3, i0 = (id & 7) * 8;
                float kv[8];
#pragma unroll
                for (int k = 0; k < 8; ++k) kv[k] = bf2f(ks[(i0 + k) * CLD + d]) * ek[i0 + k];
                *(u32x4*)(p.cKdT + (long)u * 8192 + d * 64 + i0) = (u32x4){pack2(kv[0], kv[1]), pack2(kv[2], kv[3]), pack2(kv[4], kv[5]), pack2(kv[6], kv[7])};
            }
        }
    }
}

#define GO_STORE(ptr, lo, hi) (*(u32x2*)(ptr) = (u32x2){(lo), (hi)})
#ifndef SCAN_XCD_REMAP
#define SCAN_XCD_REMAP 1
#endif
struct ScanOwn { bf16x8 f[7]; u32x2 uvr; };
__device__ __forceinline__ const bf16_t* scan_slot_ptr(const Params& p, int s, int w, int fr, int fq) {
    if (s < 4) return p.cW + (16 * w + fr) * 128 + s * 32 + fq * 8;
    if (s < 8) return p.cQd + (16 * w + fr) * 128 + (s - 4) * 32 + fq * 8;
    if (s < 12) return p.cKdT + (32 * w + 16 * ((s - 8) >> 1) + fr) * 64 + ((s - 8) & 1) * 32 + fq * 8;
    return p.cQK + (16 * w + fr) * 64 + (s - 12) * 32 + fq * 8;
}
#define SCAN_LOAD(P, cu_) do { const long co_ = (long)(cu_) * 8192; \
        _Pragma("unroll") for (int j = 0; j < 7; ++j) P.f[j] = *(const bf16x8*)(sp[j] + co_); \
        P.uvr = *(const u32x2*)(up + co_); } while (0)
#define SCAN_STEP(Pw, n_) do { \
        const long cu_ = cu0 + (n_); const long tokr = (long)b * NS_ + (n_) * 64 + 16 * w + fr; \
        bf16x8 sb[4]; \
        _Pragma("unroll") for (int k4 = 0; k4 < 4; ++k4) sb[k4] = *(const bf16x8*)(SbT + fr * CLD + k4 * 32 + fq * 8); \
        f32x4 vw = (f32x4){0.f, 0.f, 0.f, 0.f}, o = (f32x4){0.f, 0.f, 0.f, 0.f}; \
        _Pragma("unroll") for (int k4 = 0; k4 < 4; ++k4) { vw = __builtin_amdgcn_mfma_f32_16x16x32_bf16(sb[k4], F[k4], vw, 0, 0, 0); o = __builtin_amdgcn_mfma_f32_16x16x32_bf16(sb[k4], F[4 + k4], o, 0, 0, 0); } \
          \
        { const u32x2 uvc = *(const u32x2*)ub; const unsigned u0_ = uvc[0], u1_ = uvc[1]; \
          VnT[(4 * fq + 0) * 72 + 16 * w + fr] = f2bf(bf2f((bf16_t)(u0_ & 0xffff)) - vw[0]); VnT[(4 * fq + 1) * 72 + 16 * w + fr] = f2bf(bf2f((bf16_t)(u0_ >> 16)) - vw[1]); \
          VnT[(4 * fq + 2) * 72 + 16 * w + fr] = f2bf(bf2f((bf16_t)(u1_ & 0xffff)) - vw[2]); VnT[(4 * fq + 3) * 72 + 16 * w + fr] = f2bf(bf2f((bf16_t)(u1_ >> 16)) - vw[3]); } \
        LDS_BARRIER(); \
        _Pragma("unroll") for (int j = 0; j < 7; ++j) *(bf16x8*)(xw + j * 512) = Pw.f[j];                   \
        *(u32x2*)ub = Pw.uvr;                                                                                \
        const float glc = glbuf[(n_)]; \
        bf16x8 vb[2]; \
        _Pragma("unroll") for (int k2 = 0; k2 < 2; ++k2) vb[k2] = *(const bf16x8*)(VnT + fr * 72 + k2 * 32 + fq * 8); \
        _Pragma("unroll") for (int k2 = 0; k2 < 2; ++k2) o = __builtin_amdgcn_mfma_f32_16x16x32_bf16(vb[k2], F[12 + k2], o, 0, 0, 0); \
        GO_STORE((p.go + tokr * 512 + hh * 128 + vsl * 16 + 4 * fq), pack2(o[0], o[1]), pack2(o[2], o[3])); \
        _Pragma("unroll") for (int m = 0; m < 2; ++m) { \
            sacc[m] = sacc[m] * glc; \
            _Pragma("unroll") for (int k2 = 0; k2 < 2; ++k2) sacc[m] = __builtin_amdgcn_mfma_f32_16x16x32_bf16(F[8 + 2 * m + k2], vb[k2], sacc[m], 0, 0, 0); \
            *(u32x2*)(SbT + fr * CLD + 32 * w + 16 * m + 4 * fq) = (u32x2){pack2(sacc[m][0], sacc[m][1]), pack2(sacc[m][2], sacc[m][3])}; \
        } \
        LDS_BARRIER(); \
        _Pragma("unroll") for (int k = 0; k < 14; ++k) F[k] = *(const bf16x8*)(xr + k * 512);                \
        { const long c3_ = cu_ + 3 < culast ? cu_ + 3 : culast; SCAN_LOAD(Pw, c3_); } \
    } while (0)
#ifdef EMU
#define PIN2(a, b) do { } while (0)
#else
#define PIN2(a, b) asm volatile("" : "+v"(a), "+v"(b))
#endif
__device__ __forceinline__ void phase_gdn_scan(const Params& p, int nblk) {
    const int half = TID() >> 8;
    bf16_t* SbT = (bf16_t*)(LDS_BASE() + half * 8192);
    bf16_t* VnT = SbT + 16 * CLD;
    const int t = TID() & 255, lane = t & 63, w = t >> 6, fr = lane & 15, fq = lane >> 4;
    bf16_t* xbuf = (bf16_t*)(LDS_BASE() + 16384) + w * (14 * 512);
    bf16_t* xw = xbuf + half * (7 * 512) + lane * 8; const bf16_t* xr = xbuf + lane * 8;
    unsigned* ub = (unsigned*)(LDS_BASE() + 16384 + 4 * 14336) + ((half * 4 + w) * 64 + lane) * 2;
    float* glbuf = (float*)(LDS_BASE() + 16384 + 4 * 14336 + 4096);
    const int nunits = NB_ * 4 * 8;
    for (int x = blockIdx.x; x * 2 < nunits; x += nblk) {
        int up_ = x;
        if (SCAN_XCD_REMAP && (nblk & 31) == 0 && (nunits & 63) == 0) { const int xcd = x & 7, slot = x >> 3; up_ = 4 * ((slot >> 2) * 8 + xcd) + (slot & 3); }
        const int u = up_ * 2 + half;
        const int vsl = u & 7, hh = (u >> 3) & 3, b = u >> 5;
        const long cu0 = (long)(b * 4 + hh) * NCH, culast = cu0 + NCH - 1;
        const bf16_t* sp[7];
#pragma unroll
        for (int j = 0; j < 7; ++j) { const bf16_t* p0 = scan_slot_ptr(p, j, w, fr, fq); const bf16_t* p1 = scan_slot_ptr(p, 7 + j, w, fr, fq); sp[j] = half ? p1 : p0; }
        const bf16_t* up = p.cU + (16 * w + fr) * 128 + vsl * 16 + 4 * fq;
        LDS_BARRIER();
        for (int i = t; i < 16 * CLD; i += 256) SbT[i] = 0;
        f32x4 sacc[2] = {(f32x4){0.f, 0.f, 0.f, 0.f}, (f32x4){0.f, 0.f, 0.f, 0.f}};
        ScanOwn PA, PB; bf16x8 F[14];
        for (int i = TID(); i < NCH; i += NTHREADS) glbuf[i] = p.cgl[cu0 + i];
        SCAN_LOAD(PA, cu0); { const long c1_ = cu0 + 1 < culast ? cu0 + 1 : culast; SCAN_LOAD(PB, c1_); }
#pragma unroll
        for (int j = 0; j < 7; ++j) *(bf16x8*)(xw + j * 512) = PA.f[j];
        *(u32x2*)ub = PA.uvr;
        LDS_BARRIER();
#pragma unroll
        for (int k = 0; k < 14; ++k) F[k] = *(const bf16x8*)(xr + k * 512);
        { const long c2_ = cu0 + 2 < culast ? cu0 + 2 : culast; SCAN_LOAD(PA, c2_); }
        int n = 0;
#pragma unroll 1
        for (; n + 2 <= NCH; n += 2) {
            SCAN_STEP(PB, n);
            SCAN_STEP(PA, n + 1);
        }
    }
}
#undef SCAN_STEP
#undef SCAN_LOAD

__device__ __forceinline__ void phase_gdn_post(const Params& p) {
    const int lane = TID() & 63; const int gw = blockIdx.x * NW + (TID() >> 6), nw = gridDim.x * NW;
    const f32x4 nw0 = *(const f32x4*)(p.gnorm + (lane & 15) * 8), nw1 = *(const f32x4*)(p.gnorm + (lane & 15) * 8 + 4);
    for (int g8 = gw; g8 < NT / 8; g8 += nw) {
        const long tok0 = (long)g8 * 8;
        u32x4 ov[8], zv[8];
#pragma unroll
        for (int k = 0; k < 8; ++k) { ov[k] = NT_LOAD((const u32x4*)(p.go + (tok0 + k) * 512 + lane * 8)); zv[k] = NT_LOAD((const u32x4*)(p.proj + (tok0 + k) * PROJ_LD + 1536 + lane * 8)); }
#pragma unroll
        for (int k = 0; k < 8; ++k) {
            float o[8], z[8];
#pragma unroll
            for (int e = 0; e < 4; ++e) { o[2 * e] = bf2f((bf16_t)(ov[k][e] & 0xffff)); o[2 * e + 1] = bf2f((bf16_t)(ov[k][e] >> 16)); z[2 * e] = bf2f((bf16_t)(zv[k][e] & 0xffff)); z[2 * e + 1] = bf2f((bf16_t)(zv[k][e] >> 16)); }
            float ss = 0.f;
#pragma unroll
            for (int e = 0; e < 8; ++e) ss += o[e] * o[e];
            ss += __shfl_xor(ss, 1); ss += __shfl_xor(ss, 2); ss += __shfl_xor(ss, 4); ss += __shfl_xor(ss, 8);
            const float rs = rsqrtf(ss * (1.0f / 128.0f) + 1e-6f);
            float r[8];
#pragma unroll
            for (int e = 0; e < 4; ++e) { r[e] = o[e] * rs * nw0[e] * siluf_(z[e]); r[4 + e] = o[4 + e] * rs * nw1[e] * siluf_(z[4 + e]); }
            *(u32x4*)(p.ycat + (tok0 + k) * 1024 + lane * 8) = (u32x4){pack2(r[0], r[1]), pack2(r[2], r[3]), pack2(r[4], r[5]), pack2(r[6], r[7])};
        }
    }
}

__device__ __forceinline__ float gelu_tanh(float x) { return 0.5f * x * (1.0f + tanhf(0.7978845608028654f * (x + 0.044715f * x * x * x))); }
#ifndef S5_CARRY
#define S5_CARRY 1
#endif
#ifdef EMU
#define CARRY_PIN(a, b) do { } while (0)
#else
#define CARRY_PIN(a, b) asm volatile("" : "+v"(a), "+v"(b))
#endif
#define WAVE_SYNC() LDS_BARRIER()
constexpr int S5_NSEG1 = NCH >= 16 ? 8 : NCH / 2, S5_NSEG2 = NCH >= 8 ? 4 : NCH / 2;
struct S5Task { bf16x8 bfm[8]; bf16x8 cf[4]; float ar, ai; f32x4 dsk; };
struct S5In { bf16x8 uf[4]; u32x2 uu[4]; };
template <int PASS>
__device__ __forceinline__ void s5_task_init(const Params& p, S5Task& T, int g, int lane, int fr, int fq) {
    bf16x8 zf;
#pragma unroll
    for (int e = 0; e < 8; ++e) zf[e] = 0;
#pragma unroll
    for (int nt = 0; nt < 8; ++nt) T.bfm[nt] = fq < 2 ? *(const bf16x8*)(p.s5bbm + ((long)g * 128 + 16 * nt + fr) * 16 + 8 * fq) : zf;
    if (PASS == 2) {
#pragma unroll
        for (int k4 = 0; k4 < 4; ++k4) T.cf[k4] = *(const bf16x8*)(p.s5cm + (g * 16 + fr) * 128 + k4 * 32 + fq * 8);
        T.dsk = *(const f32x4*)(p.s5d + g * 16 + 4 * fq);
    }
    T.ar = p.s5a[(g * 64 + lane) * 2]; T.ai = p.s5a[(g * 64 + lane) * 2 + 1];
}
template <int PASS>
__device__ __forceinline__ void s5_load(const Params& p, S5In& I, int g, long tok0, int fr, int fq) {
    bf16x8 zf;
#pragma unroll
    for (int e = 0; e < 8; ++e) zf[e] = 0;
#pragma unroll
    for (int mt = 0; mt < 4; ++mt) I.uf[mt] = fq < 2 ? *(const bf16x8*)(p.proj + (tok0 + 16 * mt + fr) * PROJ_LD + 2048 + g * 16 + 8 * fq) : zf;
    if (PASS == 2) {
#pragma unroll
        for (int mt = 0; mt < 4; ++mt) I.uu[mt] = *(const u32x2*)(p.proj + (tok0 + 16 * mt + fr) * PROJ_LD + 2048 + g * 16 + 4 * fq);
    }
}
template <int PASS>
__device__ __forceinline__ void s5_unit(const Params& p, bf16_t* hs, const S5Task& T, const S5In& I, int g, long tok0, float& hr, float& hi, int lane, int fr, int fq) {
#pragma unroll
    for (int nt = 0; nt < 8; ++nt)
#pragma unroll
        for (int mt = 0; mt < 4; ++mt) {
            f32x4 d = (f32x4){0.f, 0.f, 0.f, 0.f};
            d = __builtin_amdgcn_mfma_f32_16x16x32_bf16(T.bfm[nt], I.uf[mt], d, 0, 0, 0);
            *(u32x2*)(hs + (16 * mt + fr) * CLD + 16 * nt + 4 * fq) = (u32x2){pack2(d[0], d[1]), pack2(d[2], d[3])};
        }
    WAVE_SYNC();
    const float ar = T.ar, ai = T.ai;
#pragma unroll 8
    for (int j = 0; j < 64; ++j) {
        const float br = bf2f(hs[j * CLD + lane]), bi = bf2f(hs[j * CLD + 64 + lane]);
        const float nr = ar * hr - ai * hi + br, ni = ar * hi + ai * hr + bi;
        hr = nr; hi = ni;
        if (PASS == 2) { hs[j * CLD + lane] = f2bf(hr); hs[j * CLD + 64 + lane] = f2bf(hi); }
    }
    if (PASS == 2) {
        WAVE_SYNC();
        f32x4 acc[4];
#pragma unroll
        for (int mt = 0; mt < 4; ++mt) acc[mt] = (f32x4){0.f, 0.f, 0.f, 0.f};
#pragma unroll
        for (int k4 = 0; k4 < 4; ++k4)
#pragma unroll
            for (int mt = 0; mt < 4; ++mt) {
                const bf16x8 hf = *(const bf16x8*)(hs + (16 * mt + fr) * CLD + k4 * 32 + fq * 8);
                acc[mt] = __builtin_amdgcn_mfma_f32_16x16x32_bf16(T.cf[k4], hf, acc[mt], 0, 0, 0);
            }
#pragma unroll
        for (int mt = 0; mt < 4; ++mt) {
            const int j = 16 * mt + fr;
            const u32x2 uu = I.uu[mt];
            const float y0 = acc[mt][0] + T.dsk[0] * bf2f((bf16_t)(uu[0] & 0xffff)), y1 = acc[mt][1] + T.dsk[1] * bf2f((bf16_t)(uu[0] >> 16));
            const float y2 = acc[mt][2] + T.dsk[2] * bf2f((bf16_t)(uu[1] & 0xffff)), y3 = acc[mt][3] + T.dsk[3] * bf2f((bf16_t)(uu[1] >> 16));
            *(u32x2*)(p.ygelu + (tok0 + j) * 512 + g * 16 + 4 * fq) = (u32x2){pack2(gelu_tanh(y0), gelu_tanh(y1)), pack2(gelu_tanh(y2), gelu_tanh(y3))};
        }
    }
    WAVE_SYNC();
}
template <int PASS>
__device__ __forceinline__ void phase_s5_pass(const Params& p, int blk0) {
    const int t = TID(), lane = t & 63, w = t >> 6, fr = lane & 15, fq = lane >> 4;
    bf16_t* hs = (bf16_t*)(LDS_BASE() + w * (64 * CLD * 2));
    constexpr int S5_NSEG = PASS == 1 ? S5_NSEG1 : S5_NSEG2, S5_CPS = NCH / S5_NSEG;
    const int ntasks = NB_ * 32 * S5_NSEG;
    if ((int)blockIdx.x < blk0) return;
    for (int bt = (int)blockIdx.x - blk0; bt < ntasks / NW; bt += (int)gridDim.x - blk0) {
        const int task = bt * NW + w;
        const int g = task & 31, seg = (task >> 5) % S5_NSEG, b = task / (32 * S5_NSEG);
        S5Task T; s5_task_init<PASS>(p, T, g, lane, fr, fq);
        const int c0 = seg * S5_CPS;
        S5In IA, IB;
        s5_load<PASS>(p, IA, g, ((long)b * NCH + c0) * 64, fr, fq);
        float hr = 0.f, hi = 0.f;
        if (PASS == 2 && S5_CARRY) {
            const float a64r = p.s5a64[(g * 64 + lane) * 2], a64i = p.s5a64[(g * 64 + lane) * 2 + 1];
            const long base = ((long)b * NCH * 32 + g) * 64 + lane;
            constexpr int CG = S5_CPS >= 8 ? 8 : S5_CPS;
#pragma unroll 1
            for (int c8 = 0; c8 < c0; c8 += CG) {
                float lr[CG], li[CG];
#pragma unroll
                for (int k = 0; k < CG; ++k) { lr[k] = p.s5loc[(base + (long)(c8 + k) * 2048) * 2]; li[k] = p.s5loc[(base + (long)(c8 + k) * 2048) * 2 + 1]; }
#pragma unroll
                for (int k = 0; k < CG; ++k) {
                    float nr = fmaf(a64r, hr, lr[k]), ni = fmaf(a64r, hi, li[k]);
                    CARRY_PIN(nr, ni);
                    nr = fmaf(-a64i, hi, nr); ni = fmaf(a64i, hr, ni);
                    CARRY_PIN(nr, ni);
                    hr = nr; hi = ni;
                }
            }
        }
#pragma unroll 1
        for (int c = c0; c < c0 + S5_CPS; c += 2) {
            const long tokA = ((long)b * NCH + c) * 64, tokB = tokA + 64;
            s5_load<PASS>(p, IB, g, tokB, fr, fq);
            if (PASS == 1) { hr = 0.f; hi = 0.f; }
            s5_unit<PASS>(p, hs, T, IA, g, tokA, hr, hi, lane, fr, fq);
            if (PASS == 1) { const long unit = ((long)b * NCH + c) * 32 + g; p.s5loc[(unit * 64 + lane) * 2] = hr; p.s5loc[(unit * 64 + lane) * 2 + 1] = hi; hr = 0.f; hi = 0.f; }
            if (c + 2 < c0 + S5_CPS) s5_load<PASS>(p, IA, g, tokB + 64, fr, fq);
            s5_unit<PASS>(p, hs, T, IB, g, tokB, hr, hi, lane, fr, fq);
            if (PASS == 1) { const long unit = ((long)b * NCH + c + 1) * 32 + g; p.s5loc[(unit * 64 + lane) * 2] = hr; p.s5loc[(unit * 64 + lane) * 2 + 1] = hi; }
        }
    }
}

struct LnrRow { f32x4 xf[4]; u32x2 xh[4]; u32x2 mm[4]; };
template <bool F32IN>
__device__ __forceinline__ void lnr_load(const Params& p, LnrRow& R, const float* hin, const bf16_t* mixp, long tok, int lane) {
#pragma unroll
    for (int i = 0; i < 4; ++i) {
        const int k = 4 * lane + 256 * i;
        if (F32IN) R.xf[i] = NT_LOAD((const f32x4*)(hin + tok * DM + k)); else R.xh[i] = NT_LOAD((const u32x2*)(p.hb + tok * DM + k));
        R.mm[i] = NT_LOAD((const u32x2*)(mixp + tok * DM + k));
    }
}
template <bool F32IN>
__device__ __forceinline__ void lnr_process(const Params& p, int layer, const LnrRow& R, const f32x4 (&gv)[4], const f32x4 (&bv)[4], const float* Wr,
                                            int* lcount, int* le, int* lrank, float* lgate, int lt, long tok, int lane, bool dry = false) {
    float h[16];
    float s = 0.f;
#pragma unroll
    for (int i = 0; i < 4; ++i) {
        f32x4 xv;
        if (F32IN) xv = R.xf[i];
        else { const u32x2 xx = R.xh[i]; xv = (f32x4){bf2f((bf16_t)(xx[0] & 0xffff)), bf2f((bf16_t)(xx[0] >> 16)), bf2f((bf16_t)(xx[1] & 0xffff)), bf2f((bf16_t)(xx[1] >> 16))}; }
        const u32x2 mm = R.mm[i];
        h[4 * i + 0] = ALPHA * xv[0] + bf2f((bf16_t)(mm[0] & 0xffff)); h[4 * i + 1] = ALPHA * xv[1] + bf2f((bf16_t)(mm[0] >> 16));
        h[4 * i + 2] = ALPHA * xv[2] + bf2f((bf16_t)(mm[1] & 0xffff)); h[4 * i + 3] = ALPHA * xv[3] + bf2f((bf16_t)(mm[1] >> 16));
        s += (h[4 * i] + h[4 * i + 1]) + (h[4 * i + 2] + h[4 * i + 3]);
    }
    const float mean = wave_sum(s) * (1.0f / DM);
    float q = 0.f;
#pragma unroll
    for (int e = 0; e < 16; ++e) { const float d = h[e] - mean; q += d * d; }
    const float rstd = rsqrtf(wave_sum(q) * (1.0f / DM) + LN_EPS);
#pragma unroll
    for (int i = 0; i < 4; ++i) {
        const int k = 4 * lane + 256 * i;
#pragma unroll
        for (int e = 0; e < 4; ++e) h[4 * i + e] = (h[4 * i + e] - mean) * rstd * gv[i][e] + bv[i][e];
        if (!dry) NT_STORE((u32x2*)(p.hb + tok * DM + k), ((u32x2){pack2(h[4 * i], h[4 * i + 1]), pack2(h[4 * i + 2], h[4 * i + 3])}));
        else NT_STORE((u32x2*)(p.H + tok * DM + k), ((u32x2){pack2(h[4 * i], h[4 * i + 1]), pack2(h[4 * i + 2], h[4 * i + 3])}));
    }
    float gl[4];
#pragma unroll
    for (int n = 0; n < 4; ++n) {
        float a = 0.f;
#pragma unroll
        for (int i = 0; i < 4; ++i) { const f32x4 wv = *(const f32x4*)(Wr + n * 1024 + 4 * lane + 256 * i); a += h[4 * i] * wv[0] + h[4 * i + 1] * wv[1] + h[4 * i + 2] * wv[2] + h[4 * i + 3] * wv[3]; }
        gl[n] = a;
    }
#pragma unroll
    for (int o = 32; o > 0; o >>= 1)
#pragma unroll
        for (int n = 0; n < 4; ++n) gl[n] += __shfl_xor(gl[n], o);
#pragma unroll
    for (int n = 0; n < 4; ++n) gl[n] += p.rgb[layer * 4 + n];
    int grp = 0; float gm = gl[0];
#pragma unroll
    for (int n = 1; n < 4; ++n) if (gl[n] > gm) { gm = gl[n]; grp = n; }
    float den = 0.f;
#pragma unroll
    for (int n = 0; n < 4; ++n) den += expf(gl[n] - gm);
    const float pg = 1.0f / den;
    float m1 = -3.0e38f, m2 = -3.0e38f; int i1 = 0, i2 = 0;
    float el8[8];
#pragma unroll
    for (int j = 0; j < 8; ++j) {
        const float* wrow = Wr + (long)(4 + grp * 8 + j) * 1024;
        float a = 0.f;
#pragma unroll
        for (int i = 0; i < 4; ++i) { const f32x4 wv = *(const f32x4*)(wrow + 4 * lane + 256 * i); a += h[4 * i] * wv[0] + h[4 * i + 1] * wv[1] + h[4 * i + 2] * wv[2] + h[4 * i + 3] * wv[3]; }
        el8[j] = a;
    }
#pragma unroll
    for (int o = 32; o > 0; o >>= 1)
#pragma unroll
        for (int j = 0; j < 8; ++j) el8[j] += __shfl_xor(el8[j], o);
#pragma unroll
    for (int j = 0; j < 8; ++j) {
        const float el = el8[j] + p.reb[layer * 32 + grp * 8 + j];
        if (el > m1) { m2 = m1; i2 = i1; m1 = el; i1 = j; } else if (el > m2) { m2 = el; i2 = j; }
    }
    if (lane == 0) {
        const float g1 = 1.0f / (1.0f + expf(m2 - m1));
        const int e0 = grp * 8 + i1, e1 = grp * 8 + i2;
        le[lt * 2] = e0; le[lt * 2 + 1] = e1; lgate[lt * 2] = pg * g1; lgate[lt * 2 + 1] = pg * (1.0f - g1);
        lrank[lt * 2] = atomicAdd(&lcount[e0], 1); lrank[lt * 2 + 1] = atomicAdd(&lcount[e1], 1);
    }
}
__device__ __forceinline__ void phase_ln_router(const Params& p, int layer, const float* hin, const bf16_t* mixp, bool dry = false) {
    float* Wr = (float*)LDS_BASE();
    int* li = (int*)(LDS_BASE() + 36 * 1024 * 4);
    int* lcount = li; int* lbase = li + 32; int* le = li + 64; int* lrank = li + 64 + 128; float* lgate = (float*)(li + 64 + 256);
    const int t = TID(), lane = t & 63, w = t >> 6;
    f32x4 gv[4], bv[4];
#pragma unroll
    for (int i = 0; i < 4; ++i) { gv[i] = *(const f32x4*)(p.lnmg + layer * DM + 4 * lane + 256 * i); bv[i] = *(const f32x4*)(p.lnmb + layer * DM + 4 * lane + 256 * i); }
    { const f32x4* src = (const f32x4*)(p.WrT + (long)layer * 36 * 1024); f32x4* dst = (f32x4*)Wr;
#pragma unroll
      for (int r = 0; r < 2; ++r) {
          f32x4 v[9];
#pragma unroll
          for (int j = 0; j < 9; ++j) v[j] = src[t + NTHREADS * (9 * r + j)];
#pragma unroll
          for (int j = 0; j < 9; ++j) dst[t + NTHREADS * (9 * r + j)] = v[j];
      } }
    for (int bb = blockIdx.x; bb < NT / 64; bb += gridDim.x) {
        __syncthreads();
        if (t < 32) lcount[t] = 0;
        __syncthreads();
        {
            const long tokb = (long)bb * 64 + w * (64 / NW);
            LnrRow RA, RB;
            if (hin) lnr_load<true>(p, RA, hin, mixp, tokb, lane); else lnr_load<false>(p, RA, hin, mixp, tokb, lane);
#pragma unroll 1
            for (int it = 0; it < 64 / NW; it += 2) {
                const long tn = tokb + (it + 2 < 64 / NW ? it + 2 : it + 1);
                if (hin) {
                    lnr_load<true>(p, RB, hin, mixp, tokb + it + 1, lane);
                    lnr_process<true>(p, layer, RA, gv, bv, Wr, lcount, le, lrank, lgate, w * (64 / NW) + it, tokb + it, lane, dry);
                    lnr_load<true>(p, RA, hin, mixp, tn, lane);
                    lnr_process<true>(p, layer, RB, gv, bv, Wr, lcount, le, lrank, lgate, w * (64 / NW) + it + 1, tokb + it + 1, lane, dry);
                } else {
                    lnr_load<false>(p, RB, hin, mixp, tokb + it + 1, lane);
                    lnr_process<false>(p, layer, RA, gv, bv, Wr, lcount, le, lrank, lgate, w * (64 / NW) + it, tokb + it, lane, dry);
                    lnr_load<false>(p, RA, hin, mixp, tn, lane);
                    lnr_process<false>(p, layer, RB, gv, bv, Wr, lcount, le, lrank, lgate, w * (64 / NW) + it + 1, tokb + it + 1, lane, dry);
                }
            }
        }
        __syncthreads();
        if (t < 32) lbase[t] = (lcount[t] > 0 && !dry) ? atomicAdd(p.cnt + layer * 32 + t, lcount[t]) : 0;
        __syncthreads();
        if (t < 128 && !dry) {
            const int e = le[t], pos = lbase[e] + lrank[t]; const long tok = (long)bb * 64 + (t >> 1);
            p.tok_e[tok * 2 + (t & 1)] = e; p.tok_pos[tok * 2 + (t & 1)] = pos; p.tok_gate[tok * 2 + (t & 1)] = lgate[t];
            WT_STORE_I(p.list + (long)e * LIST_CAP + pos, (int)tok); WT_STORE_F(p.list_gate + (long)e * LIST_CAP + pos, lgate[t]);
        }
    }
}

__device__ __forceinline__ void moe_map(const Params& p, int layer, int* ustart, int* rbase, int* cntl, int npn) {
    __syncthreads();
    if (TID() < 64) {
        const int l_ = TID(), e = l_ & 31;
        const int c = l_ < 32 ? p.cnt[layer * 32 + e] : 0;
        const int tiles = ((c + 255) >> 8) * npn;
        int us = tiles, rb = c;
#pragma unroll
        for (int o = 1; o < 32; o <<= 1) { const int a = __shfl_up(us, o), b = __shfl_up(rb, o); if ((l_ & 31) >= o) { us += a; rb += b; } }
        if (l_ < 32) { ustart[e] = us - tiles; rbase[e] = rb - c; cntl[e] = c; if (e == 31) { ustart[32] = us; rbase[32] = rb; } }
    }
    __syncthreads();
}
constexpr int MAP_OFF = 131072;

__device__ __forceinline__ void phase_moe_gather(const Params& p, int layer) {
    int* ustart = (int*)(LDS_BASE() + MAP_OFF); int* rbase = ustart + 33; int* cntl = rbase + 33;
    moe_map(p, layer, ustart, rbase, cntl, 4);
    const int lane = TID() & 63, gw = blockIdx.x * NW + (TID() >> 6), nw = gridDim.x * NW, total = rbase[32];
    for (int s = gw; s < total; s += nw) {
        int e = 0; while (rbase[e + 1] <= s) ++e;
        const int pos = s - rbase[e]; const long tok = p.list[(long)e * LIST_CAP + pos];
        const u32x4 v0 = *(const u32x4*)(p.hb + tok * DM + lane * 8), v1 = *(const u32x4*)(p.hb + tok * DM + 512 + lane * 8);
        *(u32x4*)(p.Xg + (long)s * DM + lane * 8) = v0; *(u32x4*)(p.Xg + (long)s * DM + 512 + lane * 8) = v1;
        if (lane == 0) p.slot_gate[s] = p.list_gate[(long)e * LIST_CAP + pos];
    }
}

__device__ __forceinline__ void phase_moe1(const Params& p, int layer) {
    int* ustart = (int*)(LDS_BASE() + MAP_OFF); int* rbase = ustart + 33; int* cntl = rbase + 33;
    moe_map(p, layer, ustart, rbase, cntl, 4);
    pg8::MoeOrder S{ustart, rbase, cntl, (int)gridDim.x, (int)blockIdx.x, 4, 1024};
    pg8::gemm_phase<pg8::EpiMoe1, pg8::MoeOrder, true>((PG8_LAS unsigned char*)LDS_BASE(), p.hb, p.WguT, 1024, S, pg8::EpiMoe1{p.H}, p.list);
}
__device__ __forceinline__ void phase_moe2(const Params& p, int layer) {
    int* ustart = (int*)(LDS_BASE() + MAP_OFF); int* rbase = ustart + 33; int* cntl = rbase + 33;
    moe_map(p, layer, ustart, rbase, cntl, 4);
    pg8::MoeOrder S{ustart, rbase, cntl, (int)gridDim.x, (int)blockIdx.x, 4, 1024};
    pg8::gemm_phase<pg8::EpiMoe2, pg8::MoeOrder>((PG8_LAS unsigned char*)LDS_BASE(), p.H, p.WdT, EFF, S, pg8::EpiMoe2{p.Y, p.list_gate});
}

__device__ __forceinline__ void phase_ln_ffn(const Params& p, int layer, bool write_hb, bool dry = false) {
    int* ustart = (int*)(LDS_BASE() + MAP_OFF); int* rbase = ustart + 33; int* cntl = rbase + 33;
    moe_map(p, layer, ustart, rbase, cntl, 4);
    const int lane = TID() & 63, gw = blockIdx.x * NW + (TID() >> 6), nw = gridDim.x * NW;
    const float* gam = p.lnfg + layer * DM; const float* bet = p.lnfb + layer * DM;
    for (int tok = gw; tok < NT; tok += nw) {
        const long s0 = rbase[p.tok_e[(long)tok * 2]] + p.tok_pos[(long)tok * 2], s1 = rbase[p.tok_e[(long)tok * 2 + 1]] + p.tok_pos[(long)tok * 2 + 1];
        float h[16]; float s = 0.f;
#pragma unroll
        for (int i = 0; i < 4; ++i) {
            const int k = 4 * lane + 256 * i;
            const u32x2 xx = NT_LOAD((const u32x2*)(p.hb + (long)tok * DM + k));
            const f32x4 xv = (f32x4){bf2f((bf16_t)(xx[0] & 0xffff)), bf2f((bf16_t)(xx[0] >> 16)), bf2f((bf16_t)(xx[1] & 0xffff)), bf2f((bf16_t)(xx[1] >> 16))};
            const u32x2 ya = NT_LOAD((const u32x2*)(p.Y + s0 * DM + k)), yb = NT_LOAD((const u32x2*)(p.Y + s1 * DM + k));
            h[4 * i + 0] = ALPHA * xv[0] + (bf2f((bf16_t)(ya[0] & 0xffff)) + bf2f((bf16_t)(yb[0] & 0xffff)));
            h[4 * i + 1] = ALPHA * xv[1] + (bf2f((bf16_t)(ya[0] >> 16)) + bf2f((bf16_t)(yb[0] >> 16)));
            h[4 * i + 2] = ALPHA * xv[2] + (bf2f((bf16_t)(ya[1] & 0xffff)) + bf2f((bf16_t)(yb[1] & 0xffff)));
            h[4 * i + 3] = ALPHA * xv[3] + (bf2f((bf16_t)(ya[1] >> 16)) + bf2f((bf16_t)(yb[1] >> 16)));
            s += (h[4 * i] + h[4 * i + 1]) + (h[4 * i + 2] + h[4 * i + 3]);
        }
        const float mean = wave_sum(s) * (1.0f / DM);
        float q = 0.f;
#pragma unroll
        for (int e = 0; e < 16; ++e) { const float d = h[e] - mean; q += d * d; }
        const float rstd = rsqrtf(wave_sum(q) * (1.0f / DM) + LN_EPS);
#pragma unroll
        for (int i = 0; i < 4; ++i) {
            const int k = 4 * lane + 256 * i;
            const f32x4 gv = *(const f32x4*)(gam + k), bv = *(const f32x4*)(bet + k);
#pragma unroll
            for (int e = 0; e < 4; ++e) h[4 * i + e] = (h[4 * i + e] - mean) * rstd * gv[e] + bv[e];
            if (dry) *(u32x2*)(p.H + (long)tok * DM + k) = (u32x2){pack2(h[4 * i], h[4 * i + 1]), pack2(h[4 * i + 2], h[4 * i + 3])};
            else if (write_hb) NT_STORE((u32x2*)(p.hb + (long)tok * DM + k), ((u32x2){pack2(h[4 * i], h[4 * i + 1]), pack2(h[4 * i + 2], h[4 * i + 3])}));
            else NT_STORE((f32x4*)(p.out + (long)tok * DM + k), ((f32x4){h[4 * i], h[4 * i + 1], h[4 * i + 2], h[4 * i + 3]}));
        }
    }
}


typedef float f32x16 __attribute__((ext_vector_type(16)));
typedef short s16x4 __attribute__((ext_vector_type(4)));
__device__ __forceinline__ s16x4 lds_tr_read(const bf16_t* p) {
#ifdef EMU
    return emu_ds_read_tr16_b64(p);
#else
    typedef short v4i16_t __attribute__((ext_vector_type(4)));
    return __builtin_bit_cast(s16x4, __builtin_amdgcn_ds_read_tr16_b64_v4i16((__attribute__((address_space(3))) v4i16_t*)p));
#endif
}
constexpr int KLD = 72;
struct AttnUnit { int c, d, r, grp, tpr, Ld, h, b; };
__device__ __forceinline__ AttnUnit attn_decode(int u, int g0, int g1, int g2) {
    constexpr int TPB = NS_ / 32;
    const int gper = g0 + g1 + g2; int gi = u % gper; const int bh = u / gper;
    AttnUnit a; a.h = bh & 15; a.b = bh >> 4;
    if (gi < g0) { a.c = 0; a.d = 1; } else if (gi < g0 + g1) { a.c = 1; a.d = 4; gi -= g0; } else { a.c = 2; a.d = 16; gi -= g0 + g1; }
    a.tpr = TPB / a.d; const int gpr = (a.tpr + 7) / 8; a.r = gi / gpr; a.grp = gi % gpr; a.Ld = NS_ / a.d;
    return a;
}
__device__ __forceinline__ void attn_loads(const Params& p, const AttnUnit& a, int t, int w, int q, int hh, u32x4 (&kr)[6], u32x4 (&vr)[6], bf16x8 (&qf)[4]) {
    const long tb = (long)a.b * NS_; const int M0 = 256 * a.grp;
#pragma unroll
    for (int i = 0; i < 6; ++i) {
        const int id = t + 512 * i, row = id >> 3, ch = (id & 7) * 8;
        int mk = M0 - 128 + row; mk = mk < 0 ? 0 : (mk >= a.Ld ? a.Ld - 1 : mk);
        const bf16_t* src = p.qkv + (tb + (long)mk * a.d + a.r) * 3072 + 1024 + a.h * 64 + ch;
        kr[i] = *(const u32x4*)src; vr[i] = *(const u32x4*)(src + 1024);
    }
    const int mt = 8 * a.grp + w, mtc = mt < a.tpr ? mt : a.tpr - 1;
    const long tokq = tb + (long)(32 * mtc + q) * a.d + a.r;
#pragma unroll
    for (int s = 0; s < 4; ++s) qf[s] = *(const bf16x8*)(p.qkv + tokq * 3072 + a.h * 64 + 16 * s + 8 * hh);
}
__device__ __forceinline__ void phase_attn(const Params& p) {
    constexpr int TPB = NS_ / 32;
    const int t = TID(), lane = t & 63, w = t >> 6, q = lane & 31, hh = lane >> 5;
    bf16_t* Ks = (bf16_t*)LDS_BASE(); bf16_t* Vs = Ks + 384 * KLD;
    const int g0 = (TPB + 7) / 8, g1 = 4 * ((TPB / 4 + 7) / 8), g2 = 16 * ((TPB / 16 + 7) / 8), gper = g0 + g1 + g2;
    const int nunits = NB_ * 16 * gper;
    const float C = 0.125f * 1.4426950408889634f;
    u32x4 kr[6], vr[6]; bf16x8 qn[4];
    const int G = (int)gridDim.x, nbh = NB_ * 16;
#ifndef ATTN_XCD
#define ATTN_XCD 1
#endif
    const bool xcdmap = ATTN_XCD && (G % 8 == 0) && (nbh % 8 == 0);
    const int xcd = (int)blockIdx.x & 7, lb = (int)blockIdx.x >> 3, nlb = G >> 3, nloc = (nbh / 8) * gper;
    const int nit = xcdmap ? (nloc + nlb - 1) / nlb : (nunits + G - 1) / G;
#define ATTN_UNIT_OF(it_) (xcdmap ? (((it_) * nlb + lb) < nloc ? ((((it_) * nlb + lb) / gper) * 8 + xcd) * gper + (((it_) * nlb + lb) % gper) : -1) \
                                  : (((it_) * G + (int)blockIdx.x) < nunits ? ((it_) * G + (int)blockIdx.x) : -1))
    { const int u0 = ATTN_UNIT_OF(0); if (u0 >= 0) { const AttnUnit a0 = attn_decode(u0, g0, g1, g2); attn_loads(p, a0, t, w, q, hh, kr, vr, qn); } }
    for (int it = 0; it < nit; ++it) {
        const int u = ATTN_UNIT_OF(it); if (u < 0) break;
        const AttnUnit a = attn_decode(u, g0, g1, g2);
        const int c = a.c, d = a.d, r = a.r, h = a.h, tpr = a.tpr;
        const int mt = 8 * a.grp + w;
        const long tb = (long)a.b * NS_;
        LDS_BARRIER();
#pragma unroll
        for (int i = 0; i < 6; ++i) {
            const int id = t + 512 * i, row = id >> 3, ch = (id & 7) * 8;
            *(u32x4*)(Ks + row * KLD + ch) = kr[i]; *(u32x4*)(Vs + row * KLD + ch) = vr[i];
        }
        bf16x8 qf[4];
#pragma unroll
        for (int s = 0; s < 4; ++s) qf[s] = qn[s];
        const bool active = mt < tpr;
        const int mtc = active ? mt : tpr - 1;
        const long tokq = tb + (long)(32 * mtc + q) * d + r;
        LDS_BARRIER();
        { const int un = (it + 1 < nit) ? ATTN_UNIT_OF(it + 1) : -1; if (un >= 0) { const AttnUnit an = attn_decode(un, g0, g1, g2); attn_loads(p, an, t, w, q, hh, kr, vr, qn); } }
        if (active) {
            f32x16 sc[5];
#pragma unroll
            for (int j = 0; j < 5; ++j) {
                const int mk0 = 32 * mt - 128 + 32 * j;
                if (mk0 >= 0) {
                    const bf16_t* kp = Ks + (32 * (w + j) + q) * KLD + 8 * hh;
                    f32x16 acc;
#pragma unroll
                    for (int i = 0; i < 16; ++i) acc[i] = 0.f;
#pragma unroll
                    for (int s = 0; s < 4; ++s) acc = __builtin_amdgcn_mfma_f32_32x32x16_bf16(*(const bf16x8*)(kp + 16 * s), qf[s], acc, 0, 0, 0);
                    sc[j] = acc;
                } else {
#pragma unroll
                    for (int i = 0; i < 16; ++i) sc[j][i] = -1.0e30f;
                }
            }
            float mx = -1.0e30f;
#pragma unroll
            for (int j = 0; j < 5; ++j)
#pragma unroll
                for (int i = 0; i < 16; ++i) {
                    const int kk = (i & 3) + 8 * (i >> 2) + 4 * hh;
                    if (j == 0) { if (kk < q) sc[j][i] = -1.0e30f; }
                    if (j == 4) { if (kk > q) sc[j][i] = -1.0e30f; }
                    mx = fmaxf(mx, sc[j][i]);
                }
            mx = fmaxf(mx, __shfl_xor(mx, 32));
            const float nmx = -mx * C;
            mx = mx * C;
            float l = 0.f;
#pragma unroll
            for (int j = 0; j < 5; ++j)
#pragma unroll
                for (int i = 0; i < 16; ++i) { const float e = __builtin_amdgcn_exp2f(fmaf(sc[j][i], C, nmx)); sc[j][i] = e; l += e; }
            l += __shfl_xor(l, 32);
            f32x16 o[2];
#pragma unroll
            for (int i = 0; i < 16; ++i) { o[0][i] = 0.f; o[1][i] = 0.f; }
#pragma unroll
            for (int j = 0; j < 5; ++j) {
                const int mk0 = 32 * mt - 128 + 32 * j;
                if (mk0 >= 0) {
#pragma unroll
                    for (int s = 0; s < 2; ++s) {
                        const unsigned w0 = pack2(sc[j][8 * s + 0], sc[j][8 * s + 1]), w1 = pack2(sc[j][8 * s + 2], sc[j][8 * s + 3]);
                        const unsigned w2 = pack2(sc[j][8 * s + 4], sc[j][8 * s + 5]), w3 = pack2(sc[j][8 * s + 6], sc[j][8 * s + 7]);
                        const bf16x8 pa = __builtin_bit_cast(bf16x8, (u32x4){w0, w1, w2, w3});
#pragma unroll
                        for (int db = 0; db < 2; ++db) {
                            const bf16_t* vp = Vs + (32 * (w + j) + 16 * s + 4 * hh + ((lane & 15) >> 2)) * KLD + 32 * db + 16 * ((lane >> 4) & 1) + 4 * (lane & 3);
                            const s16x4 lo = lds_tr_read(vp), hi = lds_tr_read(vp + 8 * KLD);
                            const bf16x8 vb = (bf16x8){lo[0], lo[1], lo[2], lo[3], hi[0], hi[1], hi[2], hi[3]};
                            o[db] = __builtin_amdgcn_mfma_f32_32x32x16_bf16(vb, pa, o[db], 0, 0, 0);
                        }
                    }
                }
            }
            bf16_t* ob = p.obr[c] + tokq * 1024 + h * 64 + 4 * hh;
#pragma unroll
            for (int db = 0; db < 2; ++db)
#pragma unroll
                for (int cq = 0; cq < 4; ++cq)
                    *(u32x2*)(ob + 32 * db + 8 * cq) = (u32x2){pack2(o[db][4 * cq], o[db][4 * cq + 1]), pack2(o[db][4 * cq + 2], o[db][4 * cq + 3])};
            if (hh == 0) { float* st = p.ost + ((long)c * NT + tokq) * 32 + h * 2; WT_STORE_F2(st, mx, l); }
        }
    }
}

__device__ __forceinline__ void phase_attn_merge(const Params& p) {
    const long gtid = (long)blockIdx.x * NTHREADS + TID(), gsz = (long)gridDim.x * NTHREADS;
    for (long idx = gtid; idx < (long)NT * 16 * 8; idx += gsz) {
        const long th = idx >> 3; const int ch = (int)(idx & 7);
        const long tok = th >> 4; const int h = (int)(th & 15);
        float m[3], l[3];
#pragma unroll
        for (int c = 0; c < 3; ++c) { const float* st = p.ost + ((long)c * NT + tok) * 32 + h * 2; m[c] = st[0]; l[c] = st[1]; }
        const float M = fmaxf(m[0], fmaxf(m[1], m[2]));
        float wgt[3], den = 0.f;
#pragma unroll
        for (int c = 0; c < 3; ++c) { wgt[c] = __builtin_amdgcn_exp2f(m[c] - M); den += wgt[c] * l[c]; }
        const float inv = 1.0f / den;
        float acc[8];
#pragma unroll
        for (int e = 0; e < 8; ++e) acc[e] = 0.f;
#pragma unroll
        for (int c = 0; c < 3; ++c) {
            const u32x4 v = NT_LOAD((const u32x4*)(p.obr[c] + tok * 1024 + h * 64 + ch * 8));
#pragma unroll
            for (int e = 0; e < 4; ++e) { acc[2 * e] += wgt[c] * bf2f((bf16_t)(v[e] & 0xffff)); acc[2 * e + 1] += wgt[c] * bf2f((bf16_t)(v[e] >> 16)); }
        }
        *(u32x4*)(p.attno + tok * 1024 + h * 64 + ch * 8) = (u32x4){pack2(acc[0] * inv, acc[1] * inv), pack2(acc[2] * inv, acc[3] * inv), pack2(acc[4] * inv, acc[5] * inv), pack2(acc[6] * inv, acc[7] * inv)};
    }
}

constexpr int NPHASES = 19;
__device__ __forceinline__ void run_phase(const Params& p, int ph, const XcdBarrier& xb) {
    switch (ph) {
    case 0:
#if defined(P0_VARIANT)
        _Pragma("unroll 1") for (int rep = 0; rep < 2; ++rep) { phase_prologue(p); __syncthreads(); }
#else
        phase_prologue(p);
#endif
        __syncthreads(); phase_ba(p);
        break;
    case 1: gemm_dense(p.hb, p.WinT, NT, 2560, 1024, pg8::EpiStore{p.proj, 2560}); break;
    case 2:
#if !FUSE_PREP
        phase_gdn_prep(p);
#endif
        break;
    case 3:
#if defined(P3_VARIANT) && P3_VARIANT == 1
        _Pragma("unroll 1") for (int rep = 0; rep < 2; ++rep) { phase_gdn_chunk(p); __syncthreads(); }
        phase_s5_pass<1>(p, 0);
#elif defined(P3_VARIANT) && P3_VARIANT == 2
        phase_gdn_chunk(p); __syncthreads();
        _Pragma("unroll 1") for (int rep = 0; rep < 2; ++rep) { phase_s5_pass<1>(p, 0); __syncthreads(); }
#else
        phase_gdn_chunk(p); __syncthreads(); phase_s5_pass<1>(p, 0);
#endif
        break;
    case 4: {
        int nscan = NB_ * 16; if (nscan > (int)gridDim.x / 2) nscan = (int)gridDim.x / 2;
#if defined(P4_VARIANT) && P4_VARIANT == 1
        if ((int)blockIdx.x < nscan) { phase_gdn_scan(p, nscan); LDS_BARRIER(); phase_gdn_scan(p, nscan); } else phase_s5_pass<2>(p, nscan);
#elif defined(P4_VARIANT) && P4_VARIANT == 2
        if ((int)blockIdx.x < nscan) phase_gdn_scan(p, nscan); else { phase_s5_pass<2>(p, nscan); LDS_BARRIER(); phase_s5_pass<2>(p, nscan); }
#else
        if ((int)blockIdx.x < nscan) phase_gdn_scan(p, nscan); else phase_s5_pass<2>(p, nscan);
#endif
        break; }
    case 5: phase_gdn_post(p); __syncthreads(); gemm_dense(p.ygelu, p.WgluT, NT, 512, 512, pg8::EpiGlu{p.ygelu, p.ycat}); break;
    case 6: gemm_dense(p.ycat, p.WoutT, NT, 1024, 1024, pg8::EpiStore{p.mix, 1024}); __syncthreads(); transpose_tiles<3>(p.moejobs[0]);
#if defined(P6_VARIANT)
        __syncthreads(); transpose_tiles<3>(p.moejobs[0]);
#endif
        break;
    case 7:
#if defined(P7_VARIANT)
        phase_ln_router(p, 0, p.x, p.mix, true); __syncthreads();
#endif
        phase_ln_router(p, 0, p.x, p.mix); break;
    case 8: phase_moe1(p, 0); break;
    case 9: phase_moe2(p, 0); break;
    case 10:
#if defined(P11_VARIANT)
        phase_ln_ffn(p, 0, true, true); __syncthreads();
#endif
        phase_ln_ffn(p, 0, true); break;
    case 11: gemm_dense(p.hb, p.WqkvT, NT, 3072, 1024, pg8::EpiStore{p.qkv, 3072}); break;
    case 12: phase_attn(p); break;
    case 13: phase_attn_merge(p); break;
    case 14: gemm_dense(p.attno, p.WoutcT, NT, 1024, 1024, pg8::EpiStore{p.mix1, 1024}); __syncthreads(); transpose_tiles<3>(p.moejobs[1]); break;
    case 15: phase_ln_router(p, 1, nullptr, p.mix1); break;
    case 16: phase_moe1(p, 1); break;
    case 17: phase_moe2(p, 1); break;
    case 18: phase_ln_ffn(p, 1, false); break;
    default: break;
    }
}

#if N_LAUNCH_MODE == 0
template <int PH> __global__ void __launch_bounds__(NTHREADS, 2) k_ph(Params p) { XcdBarrier xb{}; run_phase(p, PH, xb); }
template <int PH> static void launch_from(const Params& p, int grid, hipStream_t stream, int maxph) {
    if constexpr (PH < NPHASES) {
        if (PH <= maxph) {
#ifdef EMU
            emu::launch(dim3(32), dim3(NTHREADS), LDS_BYTES, [=] { k_ph<PH>(p); }, false); fprintf(stderr, "phase %d done\n", PH);
#else
            hipFuncSetAttribute((const void*)k_ph<PH>, hipFuncAttributeMaxDynamicSharedMemorySize, LDS_BYTES);
            hipLaunchKernelGGL(k_ph<PH>, dim3(grid), dim3(NTHREADS), LDS_BYTES, stream, p);
#endif
        }
        launch_from<PH + 1>(p, grid, stream, maxph);
    }
}
#else
template <int PH> __device__ __forceinline__ void mega_from(const Params& p, const XcdBarrier& xb) {
    if constexpr (PH < NPHASES && FUSE_PREP && PH == 2) { mega_from<PH + 1>(p, xb); }
    else if constexpr (PH < NPHASES) {
        run_phase(p, PH, xb);
#ifdef PROBE_MASK
        if constexpr (((PROBE_MASK) >> PH) & 1) { GRID_SYNC(); run_phase(p, PH, xb); }
#endif
        if constexpr (PH == 0) { GRID_SYNC_CG(); }
        else if constexpr (PH + 1 < NPHASES) { GRID_SYNC(); }
        mega_from<PH + 1>(p, xb);
    }
}
__global__ void __launch_bounds__(NTHREADS, 2) k_mega(Params p) {
#ifdef EMU
    XcdBarrier xb{0};
#else
    volatile XB_LAS unsigned* st = (volatile XB_LAS unsigned*)(lds_raw + XB_ST_OFF);
    if (threadIdx.x == 0) { st[0] = 0u; st[1] = 0u; }
    __syncthreads();
    const XcdBarrier xb = xcd_barrier_post(p.bar, st);
#endif
    mega_from<0>(p, xb);
}
#endif

#ifdef EMU
Params g_emu_params;
#endif

static inline size_t al256(size_t x) { return (x + 255) & ~(size_t)255; }

extern "C" void kernel_launch(void* const* d_in, const int* in_sizes, int n_in, void* d_out, int out_size, void* d_ws, size_t ws_size, hipStream_t stream) {
    Params p; memset(&p, 0, sizeof(p));
    const float* const* in = (const float* const*)d_in;
    p.x = in[0]; p.w_in = in[1]; p.conv = in[2]; p.a_log = in[3]; p.dt_bias = in[4]; p.gnorm = in[5]; p.lam_re = in[6]; p.lam_im = in[7]; p.log_dt = in[8];
    p.b_re = in[9]; p.b_im = in[10]; p.c_re = in[11]; p.c_im = in[12]; p.s5d = in[13]; p.wglu = in[14]; p.wout = in[15]; p.wqkv = in[16]; p.woutc = in[17];
    p.lnmg = in[18]; p.lnmb = in[19]; p.rgw = in[20]; p.rgb = in[21]; p.rew = in[22]; p.reb = in[23]; p.mg = in[24]; p.mu = in[25]; p.md = in[26]; p.lnfg = in[27]; p.lnfb = in[28];
    p.out = (float*)d_out;
    char* ws = (char*)d_ws; size_t off = 0;
    auto take = [&](size_t bytes) { char* r = ws + off; off += al256(bytes); return r; };
    p.WinT = (bf16_t*)take((size_t)2560 * 1024 * 2); p.WoutT = (bf16_t*)take((size_t)1024 * 1024 * 2); p.WgluT = (bf16_t*)take((size_t)512 * 512 * 2);
    p.WqkvT = (bf16_t*)take((size_t)3072 * 1024 * 2); p.WoutcT = (bf16_t*)take((size_t)1024 * 1024 * 2);
    p.WrT = (float*)take((size_t)2 * 36 * 1024 * 4);
    p.s5a = (float*)take(2048 * 2 * 4); p.s5a64 = (float*)take(2048 * 2 * 4); p.s5bbr = (float*)take(2048 * 16 * 4); p.s5bbi = (float*)take(2048 * 16 * 4); p.s5cm = (bf16_t*)take(32 * 16 * 128 * 2); p.s5bbm = (bf16_t*)take(32 * 128 * 16 * 2);
    p.cnt = (int*)take(64 * 4);
    p.bar = (unsigned*)take(4096 * 4);
    p.tok_e = (int*)take((size_t)NT * 2 * 4); p.tok_pos = (int*)take((size_t)NT * 2 * 4); p.tok_gate = (float*)take((size_t)NT * 2 * 4);
    p.list = (int*)take((size_t)32 * LIST_CAP * 4); p.list_gate = (float*)take((size_t)32 * LIST_CAP * 4);
    char* hbreg = take((size_t)NT * 1024 * 2);
    p.hb = (bf16_t*)hbreg;
    p.go = (bf16_t*)hbreg;
    p.s5loc = (float*)(hbreg + (size_t)NT * 512 * 2); p.s5in = p.s5loc + (size_t)NB_ * NCH * 2048 * 2;
    char* moew = take((size_t)32 * 1024 * 1024 * 2 + (size_t)32 * 1024 * 512 * 2);
    p.WguT = (bf16_t*)moew; p.WdT = (bf16_t*)(moew + (size_t)32 * 1024 * 1024 * 2);
    p.gq = (bf16_t*)moew; p.gk = p.gq + (size_t)NT * 512; p.gv = p.gk + (size_t)NT * 512;
    p.ygelu = (bf16_t*)moew;
    char* ar = ws + off;
    size_t a = 0;
    auto atake = [&](size_t bytes) { char* r = ar + a; a += al256(bytes); return r; };
    p.proj = (bf16_t*)atake((size_t)NT * PROJ_LD * 2);
    char* chunk0 = ar + a;
    p.cU = (bf16_t*)atake((size_t)NT * 512 * 2); p.cW = (bf16_t*)atake((size_t)NT * 512 * 2); p.cQd = (bf16_t*)atake((size_t)NT * 512 * 2); p.cKdT = (bf16_t*)atake((size_t)NT * 512 * 2);
    p.cQK = (bf16_t*)atake((size_t)NT * 512 * 2); p.cgl = (float*)atake((size_t)NB_ * 4 * NCH * 4);
    p.gbeta = (float*)atake((size_t)NT * 4 * 4); p.gg = (float*)atake((size_t)NT * 4 * 4);
    size_t amax = a;
    p.ycat = (bf16_t*)chunk0;
    p.mix = (bf16_t*)ar;
    p.Xg = (bf16_t*)ar; p.Y = (bf16_t*)ar; p.H = (bf16_t*)(ar + al256((size_t)(2 * NT + 256) * DM * 2)); p.slot_gate = (float*)((char*)p.H + al256((size_t)(2 * NT + 256) * EFF * 2));
    { size_t e = al256((size_t)(2 * NT + 256) * DM * 2) + al256((size_t)(2 * NT + 256) * EFF * 2) + (size_t)2 * NT * 4; if (e > amax) amax = e; }
    p.qkv = (bf16_t*)ar; p.attno = (bf16_t*)ar; p.mix1 = (bf16_t*)(ar + (size_t)NT * 1024 * 2);
    p.obr[0] = (bf16_t*)(ar + al256((size_t)NT * 3072 * 2) + (size_t)NT * 1024 * 2); p.obr[1] = (bf16_t*)moew; p.ost = (float*)(moew + (size_t)NT * 1024 * 2); p.obr[2] = (bf16_t*)(ar + al256((size_t)NT * 3072 * 2));
    { size_t e = al256((size_t)NT * 3072 * 2) + (size_t)2 * NT * 1024 * 2; if (e > amax) amax = e; }
    if (off + amax > ws_size) { fprintf(stderr, "workspace too small: need %zu have %zu\n", off + amax, ws_size); return; }
    auto job = [](const float* src, bf16_t* dst, int K, int N, int ldsrc, int ldd, int rb, int rs, int roff, int batch, long sbs, long dbs) {
        TJob j; memset(&j, 0, sizeof(j)); j.src = src; j.dst = dst; j.K = K; j.N = N; j.ldsrc = ldsrc; j.ldd = ldd; j.rb = rb; j.rs = rs; j.roff = roff; j.batch = batch; j.sbs = sbs; j.dbs = dbs; return j; };
    p.jobs[0] = job(p.w_in, p.WinT, 1024, 2048, 2568, 1024, 2048, 0, 0, 1, 0, 0);
    p.jobs[1] = job(p.w_in + 2056, p.WinT + (size_t)2048 * 1024, 1024, 512, 2568, 1024, 512, 0, 0, 1, 0, 0);
    p.jobs[2] = job(p.wout, p.WoutT, 1024, 1024, 1024, 1024, 1024, 0, 0, 1, 0, 0);
    p.jobs[3] = job(p.wglu, p.WgluT, 512, 512, 512, 512, 512, 0, 0, 1, 0, 0);
    p.jobs[4] = job(p.wqkv, p.WqkvT, 1024, 3072, 3072, 1024, 3072, 0, 0, 1, 0, 0);
    p.jobs[5] = job(p.woutc, p.WoutcT, 1024, 1024, 1024, 1024, 1024, 0, 0, 1, 0, 0);
    p.njobs = 6;
    for (int l = 0; l < 2; ++l) {
        p.moejobs[l][0] = job(p.mg + (size_t)l * 32 * 1024 * 512, p.WguT, 1024, 512, 512, 1024, 128, 256, 0, 32, 1024L * 512, 1024L * 1024);
        p.moejobs[l][1] = job(p.mu + (size_t)l * 32 * 1024 * 512, p.WguT, 1024, 512, 512, 1024, 128, 256, 128, 32, 1024L * 512, 1024L * 1024);
        p.moejobs[l][2] = job(p.md + (size_t)l * 32 * 512 * 1024, p.WdT, 512, 1024, 1024, 512, 1024, 0, 0, 32, 512L * 1024, 1024L * 512);
    }
#ifdef EMU
    g_emu_params = p;
#if N_LAUNCH_MODE == 1
    emu::launch(dim3(16), dim3(NTHREADS), LDS_BYTES, [=] { k_mega(p); }, true);
#else
    { const char* e = getenv("EMU_MAXPHASE"); launch_from<0>(p, 64, stream, e ? atoi(e) : NPHASES - 1); }
#endif
#else
#if N_LAUNCH_MODE == 1
    static int grid_blocks = 0;
    if (!grid_blocks) {
        int dev = 0, cus = 0, per_cu = 0;
        (void)hipGetDevice(&dev); (void)hipDeviceGetAttribute(&cus, hipDeviceAttributeMultiprocessorCount, dev);
        (void)hipFuncSetAttribute((const void*)k_mega, hipFuncAttributeMaxDynamicSharedMemorySize, LDS_BYTES);
        (void)hipOccupancyMaxActiveBlocksPerMultiprocessor(&per_cu, k_mega, NTHREADS, LDS_BYTES);
        per_cu = 1;
        grid_blocks = cus * per_cu;
    }
    (void)hipMemsetAsync(p.bar, 0, 4096 * 4, stream);
    void* args[] = {(void*)&p};
    hipError_t e = hipLaunchCooperativeKernel((void*)k_mega, dim3(grid_blocks), dim3(NTHREADS), args, LDS_BYTES, stream);
    if (e != hipSuccess) fprintf(stderr, "cooperative launch failed: %s (grid %d)\n", hipGetErrorString(e), grid_blocks);
#else
    launch_from<0>(p, 256, stream, NPHASES - 1);
#endif
#endif
}
```

```cpp
#ifndef EMU
#include <hip/hip_runtime.h>
#include <hip/hip_cooperative_groups.h>
#endif
#include <cstdint>
#include <cstdio>
#include <cmath>
#include <cstring>
#include <cstdlib>

#ifndef CFG_BATCH
#define CFG_BATCH 8
#endif
#ifndef CFG_SEQ
#define CFG_SEQ 4096
#endif
#ifndef N_LAUNCH_MODE
#define N_LAUNCH_MODE 1
#endif

typedef unsigned short bf16_t;
typedef short bf16x8 __attribute__((ext_vector_type(8)));
typedef float f32x4 __attribute__((ext_vector_type(4)));
typedef unsigned u32x4 __attribute__((ext_vector_type(4)));
typedef unsigned u32x2 __attribute__((ext_vector_type(2)));

constexpr int NB_ = CFG_BATCH, NS_ = CFG_SEQ, NT = NB_ * NS_, DM = 1024;
constexpr int NCH = NS_ / 64;
constexpr int PROJ_LD = 2560;
constexpr int NEXP = 32, EFF = 512;
constexpr int LIST_CAP = NT * 2;
constexpr float ALPHA = 1.41421356237f;
constexpr float LN_EPS = 1e-5f;
constexpr int NTHREADS = 512, NW = 8;
constexpr int LDS_BYTES = 160 * 1024;

#ifdef EMU
#define LDS_BASE() (emu::cur->blk->smem)
#define GRID_SYNC_CG() emu::grid_sync()
#define GRID_SYNC() emu::grid_sync()
struct XcdBarrier { int dummy; };
#else
extern __shared__ __attribute__((aligned(16))) char lds_raw[];
#define LDS_BASE() (lds_raw)
#define GRID_SYNC_CG() cooperative_groups::this_grid().sync()
#define GRID_SYNC() xcd_barrier(xb)
#define XB_TMO      128
#define XB_XCNT(j)  (256  + 64 * (j))
#define XB_XSUB(j)  (1280 + 64 * (j))
#define XB_XGEN(j)  (2304 + 64 * (j))
#define XB_TOP      3328
#define XB_TOPGEN   3392
#define XCD_BAR_WORDS 3456
#define XB_SPIN_CAP (1u << 18)
#define XB_LAS __attribute__((address_space(3)))
#define XB_ACQUIRE() __builtin_amdgcn_fence(__ATOMIC_ACQUIRE, "agent")
__device__ __forceinline__ unsigned xb_ld(unsigned* p)              { return __hip_atomic_load(p, __ATOMIC_RELAXED, __HIP_MEMORY_SCOPE_AGENT); }
__device__ __forceinline__ unsigned xb_add(unsigned* p, unsigned v) { return __hip_atomic_fetch_add(p, v, __ATOMIC_RELAXED, __HIP_MEMORY_SCOPE_AGENT); }
__device__ __forceinline__ unsigned xb_xcc_id() { return (unsigned)__builtin_amdgcn_s_getreg((3 << 11) | 20) & 0xFu; }
#define XB_SPIN(cond, bar) do { unsigned _sp = 0; while (cond) { __builtin_amdgcn_s_sleep(1); \
    if ((++_sp & 255u) == 0u) { if (xb_ld(&(bar)[XB_TMO])) break; if (_sp > XB_SPIN_CAP) { atomicAdd(&(bar)[XB_TMO], 1u); break; } } } } while (0)
struct XcdBarrier { unsigned* bar; unsigned x; volatile XB_LAS unsigned* st; };
__device__ __forceinline__ XcdBarrier xcd_barrier_post(unsigned* bar, volatile XB_LAS unsigned* st) {
    XcdBarrier b; b.bar = bar; b.x = xb_xcc_id(); b.st = st;
    if (threadIdx.x == 0) (void)xb_add(&bar[XB_XCNT(b.x)], 1u);
    return b;
}
__device__ __forceinline__ void xcd_barrier_complete(unsigned* bar, unsigned x, unsigned& nloc, unsigned& nx) {
    const unsigned G = gridDim.x * gridDim.y * gridDim.z;
    unsigned sum, cnt, mine, sp = 0u;
    for (;;) {
        sum = 0u; cnt = 0u; mine = 0u;
#pragma unroll
        for (unsigned j = 0; j < 16; ++j) { const unsigned c = xb_ld(&bar[XB_XCNT(j)]); sum += c; cnt += (c > 0u) ? 1u : 0u; mine = (j == x) ? c : mine; }
        if (sum == G) break;
        __builtin_amdgcn_s_sleep(1);
        if ((++sp & 255u) == 0u) { if (xb_ld(&bar[XB_TMO])) break; if (sp > XB_SPIN_CAP) { atomicAdd(&bar[XB_TMO], 1u); break; } }
    }
    nloc = mine > 0u ? mine : 1u; nx = cnt > 0u ? cnt : 1u;
}
__device__ __forceinline__ void xcd_barrier(const XcdBarrier& b) {
    asm volatile("s_waitcnt vmcnt(0)" ::: "memory");
    __syncthreads();
    if (threadIdx.x == 0) {
        unsigned* bar = b.bar;
        __builtin_amdgcn_s_waitcnt(0);
        unsigned nloc = b.st[0], nx = b.st[1];
        if (nloc == 0u) { xcd_barrier_complete(bar, b.x, nloc, nx); b.st[0] = nloc; b.st[1] = nx; }
        const unsigned old = xb_add(&bar[XB_XSUB(b.x)], 1u);
        const unsigned gen = old / nloc;
        if (old + 1u == (gen + 1u) * nloc) {
            __builtin_amdgcn_fence(__ATOMIC_RELEASE, "agent");
            asm volatile("s_waitcnt vmcnt(0)" ::: "memory");
            const unsigned og = xb_add(&bar[XB_TOP], 1u);
            const unsigned tg = og / nx;
            if (og + 1u == (tg + 1u) * nx) xb_add(&bar[XB_TOPGEN], 1u);
            else XB_SPIN(xb_ld(&bar[XB_TOPGEN]) == tg, bar);
            XB_ACQUIRE();
            xb_add(&bar[XB_XGEN(b.x)], 1u);
            asm volatile("s_waitcnt vmcnt(0)" ::: "memory");
        } else {
            XB_SPIN(xb_ld(&bar[XB_XGEN(b.x)]) == gen, bar);
            XB_ACQUIRE();
            asm volatile("s_waitcnt vmcnt(0)" ::: "memory");
        }
    }
    __syncthreads();
}
#endif
#ifdef EMU
#define NT_STORE(ptr, val) (*(ptr) = (val))
#define NT_LOAD(ptr) (*(ptr))
#else
#define NT_STORE(ptr, val) __builtin_nontemporal_store((val), (ptr))
#define NT_LOAD(ptr) __builtin_nontemporal_load(ptr)
#endif
#ifndef WT_PLAIN
#define WT_PLAIN 0
#endif
#ifdef EMU
#define WT_STORE_I(ptr, val) (*(ptr) = (val))
#define WT_STORE_F(ptr, val) (*(ptr) = (val))
#define WT_STORE_F2(ptr, a, b) ((ptr)[0] = (a), (ptr)[1] = (b))
#else
#if WT_PLAIN
#define WT_STORE_F2(ptr, a, b) ((ptr)[0] = (a), (ptr)[1] = (b))
#define WT_STORE_I(ptr, val) (*(ptr) = (val))
#define WT_STORE_F(ptr, val) (*(ptr) = (val))
#else
#define WT_STORE_F2(ptr, a, b) __hip_atomic_store((unsigned long long*)(ptr), ((unsigned long long)__float_as_uint(b) << 32) | (unsigned long long)__float_as_uint(a), __ATOMIC_RELAXED, __HIP_MEMORY_SCOPE_AGENT)
#define WT_STORE_I(ptr, val) __hip_atomic_store((ptr), (val), __ATOMIC_RELAXED, __HIP_MEMORY_SCOPE_AGENT)
#define WT_STORE_F(ptr, val) __hip_atomic_store((ptr), (val), __ATOMIC_RELAXED, __HIP_MEMORY_SCOPE_AGENT)
#endif
#endif
#ifdef EMU
#define LDS_BARRIER() emu::syncthreads()
#else
#define LDS_BARRIER() asm volatile("s_waitcnt lgkmcnt(0)\n\ts_barrier" ::: "memory")
#endif
constexpr int XB_ST_OFF = 160 * 1024 - 16;

__device__ __forceinline__ int TID() {
#ifdef EMU
    return (int)emu::cur->tid.x;
#else
    int t = (int)threadIdx.x; asm volatile("" : "+v"(t)); return t;
#endif
}
__device__ __forceinline__ float bf2f(bf16_t v) { return __builtin_bit_cast(float, (unsigned)v << 16); }
__device__ __forceinline__ bf16_t f2bf(float f) { unsigned u = __builtin_bit_cast(unsigned, f); u += 0x7fffu + ((u >> 16) & 1u); return (bf16_t)(u >> 16); }
#ifdef EMU
__device__ __forceinline__ unsigned pack2(float a, float b) { return (unsigned)f2bf(a) | ((unsigned)f2bf(b) << 16); }
#else
typedef float f32x2_t_ __attribute__((ext_vector_type(2))); typedef __bf16 bf16x2_t_ __attribute__((ext_vector_type(2)));
__device__ __forceinline__ unsigned pack2(float a, float b) { f32x2_t_ v = {a, b}; bf16x2_t_ r = __builtin_convertvector(v, bf16x2_t_); return __builtin_bit_cast(unsigned, r); }
#endif
__device__ __forceinline__ float sigmoidf_(float x) { return 1.0f / (1.0f + __expf(-x)); }
__device__ __forceinline__ float siluf_(float x) { return x / (1.0f + __expf(-x)); }
__device__ __forceinline__ float wave_sum(float v) {
#pragma unroll
    for (int o = 32; o > 0; o >>= 1) v += __shfl_xor(v, o);
    return v;
}

struct TJob { const float* src; bf16_t* dst; int K, N, ldsrc, ldd, rb, rs, roff, batch; long sbs, dbs; };

struct Params {
    const float *x, *w_in, *conv, *a_log, *dt_bias, *gnorm, *lam_re, *lam_im, *log_dt, *b_re, *b_im, *c_re, *c_im, *s5d, *wglu, *wout,
        *wqkv, *woutc, *lnmg, *lnmb, *rgw, *rgb, *rew, *reb, *mg, *mu, *md, *lnfg, *lnfb;
    float* out;
    bf16_t *WinT, *WoutT, *WgluT, *WqkvT, *WoutcT;
    float* WrT;
    float *s5a, *s5a64, *s5bbr, *s5bbi;
    bf16_t* s5cm;
    bf16_t* s5bbm;
    bf16_t* hb;
    bf16_t *WguT, *WdT;
    int* cnt;
    int *tok_e, *tok_pos; float* tok_gate;
    int* list; float* list_gate;
    bf16_t* proj;
    float *gbeta, *gg;
    bf16_t *gq, *gk, *gv;
    bf16_t *cU, *cW, *cQd, *cKdT;
    bf16_t* cQK;
    float* cgl;
    bf16_t* go;
    float *s5loc, *s5in;
    bf16_t* ygelu;
    bf16_t* ycat;
    bf16_t* mix;
    bf16_t* H;
    bf16_t* Y;
    bf16_t* qkv;
    bf16_t* attno;
    bf16_t* obr[3];
    float* ost;
    bf16_t* mix1;
    bf16_t* Xg;
    float* slot_gate;
    unsigned* bar;
    TJob jobs[8]; int njobs; int pad0;
    TJob moejobs[2][3];
};

struct TTile { const float* src; bf16_t* dst; int ldsrc, ldd, rb, rs, roff, k0, n0; };
template <int NJ>
__device__ __forceinline__ TTile tt_decode(const TJob* jobs, int g) {
    TJob J = jobs[0]; int rem = g; bool found = false;
#pragma unroll
    for (int j = 0; j < NJ; ++j) { const int nt = jobs[j].batch * (jobs[j].K / 64) * (jobs[j].N / 64); if (!found) { if (rem < nt) { J = jobs[j]; found = true; } else rem -= nt; } }
    const int tk = J.K / 64, tn = J.N / 64;
    const int b = rem / (tk * tn), r2 = rem % (tk * tn);
    TTile T; T.k0 = (r2 / tn) * 64; T.n0 = (r2 % tn) * 64; T.src = J.src + (long)b * J.sbs; T.dst = J.dst + (long)b * J.dbs;
    T.ldsrc = J.ldsrc; T.ldd = J.ldd; T.rb = J.rb; T.rs = J.rs; T.roff = J.roff; return T;
}
__device__ __forceinline__ void tt_load(const TTile& T, int t, f32x4 (&r)[4]) {
#pragma unroll
    for (int i = 0; i < 4; ++i) r[i] = __builtin_nontemporal_load((const f32x4*)(T.src + (long)(T.k0 + (t >> 4) + 16 * i) * T.ldsrc + T.n0 + (t & 15) * 4));
}
__device__ __forceinline__ void tt_emit(const TTile& T, int t, float* ts, const f32x4 (&r)[4], bool active) {
    LDS_BARRIER();
    if (active) {
#pragma unroll
        for (int i = 0; i < 4; ++i) { const int k = (t >> 4) + 16 * i, n4 = (t & 15) * 4; ts[k * 65 + n4 + 0] = r[i][0]; ts[k * 65 + n4 + 1] = r[i][1]; ts[k * 65 + n4 + 2] = r[i][2]; ts[k * 65 + n4 + 3] = r[i][3]; }
    }
    LDS_BARRIER();
    if (active) {
        const int n = t >> 2, kq = (t & 3) * 16;
        unsigned w[8];
#pragma unroll
        for (int i = 0; i < 8; ++i) w[i] = pack2(ts[(kq + 2 * i) * 65 + n], ts[(kq + 2 * i + 1) * 65 + n]);
        const int nn = T.n0 + n, row = (nn / T.rb) * T.rs + T.roff + nn % T.rb;
        u32x4* o = (u32x4*)(T.dst + (long)row * T.ldd + T.k0 + kq);
        o[0] = (u32x4){w[0], w[1], w[2], w[3]}; o[1] = (u32x4){w[4], w[5], w[6], w[7]};
    }
}
template <int NJ>
__device__ __forceinline__ void transpose_tiles(const TJob* jobs) {
    const int t = TID() & 255, half = TID() >> 8;
    float* ts = (float*)LDS_BASE() + half * (64 * 65 + 16);
    int total = 0;
#pragma unroll
    for (int j = 0; j < NJ; ++j) total += jobs[j].batch * (jobs[j].K / 64) * (jobs[j].N / 64);
    const int G = (int)gridDim.x;
    f32x4 ra[4], rb[4];
    int gp = (int)blockIdx.x;
    if (gp * 2 + half < total) { const TTile T0 = tt_decode<NJ>(jobs, gp * 2 + half); tt_load(T0, t, ra); }
#pragma unroll 1
    for (; gp * 2 < total; gp += 2 * G) {
        {
            const int g = gp * 2 + half, gn = (gp + G) * 2 + half; const bool active = g < total;
            if (gn < total) { const TTile Tn = tt_decode<NJ>(jobs, gn); tt_load(Tn, t, rb); }
            const TTile T = tt_decode<NJ>(jobs, active ? g : 0);
            tt_emit(T, t, ts, ra, active);
        }
        if ((gp + G) * 2 < total) {
            const int g = (gp + G) * 2 + half, gn = (gp + 2 * G) * 2 + half; const bool active = g < total;
            if (gn < total) { const TTile Tn = tt_decode<NJ>(jobs, gn); tt_load(Tn, t, ra); }
            const TTile T = tt_decode<NJ>(jobs, active ? g : 0);
            tt_emit(T, t, ts, rb, active);
        }
    }
}

__device__ __forceinline__ void phase_prologue(const Params& p) {
    transpose_tiles<6>(p.jobs);
    const long gtid = (long)blockIdx.x * NTHREADS + TID(), gsz = (long)gridDim.x * NTHREADS;
    for (long i = gtid; i < 2L * 36 * 1024; i += gsz) {
        const int l = (int)(i / (36 * 1024)), n = (int)((i / 1024) % 36), k = (int)(i % 1024);
        p.WrT[i] = n < 4 ? p.rgw[((long)l * 1024 + k) * 4 + n] : p.rew[((long)l * 1024 + k) * 32 + (n - 4)];
    }
    for (long idx = gtid; idx < 32 * 64 * 16; idx += gsz) {
        const long i = idx >> 4; const int h = (int)(idx & 15);
        const int g = (int)(i / 64);
        const float dt = expf(p.log_dt[g]);
        const float lr = p.lam_re[i], li = p.lam_im[i];
        const float mag = expf(lr * dt), ar = mag * cosf(li * dt), ai = mag * sinf(li * dt);
        if (h == 0) {
            const float mag64 = expf(64.0f * lr * dt), ph64 = 64.0f * li * dt;
            p.s5a[i * 2] = ar; p.s5a[i * 2 + 1] = ai;
            p.s5a64[i * 2] = mag64 * cosf(ph64); p.s5a64[i * 2 + 1] = mag64 * sinf(ph64);
        }
        const float den = lr * lr + li * li, nr = ar - 1.0f, ni = ai;
        const float cr = (nr * lr + ni * li) / den, ci = (ni * lr - nr * li) / den;
        const float br = p.b_re[i * 16 + h], bi = p.b_im[i * 16 + h];
        p.s5bbr[i * 16 + h] = cr * br - ci * bi; p.s5bbi[i * 16 + h] = cr * bi + ci * br;
        const int pp = (int)(i % 64);
        p.s5bbm[((long)g * 128 + pp) * 16 + h] = f2bf(cr * br - ci * bi); p.s5bbm[((long)g * 128 + 64 + pp) * 16 + h] = f2bf(cr * bi + ci * br);
    }
    for (long i = gtid; i < 32 * 16 * 128; i += gsz) {
        const int p2 = (int)(i % 128); const long gk = i / 128;
        p.s5cm[i] = f2bf(p2 < 64 ? p.c_re[gk * 64 + p2] : -p.c_im[gk * 64 + (p2 - 64)]);
    }
    for (long i = gtid; i < 64; i += gsz) p.cnt[i] = 0;
}

#ifndef MOE_XCD
#define MOE_XCD 1
#endif
namespace pg8 {
#ifdef EMU
#define PG8_LAS
#define PG8_WAIT_V(n) do { } while (0)
#define PG8_WAIT_L(n) do { } while (0)
#else
#define PG8_LAS __attribute__((address_space(3)))
#define PG8_WAIT_V(n) asm volatile("s_waitcnt vmcnt(" #n ")" ::: "memory")
#define PG8_WAIT_L(n) asm volatile("s_waitcnt lgkmcnt(" #n ")" ::: "memory")
#endif
constexpr int BM = 256, BK = 64, HALF = 128, HTB = HALF * BK * 2  , STAGE_BYTES = 8 * HTB, NXCD = 8, WGM = 8;
__host__ __device__ __forceinline__ int lds_byte(int r, int c) { const int st = (r >> 4) * 2 + (c >> 5), rr = r & 15, cc = c & 31, ob = rr * 64 + cc * 2; return st * 1024 + (ob ^ (((ob >> 9) & 1) << 5)); }
__host__ __device__ __forceinline__ void stage_rc(int b, int& R, int& C) { const int st = b / 1024, sb = b % 1024, swz = sb ^ (((sb >> 9) & 1) << 5); R = (st >> 1) * 16 + swz / 64; C = (st & 1) * 32 + (swz % 64) / 2; }
__host__ __device__ __forceinline__ int perm32(int rho) { const int n = rho >> 4, i = rho & 15; return 8 * (i >> 2) + 4 * n + (i & 3); }

struct Unit { int arow, brow, pn, nvalid, lrow; };

struct DenseOrder {
    int nM, nN, nwg, G, c;
    __device__ __forceinline__ void init(int M, int N, int G_, int c_) { nM = M / BM; nN = N / BM; nwg = nM * nN; G = G_; c = c_; }
    __device__ __forceinline__ bool next(int i, Unit& u) const {
        const long L = (long)i * G + c; if (L >= nwg) return false;
        int wgid = (int)L; { const int q = nwg / NXCD, r = nwg % NXCD, xcd = wgid % NXCD, off = wgid / NXCD; wgid = (xcd < r ? xcd * (q + 1) : r * (q + 1) + (xcd - r) * q) + off; }
        const int nig = WGM * nN, gid = wgid / nig, fm = gid * WGM, gsz = (nM - fm) < WGM ? (nM - fm) : WGM;
        const int pm = fm + ((wgid % nig) % gsz), pn = (wgid % nig) / gsz;
        u.arow = pm * BM; u.brow = pn * BM; u.pn = pn; u.nvalid = BM; u.lrow = 0; return true;
    }
};
struct MoeOrder {
    const int* ustart; const int* rbase; const int* cntp; int G, c, npn, brows;
    __device__ __forceinline__ bool next(int i, Unit& u) const {
        const int L0 = i * G + c, nwg = ustart[32]; if (L0 >= nwg) return false;
        int L = L0; if (MOE_XCD) { const int q = nwg / NXCD, r = nwg % NXCD, xcd = L0 % NXCD, off = L0 / NXCD; L = (xcd < r ? xcd * (q + 1) : r * (q + 1) + (xcd - r) * q) + off; }
        int e = 0; while (ustart[e + 1] <= L) ++e;
        const int cn = cntp[e], ntile = (cn + BM - 1) / BM, local = L - ustart[e], ti = local % ntile, pn = local / ntile;
        u.arow = rbase[e] + ti * BM; u.brow = e * brows + pn * BM; u.pn = pn; u.nvalid = cn - ti * BM < BM ? cn - ti * BM : BM; u.lrow = e * LIST_CAP + ti * BM; return true;
    }
};

template <class Epi, class Sched, bool GATHER = false>
__device__ __forceinline__ void gemm_phase(PG8_LAS unsigned char* lds, const bf16_t* gA, const bf16_t* gBt, const int K, const Sched& S, const Epi& E, const int* list = nullptr) {
    const int tid = TID(), wid = __builtin_amdgcn_readfirstlane(tid >> 6), lane = tid & 63, wr = wid >> 2, wc = wid & 3, fr = lane & 15, fq = lane >> 4;
    const int nt = K / BK;
    unsigned voffA[2], voffB[2]; int Rl[2], Cl[2];
#pragma unroll
    for (int i = 0; i < 2; ++i) { int R, C; stage_rc(tid * 16 + i * 8192, R, C); const int Rb = Epi::PERM ? ((R & ~31) + perm32(R & 31)) : R;
        voffA[i] = (unsigned)(R * K + C) * 2u; voffB[i] = (unsigned)(Rb * K + C) * 2u; Rl[i] = R; Cl[i] = C; }
    unsigned aoC[2][2], aoN[2][2];
#define PG8_GATHER_OFFS(ao, u_) do { _Pragma("unroll") for (int h_ = 0; h_ < 2; ++h_) _Pragma("unroll") for (int i_ = 0; i_ < 2; ++i_) { \
        int pos_ = h_ * HALF + Rl[i_]; pos_ = pos_ < (u_).nvalid ? pos_ : (u_).nvalid - 1; \
        ao[h_][i_] = (unsigned)list[(u_).lrow + pos_] * (unsigned)(K * 2) + (unsigned)(Cl[i_] * 2); } } while (0)
#define PG8_STAGE_A(bufoff, aptr, h, kb, nx) do { if constexpr (GATHER) { unsigned ao_[2] = {(nx) ? aoN[h][0] : aoC[h][0], (nx) ? aoN[h][1] : aoC[h][1]}; \
        PG8_STAGE(bufoff, (const char*)gA + (kb), ao_); } else { PG8_STAGE(bufoff, (aptr) + (h) * hstep, voffA); } } while (0)
    const size_t kstep = (size_t)(BK * 2);
    const size_t hstep = (size_t)HALF * K * 2;
    const unsigned ldsw = (unsigned)wid * 1024u;
    const int aoff = lds_byte(wr * 64 + fr, fq * 8), boff = lds_byte(wc * 32 + fr, fq * 8);
#define PG8_SA(b, h) (((b) * 2 + (h)) * HTB)
#define PG8_SB(b, h) ((4 + (b) * 2 + (h)) * HTB)
#define PG8_STAGE(bufoff, gbase, voff) do { _Pragma("unroll") for (int _i = 0; _i < 2; ++_i) \
        __builtin_amdgcn_global_load_lds((const unsigned*)((const char*)(gbase) + (voff)[_i]), (PG8_LAS unsigned*)(lds + (bufoff) + ldsw + _i * 8192), 16, 0, 0); } while (0)
#define PG8_LDA(dst, b, h) do { _Pragma("unroll") for (int m = 0; m < 4; ++m) _Pragma("unroll") for (int k = 0; k < 2; ++k) dst[m][k] = *(const PG8_LAS bf16x8*)(lds + PG8_SA(b, h) + aoff + m * 2048 + k * 1024); } while (0)
#define PG8_LDB(dst, b, h) do { _Pragma("unroll") for (int n = 0; n < 2; ++n) _Pragma("unroll") for (int k = 0; k < 2; ++k) dst[n][k] = *(const PG8_LAS bf16x8*)(lds + PG8_SB(b, h) + boff + n * 2048 + k * 1024); } while (0)
#define PG8_MMA(ai, bj, At, Bt) do { __builtin_amdgcn_s_setprio(1); _Pragma("unroll") for (int m = 0; m < 4; ++m) _Pragma("unroll") for (int n = 0; n < 2; ++n) _Pragma("unroll") for (int k = 0; k < 2; ++k) \
        acc[ai][bj][m][n] = __builtin_amdgcn_mfma_f32_16x16x32_bf16(Bt[n][k], At[m][k], acc[ai][bj][m][n], 0, 0, 0); __builtin_amdgcn_s_setprio(0); } while (0)
#define PG8_BAR __builtin_amdgcn_s_barrier()
#define PG8_SCHED __builtin_amdgcn_sched_barrier(0)
    Unit cur, nxt; int ui = 0;
    if (!S.next(0, cur)) return;
    f32x4 acc[2][2][4][2];
#pragma unroll
    for (int a = 0; a < 2; ++a)
#pragma unroll
        for (int b = 0; b < 2; ++b)
#pragma unroll
            for (int m = 0; m < 4; ++m)
#pragma unroll
                for (int n = 0; n < 2; ++n) acc[a][b][m][n] = (f32x4){0.f, 0.f, 0.f, 0.f};
    bf16x8 At[4][2], B0[2][2], B1[2][2];
    const char* cA = (const char*)gA + (size_t)cur.arow * K * 2; const char* cB = (const char*)gBt + (size_t)cur.brow * K * 2;
    if constexpr (GATHER) { PG8_GATHER_OFFS(aoC, cur); }
    PG8_STAGE(PG8_SB(0, 0), cB, voffB); PG8_STAGE(PG8_SB(0, 1), cB + hstep, voffB); PG8_STAGE_A(PG8_SA(0, 0), cA, 0, 0, false); PG8_STAGE_A(PG8_SA(0, 1), cA, 1, 0, false);
    if (wr == 1) PG8_BAR;
    PG8_WAIT_V(2); PG8_BAR;
    PG8_STAGE(PG8_SB(1, 0), cB + kstep, voffB); PG8_STAGE_A(PG8_SA(1, 0), cA + kstep, 0, kstep, false); PG8_STAGE(PG8_SB(1, 1), cB + hstep + kstep, voffB);
    PG8_WAIT_V(6); PG8_BAR;
    for (;;) {
        const bool has_next = S.next(ui + 1, nxt);
        const char* nA = has_next ? (const char*)gA + (size_t)nxt.arow * K * 2 : cA; const char* nB = has_next ? (const char*)gBt + (size_t)nxt.brow * K * 2 : cB;
        if constexpr (GATHER) { if (has_next) { PG8_GATHER_OFFS(aoN, nxt); } }
        for (int t = 0; t < nt; t += 2) {
            const bool last = (t == nt - 2);
            const bool nx = last && has_next;
            const char* a1 = cA + (size_t)(t + 1) * kstep;
            const char* a2 = last ? nA : cA + (size_t)(t + 2) * kstep; const char* b2 = last ? nB : cB + (size_t)(t + 2) * kstep;
            const char* a3 = a2 + kstep; const char* b3 = b2 + kstep;
            const size_t k1 = (size_t)(t + 1) * kstep, k2 = last ? 0 : (size_t)(t + 2) * kstep, k3 = k2 + kstep;
            PG8_LDB(B0, 0, 0); PG8_LDB(B1, 0, 1); PG8_SCHED; PG8_LDA(At, 0, 0); PG8_STAGE_A(PG8_SA(1, 1), a1, 1, k1, false);
            PG8_WAIT_V(8); PG8_WAIT_L(0); PG8_BAR; PG8_MMA(0, 0, At, B0); PG8_MMA(0, 1, At, B1); PG8_BAR; PG8_SCHED;
            PG8_LDA(At, 0, 1); PG8_STAGE(PG8_SB(0, 0), b2, voffB); PG8_STAGE(PG8_SB(0, 1), b2 + hstep, voffB); PG8_STAGE_A(PG8_SA(0, 0), a2, 0, k2, nx);
            PG8_WAIT_V(8); PG8_WAIT_L(0); PG8_BAR; PG8_MMA(1, 0, At, B0); PG8_MMA(1, 1, At, B1); PG8_BAR; PG8_SCHED;
            PG8_LDB(B0, 1, 0); PG8_LDB(B1, 1, 1); PG8_SCHED; PG8_LDA(At, 1, 0); PG8_STAGE_A(PG8_SA(0, 1), a2, 1, k2, nx);
            PG8_WAIT_V(8); PG8_WAIT_L(0); PG8_BAR; PG8_MMA(0, 0, At, B0); PG8_MMA(0, 1, At, B1); PG8_BAR; PG8_SCHED;
            PG8_LDA(At, 1, 1); PG8_STAGE(PG8_SB(1, 0), b3, voffB); PG8_STAGE(PG8_SB(1, 1), b3 + hstep, voffB); PG8_STAGE_A(PG8_SA(1, 0), a3, 0, k3, nx);
            PG8_WAIT_V(8); PG8_WAIT_L(0); PG8_BAR; PG8_MMA(1, 0, At, B0); PG8_MMA(1, 1, At, B1); PG8_BAR; PG8_SCHED;
        }
        if (wr == 0) PG8_BAR;
        E(acc, cur, wr, wc, fr, fq);
        if (!has_next) break;
#pragma unroll
        for (int a = 0; a < 2; ++a)
#pragma unroll
            for (int b = 0; b < 2; ++b)
#pragma unroll
                for (int m = 0; m < 4; ++m)
#pragma unroll
                    for (int n = 0; n < 2; ++n) acc[a][b][m][n] = (f32x4){0.f, 0.f, 0.f, 0.f};
        cur = nxt; cA = nA; cB = nB; ++ui;
        if constexpr (GATHER) { _Pragma("unroll") for (int h_ = 0; h_ < 2; ++h_) _Pragma("unroll") for (int i_ = 0; i_ < 2; ++i_) aoC[h_][i_] = aoN[h_][i_]; }
        if (wr == 1) PG8_BAR;
    }
    PG8_WAIT_V(0);
    PG8_BAR;
#undef PG8_SA
#undef PG8_SB
#undef PG8_STAGE
#undef PG8_STAGE_A
#undef PG8_GATHER_OFFS
#undef PG8_LDA
#undef PG8_LDB
#undef PG8_MMA
#undef PG8_BAR
#undef PG8_SCHED
}

struct EpiStore {
    static constexpr bool PERM = true;
    bf16_t* C; int ldc;
    __device__ __forceinline__ void operator()(const f32x4 (&acc)[2][2][4][2], const Unit& u, int wr, int wc, int fr, int fq) const {
#pragma unroll
        for (int ai = 0; ai < 2; ++ai)
#pragma unroll
            for (int m = 0; m < 4; ++m) {
                bf16_t* rowp = C + (long)(u.arow + ai * HALF + wr * 64 + m * 16 + fr) * ldc + u.pn * BM + wc * 32 + 8 * fq;
#pragma unroll
                for (int bj = 0; bj < 2; ++bj) { const f32x4 v0 = acc[ai][bj][m][0], v1 = acc[ai][bj][m][1];
                    *(u32x4*)(rowp + bj * HALF) = (u32x4){pack2(v0[0], v0[1]), pack2(v0[2], v0[3]), pack2(v1[0], v1[1]), pack2(v1[2], v1[3])}; }
            }
    }
};
struct EpiGlu {
    static constexpr bool PERM = true;
    const bf16_t* y; bf16_t* ycat;
    __device__ __forceinline__ void operator()(const f32x4 (&acc)[2][2][4][2], const Unit& u, int wr, int wc, int fr, int fq) const {
#pragma unroll
        for (int ai = 0; ai < 2; ++ai)
#pragma unroll
            for (int m = 0; m < 4; ++m) {
                const long row = u.arow + ai * HALF + wr * 64 + m * 16 + fr;
#pragma unroll
                for (int bj = 0; bj < 2; ++bj) {
                    const int col = u.pn * BM + bj * HALF + wc * 32 + 8 * fq;
                    const u32x4 yy = *(const u32x4*)(y + row * 512 + col);
                    const f32x4 v0 = acc[ai][bj][m][0], v1 = acc[ai][bj][m][1];
                    float o[8];
#pragma unroll
                    for (int e = 0; e < 4; ++e) { o[e] = sigmoidf_(v0[e]); o[4 + e] = sigmoidf_(v1[e]); }
#pragma unroll
                    for (int e = 0; e < 4; ++e) { o[2 * e] *= bf2f((bf16_t)(yy[e] & 0xffff)); o[2 * e + 1] *= bf2f((bf16_t)(yy[e] >> 16)); }
                    *(u32x4*)(ycat + row * 1024 + 512 + col) = (u32x4){pack2(o[0], o[1]), pack2(o[2], o[3]), pack2(o[4], o[5]), pack2(o[6], o[7])};
                }
            }
    }
};
struct EpiMoe1 {
    static constexpr bool PERM = true;
    bf16_t* H;
    __device__ __forceinline__ void operator()(const f32x4 (&acc)[2][2][4][2], const Unit& u, int wr, int wc, int fr, int fq) const {
#pragma unroll
        for (int ai = 0; ai < 2; ++ai)
#pragma unroll
            for (int m = 0; m < 4; ++m) {
                const int rl = ai * HALF + wr * 64 + m * 16 + fr;
                if (rl < u.nvalid) {
                    float o[8];
#pragma unroll
                    for (int n = 0; n < 2; ++n)
#pragma unroll
                        for (int e = 0; e < 4; ++e) o[4 * n + e] = siluf_(acc[ai][0][m][n][e]) * acc[ai][1][m][n][e];
                    *(u32x4*)(H + (long)(u.arow + rl) * EFF + u.pn * HALF + wc * 32 + 8 * fq) = (u32x4){pack2(o[0], o[1]), pack2(o[2], o[3]), pack2(o[4], o[5]), pack2(o[6], o[7])};
                }
            }
    }
};
struct EpiMoe2 {
    static constexpr bool PERM = true;
    bf16_t* Y; const float* gate;
    __device__ __forceinline__ void operator()(const f32x4 (&acc)[2][2][4][2], const Unit& u, int wr, int wc, int fr, int fq) const {
#pragma unroll
        for (int ai = 0; ai < 2; ++ai)
#pragma unroll
            for (int m = 0; m < 4; ++m) {
                const int rl = ai * HALF + wr * 64 + m * 16 + fr;
                if (rl < u.nvalid) {
                    const float g = gate[u.lrow + rl];
                    bf16_t* rowp = Y + (long)(u.arow + rl) * DM + u.pn * BM + wc * 32 + 8 * fq;
#pragma unroll
                    for (int bj = 0; bj < 2; ++bj) { const f32x4 v0 = acc[ai][bj][m][0] * g, v1 = acc[ai][bj][m][1] * g;
                        *(u32x4*)(rowp + bj * HALF) = (u32x4){pack2(v0[0], v0[1]), pack2(v0[2], v0[3]), pack2(v1[0], v1[1]), pack2(v1[2], v1[3])}; }
                }
            }
    }
};
}

template <class Epi>
__device__ __forceinline__ void gemm_dense(const bf16_t* A, const bf16_t* Bt, int M, int N, int K, const Epi& E) {
    pg8::DenseOrder S; S.init(M, N, (int)gridDim.x, (int)blockIdx.x);
    pg8::gemm_phase<Epi, pg8::DenseOrder>((PG8_LAS unsigned char*)LDS_BASE(), A, Bt, K, S, E);
}

__device__ __forceinline__ void phase_ba(const Params& p) {
    float* wl = (float*)LDS_BASE();
    {
        float v_[16];
#pragma unroll
        for (int j = 0; j < 16; ++j) { const int i = TID() + NTHREADS * j; v_[j] = p.w_in[(long)(i >> 3) * 2568 + 2048 + (i & 7)]; }
#pragma unroll
        for (int j = 0; j < 16; ++j) { const int i = TID() + NTHREADS * j; wl[(i & 7) * 1024 + (i >> 3)] = v_[j]; }
    }
    __syncthreads();
    const int lane = TID() & 63, gw = blockIdx.x * NW + (TID() >> 6), nw = gridDim.x * NW;
    constexpr int TPI = 4;
    for (int grp = gw; grp < NT / TPI; grp += nw) {
        const long tok0 = (long)grp * TPI;
        f32x4 xv[TPI][4];
#pragma unroll
        for (int tt = 0; tt < TPI; ++tt)
#pragma unroll
            for (int i = 0; i < 4; ++i) xv[tt][i] = NT_LOAD((const f32x4*)(p.x + (tok0 + tt) * DM + 4 * lane + 256 * i));
#pragma unroll
        for (int tt = 0; tt < TPI; ++tt)
#pragma unroll
            for (int i = 0; i < 4; ++i) *(u32x2*)(p.hb + (tok0 + tt) * DM + 4 * lane + 256 * i) = (u32x2){pack2(xv[tt][i][0], xv[tt][i][1]), pack2(xv[tt][i][2], xv[tt][i][3])};
        float acc[TPI][8];
#pragma unroll
        for (int tt = 0; tt < TPI; ++tt)
#pragma unroll
            for (int n = 0; n < 8; ++n) acc[tt][n] = 0.f;
#pragma unroll
        for (int i = 0; i < 4; ++i)
#pragma unroll
            for (int n = 0; n < 8; ++n) {
                const f32x4 wv = *(const f32x4*)(wl + n * 1024 + 4 * lane + 256 * i);
#pragma unroll
                for (int tt = 0; tt < TPI; ++tt) acc[tt][n] += (xv[tt][i][0] * wv[0] + xv[tt][i][1] * wv[1]) + (xv[tt][i][2] * wv[2] + xv[tt][i][3] * wv[3]);
            }
#pragma unroll
        for (int o = 32; o > 0; o >>= 1)
#pragma unroll
            for (int tt = 0; tt < TPI; ++tt)
#pragma unroll
                for (int n = 0; n < 8; ++n) acc[tt][n] += __shfl_xor(acc[tt][n], o);
        if (lane < 4) {
#pragma unroll
            for (int tt = 0; tt < TPI; ++tt) {
                const float bl = lane == 0 ? acc[tt][0] : lane == 1 ? acc[tt][1] : lane == 2 ? acc[tt][2] : acc[tt][3];
                const float al = lane == 0 ? acc[tt][4] : lane == 1 ? acc[tt][5] : lane == 2 ? acc[tt][6] : acc[tt][7];
                const float xx = al + p.dt_bias[lane];
                const float sp = xx > 20.f ? xx : log1pf(expf(xx));
                p.gbeta[(tok0 + tt) * 4 + lane] = 1.0f / (1.0f + expf(-bl));
                p.gg[(tok0 + tt) * 4 + lane] = -expf(p.a_log[lane]) * sp;
            }
        }
    }
}

__device__ __forceinline__ void phase_gdn_prep(const Params& p) {
    const int t = TID(), lane = t & 63, w = t >> 6;
    constexpr int RUN = 16;
    const int nitems = (NT / RUN) * 3;
    for (int item = (int)blockIdx.x * NW + w; item < nitems; item += (int)gridDim.x * NW) {
        const int i = item % 3, run = item / 3;
        const long tok0 = (long)run * RUN; const int s0 = (int)(tok0 % NS_);
        const int cb = i * 512 + lane * 8;
        u32x4 x[RUN + 3];
#pragma unroll
        for (int j = 0; j < 3; ++j) x[j] = s0 > 0 ? *(const u32x4*)(p.proj + (tok0 - 3 + j) * PROJ_LD + cb) : (u32x4){0u, 0u, 0u, 0u};
#pragma unroll
        for (int k = 0; k < RUN; ++k) x[3 + k] = *(const u32x4*)(p.proj + (tok0 + k) * PROJ_LD + cb);
        f32x4 wv[4][2];
#pragma unroll
        for (int j = 0; j < 4; ++j) { wv[j][0] = *(const f32x4*)(p.conv + j * 1536 + cb); wv[j][1] = *(const f32x4*)(p.conv + j * 1536 + cb + 4); }
        bf16_t* dst = (i == 0 ? p.gq : i == 1 ? p.gk : p.gv) + tok0 * 512 + lane * 8;
#pragma unroll
        for (int k = 0; k < RUN; ++k) {
            float a[8];
#pragma unroll
            for (int e = 0; e < 8; ++e) a[e] = 0.f;
#pragma unroll
            for (int j = 0; j < 4; ++j) {
                const u32x4 xv = x[k + j];
                a[0] += wv[j][0][0] * bf2f((bf16_t)(xv[0] & 0xffff)); a[1] += wv[j][0][1] * bf2f((bf16_t)(xv[0] >> 16));
                a[2] += wv[j][0][2] * bf2f((bf16_t)(xv[1] & 0xffff)); a[3] += wv[j][0][3] * bf2f((bf16_t)(xv[1] >> 16));
                a[4] += wv[j][1][0] * bf2f((bf16_t)(xv[2] & 0xffff)); a[5] += wv[j][1][1] * bf2f((bf16_t)(xv[2] >> 16));
                a[6] += wv[j][1][2] * bf2f((bf16_t)(xv[3] & 0xffff)); a[7] += wv[j][1][3] * bf2f((bf16_t)(xv[3] >> 16));
            }
            float ss = 0.f;
#pragma unroll
            for (int e = 0; e < 8; ++e) { a[e] = siluf_(a[e]); ss += a[e] * a[e]; }
            if (i < 2) {
                ss += __shfl_xor(ss, 1); ss += __shfl_xor(ss, 2); ss += __shfl_xor(ss, 4); ss += __shfl_xor(ss, 8);
                const float sc = rsqrtf(ss + 1e-6f);
#pragma unroll
                for (int e = 0; e < 8; ++e) a[e] *= sc;
            }
            *(u32x4*)(dst + (long)k * 512) = (u32x4){pack2(a[0], a[1]), pack2(a[2], a[3]), pack2(a[4], a[5]), pack2(a[6], a[7])};
        }
    }
}

#ifndef FUSE_PREP
#define FUSE_PREP 1
#endif
constexpr int CLD = 136;
__device__ __forceinline__ void phase_gdn_chunk(const Params& p) {
    const int half = TID() >> 8;
    char* lds = LDS_BASE() + half * 70656;
    float* gc = (float*)lds; float* be = gc + 64; float* eg = be + 64; float* ek = eg + 64; float* bek = ek + 64;
    float* Ls = (float*)(lds + 1280);
    bf16_t* vs = (bf16_t*)(lds + 1280 + 16384); bf16_t* ks = vs + 64 * CLD; bf16_t* qs = ks + 64 * CLD;
    const int t = TID() & 255, lane = t & 63, w = t >> 6, fr = lane & 15, fq = lane >> 4;
    const int nunits = NB_ * 4 * NCH;
    for (int up = blockIdx.x; up * 2 < nunits; up += gridDim.x) {
        const int u = up * 2 + half;
        const int n = u % NCH, hh = (u / NCH) & 3, b = u / (NCH * 4);
        const long tok0 = (long)b * NS_ + n * 64;
        LDS_BARRIER();
#if FUSE_PREP
        {
            const int rg = t >> 4, ch = (t & 15) * 8;
            const int s0 = n * 64 + 4 * rg;
#pragma unroll
            for (int X = 0; X < 3; ++X) {
                const int col = X * 512 + hh * 128 + ch;
                u32x4 x[7];
#pragma unroll
                for (int j = 0; j < 7; ++j) x[j] = (s0 - 3 + j) >= 0 ? *(const u32x4*)(p.proj + (tok0 + 4 * rg - 3 + j) * PROJ_LD + col) : (u32x4){0u, 0u, 0u, 0u};
                f32x4 wv[4][2];
#pragma unroll
                for (int j = 0; j < 4; ++j) { wv[j][0] = *(const f32x4*)(p.conv + j * 1536 + col); wv[j][1] = *(const f32x4*)(p.conv + j * 1536 + col + 4); }
                bf16_t* dl = X == 0 ? qs : X == 1 ? ks : vs;
#pragma unroll
                for (int i = 0; i < 4; ++i) {
                    float a[8];
#pragma unroll
                    for (int e = 0; e < 8; ++e) a[e] = 0.f;
#pragma unroll
                    for (int j = 0; j < 4; ++j) {
                        const u32x4 xv = x[i + j];
                        a[0] += wv[j][0][0] * bf2f((bf16_t)(xv[0] & 0xffff)); a[1] += wv[j][0][1] * bf2f((bf16_t)(xv[0] >> 16));
                        a[2] += wv[j][0][2] * bf2f((bf16_t)(xv[1] & 0xffff)); a[3] += wv[j][0][3] * bf2f((bf16_t)(xv[1] >> 16));
                        a[4] += wv[j][1][0] * bf2f((bf16_t)(xv[2] & 0xffff)); a[5] += wv[j][1][1] * bf2f((bf16_t)(xv[2] >> 16));
                        a[6] += wv[j][1][2] * bf2f((bf16_t)(xv[3] & 0xffff)); a[7] += wv[j][1][3] * bf2f((bf16_t)(xv[3] >> 16));
                    }
                    float ss = 0.f;
#pragma unroll
                    for (int e = 0; e < 8; ++e) { a[e] = siluf_(a[e]); ss += a[e] * a[e]; }
                    if (X < 2) {
                        ss += __shfl_xor(ss, 1); ss += __shfl_xor(ss, 2); ss += __shfl_xor(ss, 4); ss += __shfl_xor(ss, 8);
                        const float sc = rsqrtf(ss + 1e-6f);
#pragma unroll
                        for (int e = 0; e < 8; ++e) a[e] *= sc;
                    }
                    *(u32x4*)(dl + (4 * rg + i) * CLD + ch) = (u32x4){pack2(a[0], a[1]), pack2(a[2], a[3]), pack2(a[4], a[5]), pack2(a[6], a[7])};
                }
            }
        }
#else
#pragma unroll
        for (int i = 0; i < 4; ++i) {
            const int c = t + 256 * i, row = c >> 4, ch = (c & 15) * 8;
            const long go_ = (tok0 + row) * 512 + hh * 128 + ch;
            *(u32x4*)(qs + row * CLD + ch) = *(const u32x4*)(p.gq + go_);
            *(u32x4*)(ks + row * CLD + ch) = *(const u32x4*)(p.gk + go_);
            *(u32x4*)(vs + row * CLD + ch) = *(const u32x4*)(p.gv + go_);
        }
#endif
        if (w == 0) {
            float v = p.gg[(tok0 + lane) * 4 + hh];
#pragma unroll
            for (int o = 1; o < 64; o <<= 1) { const float nb = __shfl_up(v, o); if (lane >= o) v += nb; }
            const float gl = __shfl(v, 63);
            const float bt = p.gbeta[(tok0 + lane) * 4 + hh];
            gc[lane] = v; be[lane] = bt; eg[lane] = expf(v); ek[lane] = expf(gl - v); bek[lane] = bt * expf(v);
            if (lane == 0) WT_STORE_F(p.cgl + u, expf(gl));
        }
        LDS_BARRIER();
        {
            f32x4 akk[4], aqk[4];
#pragma unroll
            for (int nn = 0; nn < 4; ++nn) { akk[nn] = (f32x4){0.f, 0.f, 0.f, 0.f}; aqk[nn] = (f32x4){0.f, 0.f, 0.f, 0.f}; }
#pragma unroll
            for (int k4 = 0; k4 < 4; ++k4) {
                const bf16x8 afk = *(const bf16x8*)(ks + (16 * w + fr) * CLD + k4 * 32 + fq * 8);
                const bf16x8 afq = *(const bf16x8*)(qs + (16 * w + fr) * CLD + k4 * 32 + fq * 8);
#pragma unroll
                for (int nn = 0; nn < 4; ++nn) {
                    const bf16x8 bfr = *(const bf16x8*)(ks + (16 * nn + fr) * CLD + k4 * 32 + fq * 8);
                    akk[nn] = __builtin_amdgcn_mfma_f32_16x16x32_bf16(bfr, afk, akk[nn], 0, 0, 0);
                    aqk[nn] = __builtin_amdgcn_mfma_f32_16x16x32_bf16(bfr, afq, aqk[nn], 0, 0, 0);
                }
            }
            const int i = 16 * w + fr; const float gci = gc[i], bei = be[i];
#pragma unroll
            for (int nn = 0; nn < 4; ++nn) {
                const int j0 = 16 * nn + 4 * fq;
                f32x4 lv; float qv[4];
#pragma unroll
                for (int r = 0; r < 4; ++r) {
                    const int j = j0 + r;
                    const float dec = i >= j ? expf(gci - gc[j]) : 0.f;
                    lv[r] = i > j ? bei * akk[nn][r] * dec : 0.f;
                    qv[r] = 0.08838834764831845f * aqk[nn][r] * dec;
                }
                *(f32x4*)(Ls + i * 64 + j0) = lv;
                *(u32x2*)(p.cQK + (long)u * 8192 + i * 64 + j0) = (u32x2){pack2(qv[0], qv[1]), pack2(qv[2], qv[3])};
            }
        }
        LDS_BARRIER();
        {
            const int c = t & 127; const bf16_t* src = t < 128 ? vs : ks; const float* mulp = t < 128 ? be : bek;
            float x[64];
#pragma unroll
            for (int i = 0; i < 64; ++i) {
                float a = mulp[i] * bf2f(src[i * CLD + c]);
#pragma unroll
                for (int j4 = 0; j4 < (i + 3) / 4; ++j4) {
                    const f32x4 l4 = *(const f32x4*)(Ls + i * 64 + 4 * j4);
                    if (4 * j4 + 0 < i) a = fmaf(-l4[0], x[4 * j4 + 0], a);
                    if (4 * j4 + 1 < i) a = fmaf(-l4[1], x[4 * j4 + 1], a);
                    if (4 * j4 + 2 < i) a = fmaf(-l4[2], x[4 * j4 + 2], a);
                    if (4 * j4 + 3 < i) a = fmaf(-l4[3], x[4 * j4 + 3], a);
                }
                x[i] = a;
                asm volatile("" ::: "memory");
            }
            LDS_BARRIER();
            bf16_t* Wt = (bf16_t*)Ls;
            if (t < 128) {
#pragma unroll
                for (int i = 0; i < 64; ++i) vs[i * CLD + c] = f2bf(x[i]);
            } else {
#pragma unroll
                for (int i = 0; i < 64; ++i) Wt[i * 128 + c] = f2bf(x[i]);
            }
        }
        LDS_BARRIER();
#pragma unroll
        for (int e = 0; e < 4; ++e) {
            const int id = t + 256 * e, row = id >> 4, ch = (id & 15) * 8;
            *(u32x4*)(p.cU + (long)u * 8192 + row * 128 + ch) = *(const u32x4*)(vs + row * CLD + ch);
            *(u32x4*)(p.cW + (long)u * 8192 + row * 128 + ch) = *(const u32x4*)((const bf16_t*)Ls + row * 128 + ch);
            {
                const u32x4 qv = *(const u32x4*)(qs + row * CLD + ch); const float sc = 0.08838834764831845f * eg[row];
                unsigned o4[4];
#pragma unroll
                for (int k = 0; k < 4; ++k) o4[k] = pack2(bf2f((bf16_t)(qv[k] & 0xffff)) * sc, bf2f((bf16_t)(qv[k] >> 16)) * sc);
                *(u32x4*)(p.cQd + (long)u * 8192 + row * 128 + ch) = (u32x4){o4[0], o4[1], o4[2], o4[3]};
            }
            {
                const int d = id >> 3, i0 = (id & 7) * 8;
                float kv[8];
#pragma unroll
                for (int k = 0; k < 8; ++k) kv[k] = bf2f(ks[(i0 + k) * CLD + d]) * ek[i0 + k];
                *(u32x4*)(p.cKdT + (long)u * 8192 + d * 64 + i0) = (u32x4){pack2(kv[0], kv[1]), pack2(kv[2], kv[3]), pack2(kv[4], kv[5]), pack2(kv[6], kv[7])};
            }
        }
    }
}

#define GO_STORE(ptr, lo, hi) (*(u32x2*)(ptr) = (u32x2){(lo), (hi)})
#ifndef SCAN_XCD_REMAP
#define SCAN_XCD_REMAP 1
#endif
struct ScanOwn { bf16x8 f[7]; u32x2 uvr; };
__device__ __forceinline__ const bf16_t* scan_slot_ptr(const Params& p, int s, int w, int fr, int fq) {
    if (s < 4) return p.cW + (16 * w + fr) * 128 + s * 32 + fq * 8;
    if (s < 8) return p.cQd + (16 * w + fr) * 128 + (s - 4) * 32 + fq * 8;
    if (s < 12) return p.cKdT + (32 * w + 16 * ((s - 8) >> 1) + fr) * 64 + ((s - 8) & 1) * 32 + fq * 8;
    return p.cQK + (16 * w + fr) * 64 + (s - 12) * 32 + fq * 8;
}
#define SCAN_LOAD(P, cu_) do { const long co_ = (long)(cu_) * 8192; \
        _Pragma("unroll") for (int j = 0; j < 7; ++j) P.f[j] = *(const bf16x8*)(sp[j] + co_); \
        P.uvr = *(const u32x2*)(up + co_); } while (0)
#define SCAN_STEP(Pw, n_) do { \
        const long cu_ = cu0 + (n_); const long tokr = (long)b * NS_ + (n_) * 64 + 16 * w + fr; \
        bf16x8 sb[4]; \
        _Pragma("unroll") for (int k4 = 0; k4 < 4; ++k4) sb[k4] = *(const bf16x8*)(SbT + fr * CLD + k4 * 32 + fq * 8); \
        f32x4 vw = (f32x4){0.f, 0.f, 0.f, 0.f}, o = (f32x4){0.f, 0.f, 0.f, 0.f}; \
        _Pragma("unroll") for (int k4 = 0; k4 < 4; ++k4) { vw = __builtin_amdgcn_mfma_f32_16x16x32_bf16(sb[k4], F[k4], vw, 0, 0, 0); o = __builtin_amdgcn_mfma_f32_16x16x32_bf16(sb[k4], F[4 + k4], o, 0, 0, 0); } \
          \
        { const u32x2 uvc = *(const u32x2*)ub; const unsigned u0_ = uvc[0], u1_ = uvc[1]; \
          VnT[(4 * fq + 0) * 72 + 16 * w + fr] = f2bf(bf2f((bf16_t)(u0_ & 0xffff)) - vw[0]); VnT[(4 * fq + 1) * 72 + 16 * w + fr] = f2bf(bf2f((bf16_t)(u0_ >> 16)) - vw[1]); \
          VnT[(4 * fq + 2) * 72 + 16 * w + fr] = f2bf(bf2f((bf16_t)(u1_ & 0xffff)) - vw[2]); VnT[(4 * fq + 3) * 72 + 16 * w + fr] = f2bf(bf2f((bf16_t)(u1_ >> 16)) - vw[3]); } \
        LDS_BARRIER(); \
        _Pragma("unroll") for (int j = 0; j < 7; ++j) *(bf16x8*)(xw + j * 512) = Pw.f[j];                   \
        *(u32x2*)ub = Pw.uvr;                                                                                \
        const float glc = glbuf[(n_)]; \
        bf16x8 vb[2]; \
        _Pragma("unroll") for (int k2 = 0; k2 < 2; ++k2) vb[k2] = *(const bf16x8*)(VnT + fr * 72 + k2 * 32 + fq * 8); \
        _Pragma("unroll") for (int k2 = 0; k2 < 2; ++k2) o = __builtin_amdgcn_mfma_f32_16x16x32_bf16(vb[k2], F[12 + k2], o, 0, 0, 0); \
        GO_STORE((p.go + tokr * 512 + hh * 128 + vsl * 16 + 4 * fq), pack2(o[0], o[1]), pack2(o[2], o[3])); \
        _Pragma("unroll") for (int m = 0; m < 2; ++m) { \
            sacc[m] = sacc[m] * glc; \
            _Pragma("unroll") for (int k2 = 0; k2 < 2; ++k2) sacc[m] = __builtin_amdgcn_mfma_f32_16x16x32_bf16(F[8 + 2 * m + k2], vb[k2], sacc[m], 0, 0, 0); \
            *(u32x2*)(SbT + fr * CLD + 32 * w + 16 * m + 4 * fq) = (u32x2){pack2(sacc[m][0], sacc[m][1]), pack2(sacc[m][2], sacc[m][3])}; \
        } \
        LDS_BARRIER(); \
        _Pragma("unroll") for (int k = 0; k < 14; ++k) F[k] = *(const bf16x8*)(xr + k * 512);                \
        { const long c3_ = cu_ + 3 < culast ? cu_ + 3 : culast; SCAN_LOAD(Pw, c3_); } \
    } while (0)
#ifdef EMU
#define PIN2(a, b) do { } while (0)
#else
#define PIN2(a, b) asm volatile("" : "+v"(a), "+v"(b))
#endif
__device__ __forceinline__ void phase_gdn_scan(const Params& p, int nblk) {
    const int half = TID() >> 8;
    bf16_t* SbT = (bf16_t*)(LDS_BASE() + half * 8192);
    bf16_t* VnT = SbT + 16 * CLD;
    const int t = TID() & 255, lane = t & 63, w = t >> 6, fr = lane & 15, fq = lane >> 4;
    bf16_t* xbuf = (bf16_t*)(LDS_BASE() + 16384) + w * (14 * 512);
    bf16_t* xw = xbuf + half * (7 * 512) + lane * 8; const bf16_t* xr = xbuf + lane * 8;
    unsigned* ub = (unsigned*)(LDS_BASE() + 16384 + 4 * 14336) + ((half * 4 + w) * 64 + lane) * 2;
    float* glbuf = (float*)(LDS_BASE() + 16384 + 4 * 14336 + 4096);
    const int nunits = NB_ * 4 * 8;
    for (int x = blockIdx.x; x * 2 < nunits; x += nblk) {
        int up_ = x;
        if (SCAN_XCD_REMAP && (nblk & 31) == 0 && (nunits & 63) == 0) { const int xcd = x & 7, slot = x >> 3; up_ = 4 * ((slot >> 2) * 8 + xcd) + (slot & 3); }
        const int u = up_ * 2 + half;
        const int vsl = u & 7, hh = (u >> 3) & 3, b = u >> 5;
        const long cu0 = (long)(b * 4 + hh) * NCH, culast = cu0 + NCH - 1;
        const bf16_t* sp[7];
#pragma unroll
        for (int j = 0; j < 7; ++j) { const bf16_t* p0 = scan_slot_ptr(p, j, w, fr, fq); const bf16_t* p1 = scan_slot_ptr(p, 7 + j, w, fr, fq); sp[j] = half ? p1 : p0; }
        const bf16_t* up = p.cU + (16 * w + fr) * 128 + vsl * 16 + 4 * fq;
        LDS_BARRIER();
        for (int i = t; i < 16 * CLD; i += 256) SbT[i] = 0;
        f32x4 sacc[2] = {(f32x4){0.f, 0.f, 0.f, 0.f}, (f32x4){0.f, 0.f, 0.f, 0.f}};
        ScanOwn PA, PB; bf16x8 F[14];
        for (int i = TID(); i < NCH; i += NTHREADS) glbuf[i] = p.cgl[cu0 + i];
        SCAN_LOAD(PA, cu0); { const long c1_ = cu0 + 1 < culast ? cu0 + 1 : culast; SCAN_LOAD(PB, c1_); }
#pragma unroll
        for (int j = 0; j < 7; ++j) *(bf16x8*)(xw + j * 512) = PA.f[j];
        *(u32x2*)ub = PA.uvr;
        LDS_BARRIER();
#pragma unroll
        for (int k = 0; k < 14; ++k) F[k] = *(const bf16x8*)(xr + k * 512);
        { const long c2_ = cu0 + 2 < culast ? cu0 + 2 : culast; SCAN_LOAD(PA, c2_); }
        int n = 0;
#pragma unroll 1
        for (; n + 2 <= NCH; n += 2) {
            SCAN_STEP(PB, n);
            SCAN_STEP(PA, n + 1);
        }
    }
}
#undef SCAN_STEP
#undef SCAN_LOAD

__device__ __forceinline__ void phase_gdn_post(const Params& p) {
    const int lane = TID() & 63; const int gw = blockIdx.x * NW + (TID() >> 6), nw = gridDim.x * NW;
    const f32x4 nw0 = *(const f32x4*)(p.gnorm + (lane & 15) * 8), nw1 = *(const f32x4*)(p.gnorm + (lane & 15) * 8 + 4);
    for (int g8 = gw; g8 < NT / 8; g8 += nw) {
        const long tok0 = (long)g8 * 8;
        u32x4 ov[8], zv[8];
#pragma unroll
        for (int k = 0; k < 8; ++k) { ov[k] = NT_LOAD((const u32x4*)(p.go + (tok0 + k) * 512 + lane * 8)); zv[k] = NT_LOAD((const u32x4*)(p.proj + (tok0 + k) * PROJ_LD + 1536 + lane * 8)); }
#pragma unroll
        for (int k = 0; k < 8; ++k) {
            float o[8], z[8];
#pragma unroll
            for (int e = 0; e < 4; ++e) { o[2 * e] = bf2f((bf16_t)(ov[k][e] & 0xffff)); o[2 * e + 1] = bf2f((bf16_t)(ov[k][e] >> 16)); z[2 * e] = bf2f((bf16_t)(zv[k][e] & 0xffff)); z[2 * e + 1] = bf2f((bf16_t)(zv[k][e] >> 16)); }
            float ss = 0.f;
#pragma unroll
            for (int e = 0; e < 8; ++e) ss += o[e] * o[e];
            ss += __shfl_xor(ss, 1); ss += __shfl_xor(ss, 2); ss += __shfl_xor(ss, 4); ss += __shfl_xor(ss, 8);
            const float rs = rsqrtf(ss * (1.0f / 128.0f) + 1e-6f);
            float r[8];
#pragma unroll
            for (int e = 0; e < 4; ++e) { r[e] = o[e] * rs * nw0[e] * siluf_(z[e]); r[4 + e] = o[4 + e] * rs * nw1[e] * siluf_(z[4 + e]); }
            *(u32x4*)(p.ycat + (tok0 + k) * 1024 + lane * 8) = (u32x4){pack2(r[0], r[1]), pack2(r[2], r[3]), pack2(r[4], r[5]), pack2(r[6], r[7])};
        }
    }
}

__device__ __forceinline__ float gelu_tanh(float x) { return 0.5f * x * (1.0f + tanhf(0.7978845608028654f * (x + 0.044715f * x * x * x))); }
#ifndef S5_CARRY
#define S5_CARRY 1
#endif
#ifdef EMU
#define CARRY_PIN(a, b) do { } while (0)
#else
#define CARRY_PIN(a, b) asm volatile("" : "+v"(a), "+v"(b))
#endif
#define WAVE_SYNC() LDS_BARRIER()
constexpr int S5_NSEG1 = NCH >= 16 ? 8 : NCH / 2, S5_NSEG2 = NCH >= 8 ? 4 : NCH / 2;
struct S5Task { bf16x8 bfm[8]; bf16x8 cf[4]; float ar, ai; f32x4 dsk; };
struct S5In { bf16x8 uf[4]; u32x2 uu[4]; };
template <int PASS>
__device__ __forceinline__ void s5_task_init(const Params& p, S5Task& T, int g, int lane, int fr, int fq) {
    bf16x8 zf;
#pragma unroll
    for (int e = 0; e < 8; ++e) zf[e] = 0;
#pragma unroll
    for (int nt = 0; nt < 8; ++nt) T.bfm[nt] = fq < 2 ? *(const bf16x8*)(p.s5bbm + ((long)g * 128 + 16 * nt + fr) * 16 + 8 * fq) : zf;
    if (PASS == 2) {
#pragma unroll
        for (int k4 = 0; k4 < 4; ++k4) T.cf[k4] = *(const bf16x8*)(p.s5cm + (g * 16 + fr) * 128 + k4 * 32 + fq * 8);
        T.dsk = *(const f32x4*)(p.s5d + g * 16 + 4 * fq);
    }
    T.ar = p.s5a[(g * 64 + lane) * 2]; T.ai = p.s5a[(g * 64 + lane) * 2 + 1];
}
template <int PASS>
__device__ __forceinline__ void s5_load(const Params& p, S5In& I, int g, long tok0, int fr, int fq) {
    bf16x8 zf;
#pragma unroll
    for (int e = 0; e < 8; ++e) zf[e] = 0;
#pragma unroll
    for (int mt = 0; mt < 4; ++mt) I.uf[mt] = fq < 2 ? *(const bf16x8*)(p.proj + (tok0 + 16 * mt + fr) * PROJ_LD + 2048 + g * 16 + 8 * fq) : zf;
    if (PASS == 2) {
#pragma unroll
        for (int mt = 0; mt < 4; ++mt) I.uu[mt] = *(const u32x2*)(p.proj + (tok0 + 16 * mt + fr) * PROJ_LD + 2048 + g * 16 + 4 * fq);
    }
}
template <int PASS>
__device__ __forceinline__ void s5_unit(const Params& p, bf16_t* hs, const S5Task& T, const S5In& I, int g, long tok0, float& hr, float& hi, int lane, int fr, int fq) {
#pragma unroll
    for (int nt = 0; nt < 8; ++nt)
#pragma unroll
        for (int mt = 0; mt < 4; ++mt) {
            f32x4 d = (f32x4){0.f, 0.f, 0.f, 0.f};
            d = __builtin_amdgcn_mfma_f32_16x16x32_bf16(T.bfm[nt], I.uf[mt], d, 0, 0, 0);
            *(u32x2*)(hs + (16 * mt + fr) * CLD + 16 * nt + 4 * fq) = (u32x2){pack2(d[0], d[1]), pack2(d[2], d[3])};
        }
    WAVE_SYNC();
    const float ar = T.ar, ai = T.ai;
#pragma unroll 8
    for (int j = 0; j < 64; ++j) {
        const float br = bf2f(hs[j * CLD + lane]), bi = bf2f(hs[j * CLD + 64 + lane]);
        const float nr = ar * hr - ai * hi + br, ni = ar * hi + ai * hr + bi;
        hr = nr; hi = ni;
        if (PASS == 2) { hs[j * CLD + lane] = f2bf(hr); hs[j * CLD + 64 + lane] = f2bf(hi); }
    }
    if (PASS == 2) {
        WAVE_SYNC();
        f32x4 acc[4];
#pragma unroll
        for (int mt = 0; mt < 4; ++mt) acc[mt] = (f32x4){0.f, 0.f, 0.f, 0.f};
#pragma unroll
        for (int k4 = 0; k4 < 4; ++k4)
#pragma unroll
            for (int mt = 0; mt < 4; ++mt) {
                const bf16x8 hf = *(const bf16x8*)(hs + (16 * mt + fr) * CLD + k4 * 32 + fq * 8);
                acc[mt] = __builtin_amdgcn_mfma_f32_16x16x32_bf16(T.cf[k4], hf, acc[mt], 0, 0, 0);
            }
#pragma unroll
        for (int mt = 0; mt < 4; ++mt) {
            const int j = 16 * mt + fr;
            const u32x2 uu = I.uu[mt];
            const float y0 = acc[mt][0] + T.dsk[0] * bf2f((bf16_t)(uu[0] & 0xffff)), y1 = acc[mt][1] + T.dsk[1] * bf2f((bf16_t)(uu[0] >> 16));
            const float y2 = acc[mt][2] + T.dsk[2] * bf2f((bf16_t)(uu[1] & 0xffff)), y3 = acc[mt][3] + T.dsk[3] * bf2f((bf16_t)(uu[1] >> 16));
            *(u32x2*)(p.ygelu + (tok0 + j) * 512 + g * 16 + 4 * fq) = (u32x2){pack2(gelu_tanh(y0), gelu_tanh(y1)), pack2(gelu_tanh(y2), gelu_tanh(y3))};
        }
    }
    WAVE_SYNC();
}
template <int PASS>
__device__ __forceinline__ void phase_s5_pass(const Params& p, int blk0) {
    const int t = TID(), lane = t & 63, w = t >> 6, fr = lane & 15, fq = lane >> 4;
    bf16_t* hs = (bf16_t*)(LDS_BASE() + w * (64 * CLD * 2));
    constexpr int S5_NSEG = PASS == 1 ? S5_NSEG1 : S5_NSEG2, S5_CPS = NCH / S5_NSEG;
    const int ntasks = NB_ * 32 * S5_NSEG;
    if ((int)blockIdx.x < blk0) return;
    for (int bt = (int)blockIdx.x - blk0; bt < ntasks / NW; bt += (int)gridDim.x - blk0) {
        const int task = bt * NW + w;
        const int g = task & 31, seg = (task >> 5) % S5_NSEG, b = task / (32 * S5_NSEG);
        S5Task T; s5_task_init<PASS>(p, T, g, lane, fr, fq);
        const int c0 = seg * S5_CPS;
        S5In IA, IB;
        s5_load<PASS>(p, IA, g, ((long)b * NCH + c0) * 64, fr, fq);
        float hr = 0.f, hi = 0.f;
        if (PASS == 2 && S5_CARRY) {
            const float a64r = p.s5a64[(g * 64 + lane) * 2], a64i = p.s5a64[(g * 64 + lane) * 2 + 1];
            const long base = ((long)b * NCH * 32 + g) * 64 + lane;
            constexpr int CG = S5_CPS >= 8 ? 8 : S5_CPS;
#pragma unroll 1
            for (int c8 = 0; c8 < c0; c8 += CG) {
                float lr[CG], li[CG];
#pragma unroll
                for (int k = 0; k < CG; ++k) { lr[k] = p.s5loc[(base + (long)(c8 + k) * 2048) * 2]; li[k] = p.s5loc[(base + (long)(c8 + k) * 2048) * 2 + 1]; }
#pragma unroll
                for (int k = 0; k < CG; ++k) {
                    float nr = fmaf(a64r, hr, lr[k]), ni = fmaf(a64r, hi, li[k]);
                    CARRY_PIN(nr, ni);
                    nr = fmaf(-a64i, hi, nr); ni = fmaf(a64i, hr, ni);
                    CARRY_PIN(nr, ni);
                    hr = nr; hi = ni;
                }
            }
        }
#pragma unroll 1
        for (int c = c0; c < c0 + S5_CPS; c += 2) {
            const long tokA = ((long)b * NCH + c) * 64, tokB = tokA + 64;
            s5_load<PASS>(p, IB, g, tokB, fr, fq);
            if (PASS == 1) { hr = 0.f; hi = 0.f; }
            s5_unit<PASS>(p, hs, T, IA, g, tokA, hr, hi, lane, fr, fq);
            if (PASS == 1) { const long unit = ((long)b * NCH + c) * 32 + g; p.s5loc[(unit * 64 + lane) * 2] = hr; p.s5loc[(unit * 64 + lane) * 2 + 1] = hi; hr = 0.f; hi = 0.f; }
            if (c + 2 < c0 + S5_CPS) s5_load<PASS>(p, IA, g, tokB + 64, fr, fq);
            s5_unit<PASS>(p, hs, T, IB, g, tokB, hr, hi, lane, fr, fq);
            if (PASS == 1) { const long unit = ((long)b * NCH + c + 1) * 32 + g; p.s5loc[(unit * 64 + lane) * 2] = hr; p.s5loc[(unit * 64 + lane) * 2 + 1] = hi; }
        }
    }
}

struct LnrRow { f32x4 xf[4]; u32x2 xh[4]; u32x2 mm[4]; };
template <bool F32IN>
__device__ __forceinline__ void lnr_load(const Params& p, LnrRow& R, const float* hin, const bf16_t* mixp, long tok, int lane) {
#pragma unroll
    for (int i = 0; i < 4; ++i) {
        const int k = 4 * lane + 256 * i;
        if (F32IN) R.xf[i] = NT_LOAD((const f32x4*)(hin + tok * DM + k)); else R.xh[i] = NT_LOAD((const u32x2*)(p.hb + tok * DM + k));
        R.mm[i] = NT_LOAD((const u32x2*)(mixp + tok * DM + k));
    }
}
template <bool F32IN>
__device__ __forceinline__ void lnr_process(const Params& p, int layer, const LnrRow& R, const f32x4 (&gv)[4], const f32x4 (&bv)[4], const float* Wr,
                                            int* lcount, int* le, int* lrank, float* lgate, int lt, long tok, int lane, bool dry = false) {
    float h[16];
    float s = 0.f;
#pragma unroll
    for (int i = 0; i < 4; ++i) {
        f32x4 xv;
        if (F32IN) xv = R.xf[i];
        else { const u32x2 xx = R.xh[i]; xv = (f32x4){bf2f((bf16_t)(xx[0] & 0xffff)), bf2f((bf16_t)(xx[0] >> 16)), bf2f((bf16_t)(xx[1] & 0xffff)), bf2f((bf16_t)(xx[1] >> 16))}; }
        const u32x2 mm = R.mm[i];
        h[4 * i + 0] = ALPHA * xv[0] + bf2f((bf16_t)(mm[0] & 0xffff)); h[4 * i + 1] = ALPHA * xv[1] + bf2f((bf16_t)(mm[0] >> 16));
        h[4 * i + 2] = ALPHA * xv[2] + bf2f((bf16_t)(mm[1] & 0xffff)); h[4 * i + 3] = ALPHA * xv[3] + bf2f((bf16_t)(mm[1] >> 16));
        s += (h[4 * i] + h[4 * i + 1]) + (h[4 * i + 2] + h[4 * i + 3]);
    }
    const float mean = wave_sum(s) * (1.0f / DM);
    float q = 0.f;
#pragma unroll
    for (int e = 0; e < 16; ++e) { const float d = h[e] - mean; q += d * d; }
    const float rstd = rsqrtf(wave_sum(q) * (1.0f / DM) + LN_EPS);
#pragma unroll
    for (int i = 0; i < 4; ++i) {
        const int k = 4 * lane + 256 * i;
#pragma unroll
        for (int e = 0; e < 4; ++e) h[4 * i + e] = (h[4 * i + e] - mean) * rstd * gv[i][e] + bv[i][e];
        if (!dry) NT_STORE((u32x2*)(p.hb + tok * DM + k), ((u32x2){pack2(h[4 * i], h[4 * i + 1]), pack2(h[4 * i + 2], h[4 * i + 3])}));
        else NT_STORE((u32x2*)(p.H + tok * DM + k), ((u32x2){pack2(h[4 * i], h[4 * i + 1]), pack2(h[4 * i + 2], h[4 * i + 3])}));
    }
    float gl[4];
#pragma unroll
    for (int n = 0; n < 4; ++n) {
        float a = 0.f;
#pragma unroll
        for (int i = 0; i < 4; ++i) { const f32x4 wv = *(const f32x4*)(Wr + n * 1024 + 4 * lane + 256 * i); a += h[4 * i] * wv[0] + h[4 * i + 1] * wv[1] + h[4 * i + 2] * wv[2] + h[4 * i + 3] * wv[3]; }
        gl[n] = a;
    }
#pragma unroll
    for (int o = 32; o > 0; o >>= 1)
#pragma unroll
        for (int n = 0; n < 4; ++n) gl[n] += __shfl_xor(gl[n], o);
#pragma unroll
    for (int n = 0; n < 4; ++n) gl[n] += p.rgb[layer * 4 + n];
    int grp = 0; float gm = gl[0];
#pragma unroll
    for (int n = 1; n < 4; ++n) if (gl[n] > gm) { gm = gl[n]; grp = n; }
    float den = 0.f;
#pragma unroll
    for (int n = 0; n < 4; ++n) den += expf(gl[n] - gm);
    const float pg = 1.0f / den;
    float m1 = -3.0e38f, m2 = -3.0e38f; int i1 = 0, i2 = 0;
    float el8[8];
#pragma unroll
    for (int j = 0; j < 8; ++j) {
        const float* wrow = Wr + (long)(4 + grp * 8 + j) * 1024;
        float a = 0.f;
#pragma unroll
        for (int i = 0; i < 4; ++i) { const f32x4 wv = *(const f32x4*)(wrow + 4 * lane + 256 * i); a += h[4 * i] * wv[0] + h[4 * i + 1] * wv[1] + h[4 * i + 2] * wv[2] + h[4 * i + 3] * wv[3]; }
        el8[j] = a;
    }
#pragma unroll
    for (int o = 32; o > 0; o >>= 1)
#pragma unroll
        for (int j = 0; j < 8; ++j) el8[j] += __shfl_xor(el8[j], o);
#pragma unroll
    for (int j = 0; j < 8; ++j) {
        const float el = el8[j] + p.reb[layer * 32 + grp * 8 + j];
        if (el > m1) { m2 = m1; i2 = i1; m1 = el; i1 = j; } else if (el > m2) { m2 = el; i2 = j; }
    }
    if (lane == 0) {
        const float g1 = 1.0f / (1.0f + expf(m2 - m1));
        const int e0 = grp * 8 + i1, e1 = grp * 8 + i2;
        le[lt * 2] = e0; le[lt * 2 + 1] = e1; lgate[lt * 2] = pg * g1; lgate[lt * 2 + 1] = pg * (1.0f - g1);
        lrank[lt * 2] = atomicAdd(&lcount[e0], 1); lrank[lt * 2 + 1] = atomicAdd(&lcount[e1], 1);
    }
}
__device__ __forceinline__ void phase_ln_router(const Params& p, int layer, const float* hin, const bf16_t* mixp, bool dry = false) {
    float* Wr = (float*)LDS_BASE();
    int* li = (int*)(LDS_BASE() + 36 * 1024 * 4);
    int* lcount = li; int* lbase = li + 32; int* le = li + 64; int* lrank = li + 64 + 128; float* lgate = (float*)(li + 64 + 256);
    const int t = TID(), lane = t & 63, w = t >> 6;
    f32x4 gv[4], bv[4];
#pragma unroll
    for (int i = 0; i < 4; ++i) { gv[i] = *(const f32x4*)(p.lnmg + layer * DM + 4 * lane + 256 * i); bv[i] = *(const f32x4*)(p.lnmb + layer * DM + 4 * lane + 256 * i); }
    { const f32x4* src = (const f32x4*)(p.WrT + (long)layer * 36 * 1024); f32x4* dst = (f32x4*)Wr;
#pragma unroll
      for (int r = 0; r < 2; ++r) {
          f32x4 v[9];
#pragma unroll
          for (int j = 0; j < 9; ++j) v[j] = src[t + NTHREADS * (9 * r + j)];
#pragma unroll
          for (int j = 0; j < 9; ++j) dst[t + NTHREADS * (9 * r + j)] = v[j];
      } }
    for (int bb = blockIdx.x; bb < NT / 64; bb += gridDim.x) {
        __syncthreads();
        if (t < 32) lcount[t] = 0;
        __syncthreads();
        {
            const long tokb = (long)bb * 64 + w * (64 / NW);
            LnrRow RA, RB;
            if (hin) lnr_load<true>(p, RA, hin, mixp, tokb, lane); else lnr_load<false>(p, RA, hin, mixp, tokb, lane);
#pragma unroll 1
            for (int it = 0; it < 64 / NW; it += 2) {
                const long tn = tokb + (it + 2 < 64 / NW ? it + 2 : it + 1);
                if (hin) {
                    lnr_load<true>(p, RB, hin, mixp, tokb + it + 1, lane);
                    lnr_process<true>(p, layer, RA, gv, bv, Wr, lcount, le, lrank, lgate, w * (64 / NW) + it, tokb + it, lane, dry);
                    lnr_load<true>(p, RA, hin, mixp, tn, lane);
                    lnr_process<true>(p, layer, RB, gv, bv, Wr, lcount, le, lrank, lgate, w * (64 / NW) + it + 1, tokb + it + 1, lane, dry);
                } else {
                    lnr_load<false>(p, RB, hin, mixp, tokb + it + 1, lane);
                    lnr_process<false>(p, layer, RA, gv, bv, Wr, lcount, le, lrank, lgate, w * (64 / NW) + it, tokb + it, lane, dry);
                    lnr_load<false>(p, RA, hin, mixp, tn, lane);
                    lnr_process<false>(p, layer, RB, gv, bv, Wr, lcount, le, lrank, lgate, w * (64 / NW) + it + 1, tokb + it + 1, lane, dry);
                }
            }
        }
        __syncthreads();
        if (t < 32) lbase[t] = (lcount[t] > 0 && !dry) ? atomicAdd(p.cnt + layer * 32 + t, lcount[t]) : 0;
        __syncthreads();
        if (t < 128 && !dry) {
            const int e = le[t], pos = lbase[e] + lrank[t]; const long tok = (long)bb * 64 + (t >> 1);
            p.tok_e[tok * 2 + (t & 1)] = e; p.tok_pos[tok * 2 + (t & 1)] = pos; p.tok_gate[tok * 2 + (t & 1)] = lgate[t];
            WT_STORE_I(p.list + (long)e * LIST_CAP + pos, (int)tok); WT_STORE_F(p.list_gate + (long)e * LIST_CAP + pos, lgate[t]);
        }
    }
}

__device__ __forceinline__ void moe_map(const Params& p, int layer, int* ustart, int* rbase, int* cntl, int npn) {
    __syncthreads();
    if (TID() < 64) {
        const int l_ = TID(), e = l_ & 31;
        const int c = l_ < 32 ? p.cnt[layer * 32 + e] : 0;
        const int tiles = ((c + 255) >> 8) * npn;
        int us = tiles, rb = c;
#pragma unroll
        for (int o = 1; o < 32; o <<= 1) { const int a = __shfl_up(us, o), b = __shfl_up(rb, o); if ((l_ & 31) >= o) { us += a; rb += b; } }
        if (l_ < 32) { ustart[e] = us - tiles; rbase[e] = rb - c; cntl[e] = c; if (e == 31) { ustart[32] = us; rbase[32] = rb; } }
    }
    __syncthreads();
}
constexpr int MAP_OFF = 131072;

__device__ __forceinline__ void phase_moe_gather(const Params& p, int layer) {
    int* ustart = (int*)(LDS_BASE() + MAP_OFF); int* rbase = ustart + 33; int* cntl = rbase + 33;
    moe_map(p, layer, ustart, rbase, cntl, 4);
    const int lane = TID() & 63, gw = blockIdx.x * NW + (TID() >> 6), nw = gridDim.x * NW, total = rbase[32];
    for (int s = gw; s < total; s += nw) {
        int e = 0; while (rbase[e + 1] <= s) ++e;
        const int pos = s - rbase[e]; const long tok = p.list[(long)e * LIST_CAP + pos];
        const u32x4 v0 = *(const u32x4*)(p.hb + tok * DM + lane * 8), v1 = *(const u32x4*)(p.hb + tok * DM + 512 + lane * 8);
        *(u32x4*)(p.Xg + (long)s * DM + lane * 8) = v0; *(u32x4*)(p.Xg + (long)s * DM + 512 + lane * 8) = v1;
        if (lane == 0) p.slot_gate[s] = p.list_gate[(long)e * LIST_CAP + pos];
    }
}

__device__ __forceinline__ void phase_moe1(const Params& p, int layer) {
    int* ustart = (int*)(LDS_BASE() + MAP_OFF); int* rbase = ustart + 33; int* cntl = rbase + 33;
    moe_map(p, layer, ustart, rbase, cntl, 4);
    pg8::MoeOrder S{ustart, rbase, cntl, (int)gridDim.x, (int)blockIdx.x, 4, 1024};
    pg8::gemm_phase<pg8::EpiMoe1, pg8::MoeOrder, true>((PG8_LAS unsigned char*)LDS_BASE(), p.hb, p.WguT, 1024, S, pg8::EpiMoe1{p.H}, p.list);
}
__device__ __forceinline__ void phase_moe2(const Params& p, int layer) {
    int* ustart = (int*)(LDS_BASE() + MAP_OFF); int* rbase = ustart + 33; int* cntl = rbase + 33;
    moe_map(p, layer, ustart, rbase, cntl, 4);
    pg8::MoeOrder S{ustart, rbase, cntl, (int)gridDim.x, (int)blockIdx.x, 4, 1024};
    pg8::gemm_phase<pg8::EpiMoe2, pg8::MoeOrder>((PG8_LAS unsigned char*)LDS_BASE(), p.H, p.WdT, EFF, S, pg8::EpiMoe2{p.Y, p.list_gate});
}

__device__ __forceinline__ void phase_ln_ffn(const Params& p, int layer, bool write_hb, bool dry = false) {
    int* ustart = (int*)(LDS_BASE() + MAP_OFF); int* rbase = ustart + 33; int* cntl = rbase + 33;
    moe_map(p, layer, ustart, rbase, cntl, 4);
    const int lane = TID() & 63, gw = blockIdx.x * NW + (TID() >> 6), nw = gridDim.x * NW;
    const float* gam = p.lnfg + layer * DM; const float* bet = p.lnfb + layer * DM;
    for (int tok = gw; tok < NT; tok += nw) {
        const long s0 = rbase[p.tok_e[(long)tok * 2]] + p.tok_pos[(long)tok * 2], s1 = rbase[p.tok_e[(long)tok * 2 + 1]] + p.tok_pos[(long)tok * 2 + 1];
        float h[16]; float s = 0.f;
#pragma unroll
        for (int i = 0; i < 2; ++i) {
            const int k = 8 * lane + 512 * i;
            const u32x4 xx = NT_LOAD((const u32x4*)(p.hb + (long)tok * DM + k));
            const u32x4 ya = NT_LOAD((const u32x4*)(p.Y + s0 * DM + k)), yb = NT_LOAD((const u32x4*)(p.Y + s1 * DM + k));
#pragma unroll
            for (int e = 0; e < 4; ++e) {
                h[8 * i + 2 * e] = ALPHA * bf2f((bf16_t)(xx[e] & 0xffff)) + (bf2f((bf16_t)(ya[e] & 0xffff)) + bf2f((bf16_t)(yb[e] & 0xffff)));
                h[8 * i + 2 * e + 1] = ALPHA * bf2f((bf16_t)(xx[e] >> 16)) + (bf2f((bf16_t)(ya[e] >> 16)) + bf2f((bf16_t)(yb[e] >> 16)));
                s += h[8 * i + 2 * e] + h[8 * i + 2 * e + 1];
            }
        }
        const float mean = wave_sum(s) * (1.0f / DM);
        float q = 0.f;
#pragma unroll
        for (int e = 0; e < 16; ++e) { const float d = h[e] - mean; q += d * d; }
        const float rstd = rsqrtf(wave_sum(q) * (1.0f / DM) + LN_EPS);
#pragma unroll
        for (int i = 0; i < 2; ++i) {
            const int k = 8 * lane + 512 * i;
            const f32x4 g0 = *(const f32x4*)(gam + k), g1 = *(const f32x4*)(gam + k + 4), b0 = *(const f32x4*)(bet + k), b1 = *(const f32x4*)(bet + k + 4);
#pragma unroll
            for (int e = 0; e < 4; ++e) { h[8 * i + e] = (h[8 * i + e] - mean) * rstd * g0[e] + b0[e]; h[8 * i + 4 + e] = (h[8 * i + 4 + e] - mean) * rstd * g1[e] + b1[e]; }
            const u32x4 pk = (u32x4){pack2(h[8 * i], h[8 * i + 1]), pack2(h[8 * i + 2], h[8 * i + 3]), pack2(h[8 * i + 4], h[8 * i + 5]), pack2(h[8 * i + 6], h[8 * i + 7])};
            if (dry) *(u32x4*)(p.H + (long)tok * DM + k) = pk;
            else if (write_hb) NT_STORE((u32x4*)(p.hb + (long)tok * DM + k), pk);
            else { NT_STORE((f32x4*)(p.out + (long)tok * DM + k), ((f32x4){h[8 * i], h[8 * i + 1], h[8 * i + 2], h[8 * i + 3]}));
                   NT_STORE((f32x4*)(p.out + (long)tok * DM + k + 4), ((f32x4){h[8 * i + 4], h[8 * i + 5], h[8 * i + 6], h[8 * i + 7]})); }
        }
    }
}


typedef float f32x16 __attribute__((ext_vector_type(16)));
typedef short s16x4 __attribute__((ext_vector_type(4)));
__device__ __forceinline__ s16x4 lds_tr_read(const bf16_t* p) {
#ifdef EMU
    return emu_ds_read_tr16_b64(p);
#else
    typedef short v4i16_t __attribute__((ext_vector_type(4)));
    return __builtin_bit_cast(s16x4, __builtin_amdgcn_ds_read_tr16_b64_v4i16((__attribute__((address_space(3))) v4i16_t*)p));
#endif
}
constexpr int KLD = 72;
struct AttnUnit { int c, d, r, grp, tpr, Ld, h, b; };
__device__ __forceinline__ AttnUnit attn_decode(int u, int g0, int g1, int g2) {
    constexpr int TPB = NS_ / 32;
    const int gper = g0 + g1 + g2; int gi = u % gper; const int bh = u / gper;
    AttnUnit a; a.h = bh & 15; a.b = bh >> 4;
    if (gi < g0) { a.c = 0; a.d = 1; } else if (gi < g0 + g1) { a.c = 1; a.d = 4; gi -= g0; } else { a.c = 2; a.d = 16; gi -= g0 + g1; }
    a.tpr = TPB / a.d; const int gpr = (a.tpr + 7) / 8; a.r = gi / gpr; a.grp = gi % gpr; a.Ld = NS_ / a.d;
    return a;
}
__device__ __forceinline__ void attn_loads(const Params& p, const AttnUnit& a, int t, int w, int q, int hh, u32x4 (&kr)[6], u32x4 (&vr)[6], bf16x8 (&qf)[4]) {
    const long tb = (long)a.b * NS_; const int M0 = 256 * a.grp;
#pragma unroll
    for (int i = 0; i < 6; ++i) {
        const int id = t + 512 * i, row = id >> 3, ch = (id & 7) * 8;
        int mk = M0 - 128 + row; mk = mk < 0 ? 0 : (mk >= a.Ld ? a.Ld - 1 : mk);
        const bf16_t* src = p.qkv + (tb + (long)mk * a.d + a.r) * 3072 + 1024 + a.h * 64 + ch;
        kr[i] = *(const u32x4*)src; vr[i] = *(const u32x4*)(src + 1024);
    }
    const int mt = 8 * a.grp + w, mtc = mt < a.tpr ? mt : a.tpr - 1;
    const long tokq = tb + (long)(32 * mtc + q) * a.d + a.r;
#pragma unroll
    for (int s = 0; s < 4; ++s) qf[s] = *(const bf16x8*)(p.qkv + tokq * 3072 + a.h * 64 + 16 * s + 8 * hh);
}
__device__ __forceinline__ void phase_attn(const Params& p) {
    constexpr int TPB = NS_ / 32;
    const int t = TID(), lane = t & 63, w = t >> 6, q = lane & 31, hh = lane >> 5;
    bf16_t* Ks = (bf16_t*)LDS_BASE(); bf16_t* Vs = Ks + 384 * KLD;
    const int g0 = (TPB + 7) / 8, g1 = 4 * ((TPB / 4 + 7) / 8), g2 = 16 * ((TPB / 16 + 7) / 8), gper = g0 + g1 + g2;
    const int nunits = NB_ * 16 * gper;
    const float C = 0.125f * 1.4426950408889634f;
    u32x4 kr[6], vr[6]; bf16x8 qn[4];
    const int G = (int)gridDim.x, nbh = NB_ * 16;
#ifndef ATTN_XCD
#define ATTN_XCD 1
#endif
    const bool xcdmap = ATTN_XCD && (G % 8 == 0) && (nbh % 8 == 0);
    const int xcd = (int)blockIdx.x & 7, lb = (int)blockIdx.x >> 3, nlb = G >> 3, nloc = (nbh / 8) * gper;
    const int nit = xcdmap ? (nloc + nlb - 1) / nlb : (nunits + G - 1) / G;
#define ATTN_UNIT_OF(it_) (xcdmap ? (((it_) * nlb + lb) < nloc ? ((((it_) * nlb + lb) / gper) * 8 + xcd) * gper + (((it_) * nlb + lb) % gper) : -1) \
                                  : (((it_) * G + (int)blockIdx.x) < nunits ? ((it_) * G + (int)blockIdx.x) : -1))
    { const int u0 = ATTN_UNIT_OF(0); if (u0 >= 0) { const AttnUnit a0 = attn_decode(u0, g0, g1, g2); attn_loads(p, a0, t, w, q, hh, kr, vr, qn); } }
    for (int it = 0; it < nit; ++it) {
        const int u = ATTN_UNIT_OF(it); if (u < 0) break;
        const AttnUnit a = attn_decode(u, g0, g1, g2);
        const int c = a.c, d = a.d, r = a.r, h = a.h, tpr = a.tpr;
        const int mt = 8 * a.grp + w;
        const long tb = (long)a.b * NS_;
        LDS_BARRIER();
#pragma unroll
        for (int i = 0; i < 6; ++i) {
            const int id = t + 512 * i, row = id >> 3, ch = (id & 7) * 8;
            *(u32x4*)(Ks + row * KLD + ch) = kr[i]; *(u32x4*)(Vs + row * KLD + ch) = vr[i];
        }
        bf16x8 qf[4];
#pragma unroll
        for (int s = 0; s < 4; ++s) qf[s] = qn[s];
        const bool active = mt < tpr;
        const int mtc = active ? mt : tpr - 1;
        const long tokq = tb + (long)(32 * mtc + q) * d + r;
        LDS_BARRIER();
        { const int un = (it + 1 < nit) ? ATTN_UNIT_OF(it + 1) : -1; if (un >= 0) { const AttnUnit an = attn_decode(un, g0, g1, g2); attn_loads(p, an, t, w, q, hh, kr, vr, qn); } }
        if (active) {
            f32x16 sc[5];
#pragma unroll
            for (int j = 0; j < 5; ++j) {
                const int mk0 = 32 * mt - 128 + 32 * j;
                if (mk0 >= 0) {
                    const bf16_t* kp = Ks + (32 * (w + j) + q) * KLD + 8 * hh;
                    f32x16 acc;
#pragma unroll
                    for (int i = 0; i < 16; ++i) acc[i] = 0.f;
#pragma unroll
                    for (int s = 0; s < 4; ++s) acc = __builtin_amdgcn_mfma_f32_32x32x16_bf16(*(const bf16x8*)(kp + 16 * s), qf[s], acc, 0, 0, 0);
                    sc[j] = acc;
                } else {
#pragma unroll
                    for (int i = 0; i < 16; ++i) sc[j][i] = -1.0e30f;
                }
            }
            float mx = -1.0e30f;
#pragma unroll
            for (int j = 0; j < 5; ++j)
#pragma unroll
                for (int i = 0; i < 16; ++i) {
                    const int kk = (i & 3) + 8 * (i >> 2) + 4 * hh;
                    if (j == 0) { if (kk < q) sc[j][i] = -1.0e30f; }
                    if (j == 4) { if (kk > q) sc[j][i] = -1.0e30f; }
                    mx = fmaxf(mx, sc[j][i]);
                }
            mx = fmaxf(mx, __shfl_xor(mx, 32));
            const float nmx = -mx * C;
            mx = mx * C;
            float l = 0.f;
#pragma unroll
            for (int j = 0; j < 5; ++j)
#pragma unroll
                for (int i = 0; i < 16; ++i) { const float e = __builtin_amdgcn_exp2f(fmaf(sc[j][i], C, nmx)); sc[j][i] = e; l += e; }
            l += __shfl_xor(l, 32);
            f32x16 o[2];
#pragma unroll
            for (int i = 0; i < 16; ++i) { o[0][i] = 0.f; o[1][i] = 0.f; }
#pragma unroll
            for (int j = 0; j < 5; ++j) {
                const int mk0 = 32 * mt - 128 + 32 * j;
                if (mk0 >= 0) {
#pragma unroll
                    for (int s = 0; s < 2; ++s) {
                        const unsigned w0 = pack2(sc[j][8 * s + 0], sc[j][8 * s + 1]), w1 = pack2(sc[j][8 * s + 2], sc[j][8 * s + 3]);
                        const unsigned w2 = pack2(sc[j][8 * s + 4], sc[j][8 * s + 5]), w3 = pack2(sc[j][8 * s + 6], sc[j][8 * s + 7]);
                        const bf16x8 pa = __builtin_bit_cast(bf16x8, (u32x4){w0, w1, w2, w3});
#pragma unroll
                        for (int db = 0; db < 2; ++db) {
                            const bf16_t* vp = Vs + (32 * (w + j) + 16 * s + 4 * hh + ((lane & 15) >> 2)) * KLD + 32 * db + 16 * ((lane >> 4) & 1) + 4 * (lane & 3);
                            const s16x4 lo = lds_tr_read(vp), hi = lds_tr_read(vp + 8 * KLD);
                            const bf16x8 vb = (bf16x8){lo[0], lo[1], lo[2], lo[3], hi[0], hi[1], hi[2], hi[3]};
                            o[db] = __builtin_amdgcn_mfma_f32_32x32x16_bf16(vb, pa, o[db], 0, 0, 0);
                        }
                    }
                }
            }
            bf16_t* ob = p.obr[c] + tokq * 1024 + h * 64 + 8 * hh;
#pragma unroll
            for (int db = 0; db < 2; ++db)
#pragma unroll
                for (int pc = 0; pc < 2; ++pc) {
                    const unsigned e0 = pack2(o[db][8 * pc], o[db][8 * pc + 1]), e1 = pack2(o[db][8 * pc + 2], o[db][8 * pc + 3]);
                    const unsigned d0 = pack2(o[db][8 * pc + 4], o[db][8 * pc + 5]), d1 = pack2(o[db][8 * pc + 6], o[db][8 * pc + 7]);
                    const unsigned k0 = hh ? d0 : e0, k1 = hh ? d1 : e1, s0 = hh ? e0 : d0, s1 = hh ? e1 : d1;
                    const unsigned r0 = __shfl_xor(s0, 32), r1 = __shfl_xor(s1, 32);
                    const u32x4 v = (u32x4){hh ? r0 : k0, hh ? r1 : k1, hh ? k0 : r0, hh ? k1 : r1};
                    *(u32x4*)(ob + 32 * db + 16 * pc) = v;
                }
            if (hh == 0) { float* st = p.ost + ((long)c * NT + tokq) * 32 + h * 2; WT_STORE_F2(st, mx, l); }
        }
    }
}

__device__ __forceinline__ void phase_attn_merge(const Params& p) {
    const long gtid = (long)blockIdx.x * NTHREADS + TID(), gsz = (long)gridDim.x * NTHREADS;
    for (long idx = gtid; idx < (long)NT * 16 * 8; idx += gsz) {
        const long th = idx >> 3; const int ch = (int)(idx & 7);
        const long tok = th >> 4; const int h = (int)(th & 15);
        float m[3], l[3];
#pragma unroll
        for (int c = 0; c < 3; ++c) { const float* st = p.ost + ((long)c * NT + tok) * 32 + h * 2; m[c] = st[0]; l[c] = st[1]; }
        const float M = fmaxf(m[0], fmaxf(m[1], m[2]));
        float wgt[3], den = 0.f;
#pragma unroll
        for (int c = 0; c < 3; ++c) { wgt[c] = __builtin_amdgcn_exp2f(m[c] - M); den += wgt[c] * l[c]; }
        const float inv = 1.0f / den;
        float acc[8];
#pragma unroll
        for (int e = 0; e < 8; ++e) acc[e] = 0.f;
#pragma unroll
        for (int c = 0; c < 3; ++c) {
            const u32x4 v = NT_LOAD((const u32x4*)(p.obr[c] + tok * 1024 + h * 64 + ch * 8));
#pragma unroll
            for (int e = 0; e < 4; ++e) { acc[2 * e] += wgt[c] * bf2f((bf16_t)(v[e] & 0xffff)); acc[2 * e + 1] += wgt[c] * bf2f((bf16_t)(v[e] >> 16)); }
        }
        *(u32x4*)(p.attno + tok * 1024 + h * 64 + ch * 8) = (u32x4){pack2(acc[0] * inv, acc[1] * inv), pack2(acc[2] * inv, acc[3] * inv), pack2(acc[4] * inv, acc[5] * inv), pack2(acc[6] * inv, acc[7] * inv)};
    }
}

constexpr int NPHASES = 19;
__device__ __forceinline__ void run_phase(const Params& p, int ph, const XcdBarrier& xb) {
    switch (ph) {
    case 0:
#if defined(P0_VARIANT)
        _Pragma("unroll 1") for (int rep = 0; rep < 2; ++rep) { phase_prologue(p); __syncthreads(); }
#else
        phase_prologue(p);
#endif
        __syncthreads(); phase_ba(p);
        break;
    case 1: gemm_dense(p.hb, p.WinT, NT, 2560, 1024, pg8::EpiStore{p.proj, 2560}); break;
    case 2:
#if !FUSE_PREP
        phase_gdn_prep(p);
#endif
        break;
    case 3:
#if defined(P3_VARIANT) && P3_VARIANT == 1
        _Pragma("unroll 1") for (int rep = 0; rep < 2; ++rep) { phase_gdn_chunk(p); __syncthreads(); }
        phase_s5_pass<1>(p, 0);
#elif defined(P3_VARIANT) && P3_VARIANT == 2
        phase_gdn_chunk(p); __syncthreads();
        _Pragma("unroll 1") for (int rep = 0; rep < 2; ++rep) { phase_s5_pass<1>(p, 0); __syncthreads(); }
#else
        phase_gdn_chunk(p); __syncthreads(); phase_s5_pass<1>(p, 0);
#endif
        break;
    case 4: {
        int nscan = NB_ * 16; if (nscan > (int)gridDim.x / 2) nscan = (int)gridDim.x / 2;
#if defined(P4_VARIANT) && P4_VARIANT == 1
        if ((int)blockIdx.x < nscan) { phase_gdn_scan(p, nscan); LDS_BARRIER(); phase_gdn_scan(p, nscan); } else phase_s5_pass<2>(p, nscan);
#elif defined(P4_VARIANT) && P4_VARIANT == 2
        if ((int)blockIdx.x < nscan) phase_gdn_scan(p, nscan); else { phase_s5_pass<2>(p, nscan); LDS_BARRIER(); phase_s5_pass<2>(p, nscan); }
#else
        if ((int)blockIdx.x < nscan) phase_gdn_scan(p, nscan); else phase_s5_pass<2>(p, nscan);
#endif
        break; }
    case 5: phase_gdn_post(p); __syncthreads(); gemm_dense(p.ygelu, p.WgluT, NT, 512, 512, pg8::EpiGlu{p.ygelu, p.ycat}); break;
    case 6: gemm_dense(p.ycat, p.WoutT, NT, 1024, 1024, pg8::EpiStore{p.mix, 1024}); __syncthreads(); transpose_tiles<3>(p.moejobs[0]);
#if defined(P6_VARIANT)
        __syncthreads(); transpose_tiles<3>(p.moejobs[0]);
#endif
        break;
    case 7:
#if defined(P7_VARIANT)
        phase_ln_router(p, 0, p.x, p.mix, true); __syncthreads();
#endif
        phase_ln_router(p, 0, p.x, p.mix); break;
    case 8: phase_moe1(p, 0); break;
    case 9: phase_moe2(p, 0); break;
    case 10:
#if defined(P11_VARIANT)
        phase_ln_ffn(p, 0, true, true); __syncthreads();
#endif
        phase_ln_ffn(p, 0, true); break;
    case 11: gemm_dense(p.hb, p.WqkvT, NT, 3072, 1024, pg8::EpiStore{p.qkv, 3072}); break;
    case 12: phase_attn(p); break;
    case 13: phase_attn_merge(p); break;
    case 14: gemm_dense(p.attno, p.WoutcT, NT, 1024, 1024, pg8::EpiStore{p.mix1, 1024}); __syncthreads(); transpose_tiles<3>(p.moejobs[1]); break;
    case 15: phase_ln_router(p, 1, nullptr, p.mix1); break;
    case 16: phase_moe1(p, 1); break;
    case 17: phase_moe2(p, 1); break;
    case 18: phase_ln_ffn(p, 1, false); break;
    default: break;
    }
}

#if N_LAUNCH_MODE == 0
template <int PH> __global__ void __launch_bounds__(NTHREADS, 2) k_ph(Params p) { XcdBarrier xb{}; run_phase(p, PH, xb); }
template <int PH> static void launch_from(const Params& p, int grid, hipStream_t stream, int maxph) {
    if constexpr (PH < NPHASES) {
        if (PH <= maxph) {
#ifdef EMU
            emu::launch(dim3(32), dim3(NTHREADS), LDS_BYTES, [=] { k_ph<PH>(p); }, false); fprintf(stderr, "phase %d done\n", PH);
#else
            hipFuncSetAttribute((const void*)k_ph<PH>, hipFuncAttributeMaxDynamicSharedMemorySize, LDS_BYTES);
            hipLaunchKernelGGL(k_ph<PH>, dim3(grid), dim3(NTHREADS), LDS_BYTES, stream, p);
#endif
        }
        launch_from<PH + 1>(p, grid, stream, maxph);
    }
}
#else
template <int PH> __device__ __forceinline__ void mega_from(const Params& p, const XcdBarrier& xb) {
    if constexpr (PH < NPHASES && FUSE_PREP && PH == 2) { mega_from<PH + 1>(p, xb); }
    else if constexpr (PH < NPHASES) {
        run_phase(p, PH, xb);
#ifdef PROBE_MASK
        if constexpr (((PROBE_MASK) >> PH) & 1) { GRID_SYNC(); run_phase(p, PH, xb); }
#endif
        if constexpr (PH == 0) { GRID_SYNC_CG(); }
        else if constexpr (PH + 1 < NPHASES) { GRID_SYNC(); }
        mega_from<PH + 1>(p, xb);
    }
}
__global__ void __launch_bounds__(NTHREADS, 2) k_mega(Params p) {
#ifdef EMU
    XcdBarrier xb{0};
#else
    volatile XB_LAS unsigned* st = (volatile XB_LAS unsigned*)(lds_raw + XB_ST_OFF);
    if (threadIdx.x == 0) { st[0] = 0u; st[1] = 0u; }
    __syncthreads();
    const XcdBarrier xb = xcd_barrier_post(p.bar, st);
#endif
    mega_from<0>(p, xb);
}
#endif

#ifdef EMU
Params g_emu_params;
#endif

static inline size_t al256(size_t x) { return (x + 255) & ~(size_t)255; }

extern "C" void kernel_launch(void* const* d_in, const int* in_sizes, int n_in, void* d_out, int out_size, void* d_ws, size_t ws_size, hipStream_t stream) {
    Params p; memset(&p, 0, sizeof(p));
    const float* const* in = (const float* const*)d_in;
    p.x = in[0]; p.w_in = in[1]; p.conv = in[2]; p.a_log = in[3]; p.dt_bias = in[4]; p.gnorm = in[5]; p.lam_re = in[6]; p.lam_im = in[7]; p.log_dt = in[8];
    p.b_re = in[9]; p.b_im = in[10]; p.c_re = in[11]; p.c_im = in[12]; p.s5d = in[13]; p.wglu = in[14]; p.wout = in[15]; p.wqkv = in[16]; p.woutc = in[17];
    p.lnmg = in[18]; p.lnmb = in[19]; p.rgw = in[20]; p.rgb = in[21]; p.rew = in[22]; p.reb = in[23]; p.mg = in[24]; p.mu = in[25]; p.md = in[26]; p.lnfg = in[27]; p.lnfb = in[28];
    p.out = (float*)d_out;
    char* ws = (char*)d_ws; size_t off = 0;
    auto take = [&](size_t bytes) { char* r = ws + off; off += al256(bytes); return r; };
    p.WinT = (bf16_t*)take((size_t)2560 * 1024 * 2); p.WoutT = (bf16_t*)take((size_t)1024 * 1024 * 2); p.WgluT = (bf16_t*)take((size_t)512 * 512 * 2);
    p.WqkvT = (bf16_t*)take((size_t)3072 * 1024 * 2); p.WoutcT = (bf16_t*)take((size_t)1024 * 1024 * 2);
    p.WrT = (float*)take((size_t)2 * 36 * 1024 * 4);
    p.s5a = (float*)take(2048 * 2 * 4); p.s5a64 = (float*)take(2048 * 2 * 4); p.s5bbr = (float*)take(2048 * 16 * 4); p.s5bbi = (float*)take(2048 * 16 * 4); p.s5cm = (bf16_t*)take(32 * 16 * 128 * 2); p.s5bbm = (bf16_t*)take(32 * 128 * 16 * 2);
    p.cnt = (int*)take(64 * 4);
    p.bar = (unsigned*)take(4096 * 4);
    p.tok_e = (int*)take((size_t)NT * 2 * 4); p.tok_pos = (int*)take((size_t)NT * 2 * 4); p.tok_gate = (float*)take((size_t)NT * 2 * 4);
    p.list = (int*)take((size_t)32 * LIST_CAP * 4); p.list_gate = (float*)take((size_t)32 * LIST_CAP * 4);
    char* hbreg = take((size_t)NT * 1024 * 2);
    p.hb = (bf16_t*)hbreg;
    p.go = (bf16_t*)hbreg;
    p.s5loc = (float*)(hbreg + (size_t)NT * 512 * 2); p.s5in = p.s5loc + (size_t)NB_ * NCH * 2048 * 2;
    char* moew = take((size_t)32 * 1024 * 1024 * 2 + (size_t)32 * 1024 * 512 * 2);
    p.WguT = (bf16_t*)moew; p.WdT = (bf16_t*)(moew + (size_t)32 * 1024 * 1024 * 2);
    p.gq = (bf16_t*)moew; p.gk = p.gq + (size_t)NT * 512; p.gv = p.gk + (size_t)NT * 512;
    p.ygelu = (bf16_t*)moew;
    char* ar = ws + off;
    size_t a = 0;
    auto atake = [&](size_t bytes) { char* r = ar + a; a += al256(bytes); return r; };
    p.proj = (bf16_t*)atake((size_t)NT * PROJ_LD * 2);
    char* chunk0 = ar + a;
    p.cU = (bf16_t*)atake((size_t)NT * 512 * 2); p.cW = (bf16_t*)atake((size_t)NT * 512 * 2); p.cQd = (bf16_t*)atake((size_t)NT * 512 * 2); p.cKdT = (bf16_t*)atake((size_t)NT * 512 * 2);
    p.cQK = (bf16_t*)atake((size_t)NT * 512 * 2); p.cgl = (float*)atake((size_t)NB_ * 4 * NCH * 4);
    p.gbeta = (float*)atake((size_t)NT * 4 * 4); p.gg = (float*)atake((size_t)NT * 4 * 4);
    size_t amax = a;
    p.ycat = (bf16_t*)chunk0;
    p.mix = (bf16_t*)ar;
    p.Xg = (bf16_t*)ar; p.Y = (bf16_t*)ar; p.H = (bf16_t*)(ar + al256((size_t)(2 * NT + 256) * DM * 2)); p.slot_gate = (float*)((char*)p.H + al256((size_t)(2 * NT + 256) * EFF * 2));
    { size_t e = al256((size_t)(2 * NT + 256) * DM * 2) + al256((size_t)(2 * NT + 256) * EFF * 2) + (size_t)2 * NT * 4; if (e > amax) amax = e; }
    p.qkv = (bf16_t*)ar; p.attno = (bf16_t*)ar; p.mix1 = (bf16_t*)(ar + (size_t)NT * 1024 * 2);
    p.obr[0] = (bf16_t*)(ar + al256((size_t)NT * 3072 * 2) + (size_t)NT * 1024 * 2); p.obr[1] = (bf16_t*)moew; p.ost = (float*)(moew + (size_t)NT * 1024 * 2); p.obr[2] = (bf16_t*)(ar + al256((size_t)NT * 3072 * 2));
    { size_t e = al256((size_t)NT * 3072 * 2) + (size_t)2 * NT * 1024 * 2; if (e > amax) amax = e; }
    if (off + amax > ws_size) { fprintf(stderr, "workspace too small: need %zu have %zu\n", off + amax, ws_size); return; }
    auto job = [](const float* src, bf16_t* dst, int K, int N, int ldsrc, int ldd, int rb, int rs, int roff, int batch, long sbs, long dbs) {
        TJob j; memset(&j, 0, sizeof(j)); j.src = src; j.dst = dst; j.K = K; j.N = N; j.ldsrc = ldsrc; j.ldd = ldd; j.rb = rb; j.rs = rs; j.roff = roff; j.batch = batch; j.sbs = sbs; j.dbs = dbs; return j; };
    p.jobs[0] = job(p.w_in, p.WinT, 1024, 2048, 2568, 1024, 2048, 0, 0, 1, 0, 0);
    p.jobs[1] = job(p.w_in + 2056, p.WinT + (size_t)2048 * 1024, 1024, 512, 2568, 1024, 512, 0, 0, 1, 0, 0);
    p.jobs[2] = job(p.wout, p.WoutT, 1024, 1024, 1024, 1024, 1024, 0, 0, 1, 0, 0);
    p.jobs[3] = job(p.wglu, p.WgluT, 512, 512, 512, 512, 512, 0, 0, 1, 0, 0);
    p.jobs[4] = job(p.wqkv, p.WqkvT, 1024, 3072, 3072, 1024, 3072, 0, 0, 1, 0, 0);
    p.jobs[5] = job(p.woutc, p.WoutcT, 1024, 1024, 1024, 1024, 1024, 0, 0, 1, 0, 0);
    p.njobs = 6;
    for (int l = 0; l < 2; ++l) {
        p.moejobs[l][0] = job(p.mg + (size_t)l * 32 * 1024 * 512, p.WguT, 1024, 512, 512, 1024, 128, 256, 0, 32, 1024L * 512, 1024L * 1024);
        p.moejobs[l][1] = job(p.mu + (size_t)l * 32 * 1024 * 512, p.WguT, 1024, 512, 512, 1024, 128, 256, 128, 32, 1024L * 512, 1024L * 1024);
        p.moejobs[l][2] = job(p.md + (size_t)l * 32 * 512 * 1024, p.WdT, 512, 1024, 1024, 512, 1024, 0, 0, 32, 512L * 1024, 1024L * 512);
    }
#ifdef EMU
    g_emu_params = p;
#if N_LAUNCH_MODE == 1
    emu::launch(dim3(16), dim3(NTHREADS), LDS_BYTES, [=] { k_mega(p); }, true);
#else
    { const char* e = getenv("EMU_MAXPHASE"); launch_from<0>(p, 64, stream, e ? atoi(e) : NPHASES - 1); }
#endif
#else
#if N_LAUNCH_MODE == 1
    static int grid_blocks = 0;
    if (!grid_blocks) {
        int dev = 0, cus = 0, per_cu = 0;
        (void)hipGetDevice(&dev); (void)hipDeviceGetAttribute(&cus, hipDeviceAttributeMultiprocessorCount, dev);
        (void)hipFuncSetAttribute((const void*)k_mega, hipFuncAttributeMaxDynamicSharedMemorySize, LDS_BYTES);
        (void)hipOccupancyMaxActiveBlocksPerMultiprocessor(&per_cu, k_mega, NTHREADS, LDS_BYTES);
        per_cu = 1;
        grid_blocks = cus * per_cu;
    }
    (void)hipMemsetAsync(p.bar, 0, 4096 * 4, stream);
    void* args[] = {(void*)&p};
    hipError_t e = hipLaunchCooperativeKernel((void*)k_mega, dim3(grid_blocks), dim3(NTHREADS), args, LDS_BYTES, stream);
    if (e != hipSuccess) fprintf(stderr, "cooperative launch failed: %s (grid %d)\n", hipGetErrorString(e), grid_blocks);
#else
    launch_from<0>(p, 256, stream, NPHASES - 1);
#endif
#endif
}
```
